# Optimizing an MI355X kernel written in HIP

```python
import jax, jax.numpy as jnp
from jax import lax
import numpy as np

D_MODEL = 1024
BATCH = 4
SEQ = 8192
DEPTH = 2

GRID_W = 64
CTX_LEN = 256

D_MIX = D_MODEL
GROUP_W = D_MIX // 4

FNET_GROUPS = 4
FNET_CH = GROUP_W // FNET_GROUPS

WIN_HEADS = 4
WIN_KV_HEADS = 2
WIN_GROUP = WIN_HEADS // WIN_KV_HEADS
WIN_HEAD_DIM = GROUP_W // WIN_HEADS
WINDOW = 128
BLOCK = 128

MLA_HEADS = 4
MLA_NOPE = 64
MLA_ROPE = 32
MLA_QK = MLA_NOPE + MLA_ROPE
MLA_V = GROUP_W // MLA_HEADS
MLA_Q_RANK = 256
MLA_KV_RANK = 128

SGU_GROUPS = 4
SGU_CHUNK = 128
SGU_CH = GROUP_W // SGU_GROUPS

D_FF = 3584
N_EXPERTS = 8
TOP_K = 2

ROPE_THETA = 10000.0
EPS = 1e-6
NEG_INF = -1e30

PROJ_SIZES = (GROUP_W, WIN_HEADS * WIN_HEAD_DIM, WIN_KV_HEADS * WIN_HEAD_DIM, WIN_KV_HEADS * WIN_HEAD_DIM,
              MLA_Q_RANK, MLA_KV_RANK, MLA_ROPE, 2 * GROUP_W)
D_IN_PROJ = GROUP_W + WIN_HEADS * WIN_HEAD_DIM + 2 * WIN_KV_HEADS * WIN_HEAD_DIM + MLA_Q_RANK + MLA_KV_RANK + MLA_ROPE + 2 * GROUP_W

kernel_name = 'hybrid_diffusion_prefix_block'


def rms_norm(x, g):
    xf = x.astype(jnp.float32)
    y = xf * lax.rsqrt(jnp.mean(jnp.square(xf), axis=-1, keepdims=True) + EPS)
    return (y * g.astype(jnp.float32)).astype(x.dtype)


def layer_norm(x):
    xf = x.astype(jnp.float32)
    mu = jnp.mean(xf, axis=-1, keepdims=True)
    var = jnp.mean(jnp.square(xf - mu), axis=-1, keepdims=True)
    return ((xf - mu) * lax.rsqrt(var + EPS)).astype(x.dtype)


def adaln(cond, w_mod, b_mod):
    mod = jax.nn.silu(cond) @ w_mod + b_mod
    return [m[:, None, :] for m in jnp.split(mod, 6, axis=-1)]


def modulate(x, shift, scale):
    return x * (1.0 + scale) + shift


def axial_rope_tables(rows, rot_dim):
    n_freq = rot_dim // 4
    inv_freq = ROPE_THETA ** (-jnp.arange(n_freq, dtype=jnp.float32) / n_freq)
    row = jnp.repeat(jnp.arange(rows, dtype=jnp.float32), GRID_W)
    col = jnp.tile(jnp.arange(GRID_W, dtype=jnp.float32), rows)
    ang = jnp.concatenate([row[:, None] * inv_freq, col[:, None] * inv_freq], axis=-1)
    return jnp.cos(ang), jnp.sin(ang)


def apply_rope(x, cos, sin):
    xf = x.astype(jnp.float32).reshape(x.shape[:-1] + (x.shape[-1] // 2, 2))
    x1, x2 = xf[..., 0], xf[..., 1]
    cs, sn = cos[:, None, :], sin[:, None, :]
    out = jnp.stack([x1 * cs - x2 * sn, x1 * sn + x2 * cs], axis=-1)
    return out.reshape(x.shape).astype(x.dtype)


def split_proj(z):
    idx, acc = [], 0
    for s in PROJ_SIZES[:-1]:
        acc += s
        idx.append(acc)
    return jnp.split(z, idx, axis=-1)


def fourier_mix(a, w_f):
    b, n, _ = a.shape
    af = a.astype(jnp.float32).reshape(b, n, FNET_GROUPS, FNET_CH)
    y = jnp.fft.fft2(af, axes=(1, 3), norm='ortho').real
    return y.reshape(b, n, GROUP_W).astype(a.dtype) @ w_f


def sgu_mix(z, w_s, b_s):
    u, v = jnp.split(z, 2, axis=-1)
    v = layer_norm(v)
    b, n, _ = v.shape
    vc = v.reshape(b, n // SGU_CHUNK, SGU_CHUNK, SGU_GROUPS, SGU_CH)
    s = jnp.einsum('gpq,bcqgd->bcpgd', w_s, vc) + b_s.T[None, None, :, :, None]
    return u * s.reshape(b, n, GROUP_W)


def window_attn_latent(q, k, v, kc, vc, sink):
    b, n = q.shape[:2]
    lc = kc.shape[1]
    nb = n // BLOCK
    qb = q.reshape(b, nb, BLOCK, WIN_KV_HEADS, WIN_GROUP, WIN_HEAD_DIM)
    pad = ((0, 0), (BLOCK, BLOCK), (0, 0), (0, 0))
    kp = jnp.pad(k, pad).reshape(b, nb + 2, BLOCK, WIN_KV_HEADS, WIN_HEAD_DIM)
    vp = jnp.pad(v, pad).reshape(b, nb + 2, BLOCK, WIN_KV_HEADS, WIN_HEAD_DIM)
    kband = jnp.concatenate([kp[:, :-2], kp[:, 1:-1], kp[:, 2:]], axis=2)
    vband = jnp.concatenate([vp[:, :-2], vp[:, 1:-1], vp[:, 2:]], axis=2)
    s_win = jnp.einsum('bnqhgd,bnkhd->bnhgqk', qb, kband).astype(jnp.float32)
    qi = jnp.arange(BLOCK)[:, None]
    kj = jnp.arange(3 * BLOCK)[None, :]
    kpos = jnp.arange(nb)[:, None, None] * BLOCK - BLOCK + kj
    valid = (jnp.abs(kj - BLOCK - qi) <= WINDOW)[None] & (kpos >= 0) & (kpos < n)
    s_win = jnp.where(valid[None, :, None, None], s_win, NEG_INF)
    s_ctx = jnp.einsum('bnqhgd,bkhd->bnhgqk', qb, kc).astype(jnp.float32)
    s_sink = jnp.broadcast_to(sink.astype(jnp.float32).reshape(WIN_KV_HEADS, WIN_GROUP)[None, None, :, :, None, None],
                              s_win.shape[:-1] + (1,))
    p = jax.nn.softmax(jnp.concatenate([s_win, s_ctx, s_sink], axis=-1), axis=-1)
    p_win = p[..., :3 * BLOCK].astype(v.dtype)
    p_ctx = p[..., 3 * BLOCK:3 * BLOCK + lc].astype(v.dtype)
    o = jnp.einsum('bnhgqk,bnkhd->bnqhgd', p_win, vband) + jnp.einsum('bnhgqk,bkhd->bnqhgd', p_ctx, vc)
    return o.reshape(b, n, WIN_HEADS * WIN_HEAD_DIM)


def window_attn_context(q, kc, vc, sink):
    b, lc = q.shape[:2]
    s = jnp.einsum('bqhgd,bkhd->bhgqk', q, kc).astype(jnp.float32)
    s_sink = jnp.broadcast_to(sink.astype(jnp.float32).reshape(WIN_KV_HEADS, WIN_GROUP)[None, :, :, None, None],
                              s.shape[:-1] + (1,))
    p = jax.nn.softmax(jnp.concatenate([s, s_sink], axis=-1), axis=-1)[..., :lc].astype(vc.dtype)
    o = jnp.einsum('bhgqk,bkhd->bqhgd', p, vc)
    return o.reshape(b, lc, WIN_HEADS * WIN_HEAD_DIM)


def mla_q(cq, g_q, w_uq):
    b, l = cq.shape[:2]
    q = (rms_norm(cq, g_q) @ w_uq).reshape(b, l, MLA_HEADS, MLA_QK)
    return q[..., :MLA_NOPE], q[..., MLA_NOPE:]


def mla_kv(ckv, kr, g_kv, w_ukv):
    b, l = ckv.shape[:2]
    kv = (rms_norm(ckv, g_kv) @ w_ukv).reshape(b, l, MLA_HEADS, MLA_NOPE + MLA_V)
    k = jnp.concatenate([kv[..., :MLA_NOPE], jnp.broadcast_to(kr, (b, l, MLA_HEADS, MLA_ROPE))], axis=-1)
    return k, kv[..., MLA_NOPE:]


def mla_attn_latent(q, k, v, kc, vc):
    b, n = q.shape[:2]
    nb = n // BLOCK
    k_all = jnp.concatenate([k, kc], axis=1)
    v_all = jnp.concatenate([v, vc], axis=1)
    qb = jnp.moveaxis(q.reshape(b, nb, BLOCK, MLA_HEADS, MLA_QK), 1, 0)

    def one_block(q_blk):
        s = jnp.einsum('bqhd,bkhd->bhqk', q_blk, k_all).astype(jnp.float32)
        p = jax.nn.softmax(s, axis=-1).astype(v_all.dtype)
        return jnp.einsum('bhqk,bkhd->bqhd', p, v_all)

    o = lax.map(one_block, qb)
    return jnp.moveaxis(o, 0, 1).reshape(b, n, MLA_HEADS * MLA_V)


def mla_attn_context(q, kc, vc):
    b, lc = q.shape[:2]
    s = jnp.einsum('bqhd,bkhd->bhqk', q, kc).astype(jnp.float32)
    p = jax.nn.softmax(s, axis=-1).astype(vc.dtype)
    return jnp.einsum('bhqk,bkhd->bqhd', p, vc).reshape(b, lc, MLA_HEADS * MLA_V)


def token_mixer(ax, ac, cos_w, sin_w, cos_m, sin_m, w_in, w_fourier, win_sink, mla_g_q, mla_g_kv,
                mla_w_uq, mla_w_ukv, sgu_w, sgu_b, w_out, need_ctx_out):
    b, n, _ = ax.shape
    lc = ac.shape[1]
    mla_scale = MLA_QK ** -0.5
    a_x, wq_x, wk_x, wv_x, cq_x, ckv_x, kr_x, sg_x = split_proj(ax @ w_in)
    w_parts = split_proj(w_in)
    wk_c, wv_c, ckv_c, kr_c = [ac @ w_parts[i] for i in (2, 3, 5, 6)]
    k_win_c = wk_c.reshape(b, lc, WIN_KV_HEADS, WIN_HEAD_DIM)
    v_win_c = wv_c.reshape(b, lc, WIN_KV_HEADS, WIN_HEAD_DIM)
    k_mla_c, v_mla_c = mla_kv(ckv_c, kr_c[:, :, None, :], mla_g_kv, mla_w_ukv)

    four_x = fourier_mix(a_x, w_fourier)
    q = apply_rope(wq_x.reshape(b, n, WIN_HEADS, WIN_HEAD_DIM), cos_w, sin_w) * (WIN_HEAD_DIM ** -0.5)
    k = apply_rope(wk_x.reshape(b, n, WIN_KV_HEADS, WIN_HEAD_DIM), cos_w, sin_w)
    v = wv_x.reshape(b, n, WIN_KV_HEADS, WIN_HEAD_DIM)
    win_x = window_attn_latent(q.reshape(b, n, WIN_KV_HEADS, WIN_GROUP, WIN_HEAD_DIM), k, v, k_win_c, v_win_c, win_sink)
    qn, qr = mla_q(cq_x, mla_g_q, mla_w_uq)
    q_mla = jnp.concatenate([qn, apply_rope(qr, cos_m, sin_m)], axis=-1) * mla_scale
    k_mla, v_mla = mla_kv(ckv_x, apply_rope(kr_x[:, :, None, :], cos_m, sin_m), mla_g_kv, mla_w_ukv)
    mla_x = mla_attn_latent(q_mla, k_mla, v_mla, k_mla_c, v_mla_c)
    sgu_x = sgu_mix(jax.nn.gelu(sg_x, approximate=False), sgu_w, sgu_b)
    out_x = jnp.concatenate([four_x, win_x, mla_x, sgu_x], axis=-1) @ w_out
    if not need_ctx_out:
        return out_x, None

    a_c, wq_c, cq_c, sg_c = [ac @ w_parts[i] for i in (0, 1, 4, 7)]
    four_c = fourier_mix(a_c, w_fourier)
    q_c = wq_c.reshape(b, lc, WIN_KV_HEADS, WIN_GROUP, WIN_HEAD_DIM) * (WIN_HEAD_DIM ** -0.5)
    win_c = window_attn_context(q_c, k_win_c, v_win_c, win_sink)
    qn_c, qr_c = mla_q(cq_c, mla_g_q, mla_w_uq)
    mla_c = mla_attn_context(jnp.concatenate([qn_c, qr_c], axis=-1) * mla_scale, k_mla_c, v_mla_c)
    sgu_c = sgu_mix(jax.nn.gelu(sg_c, approximate=False), sgu_w, sgu_b)
    out_c = jnp.concatenate([four_c, win_c, mla_c, sgu_c], axis=-1) @ w_out
    return out_x, out_c


def swiglu(t, w_gate, w_up, w_down):
    return (jax.nn.silu(t @ w_gate) * (t @ w_up)) @ w_down


def moe_ffn(x, w_router, w_gate, w_up, w_down):
    b, n, d = x.shape
    t = x.reshape(-1, d)
    logits = (t @ w_router).astype(jnp.float32)
    top_val, top_idx = lax.top_k(logits, TOP_K)
    top_w = jax.nn.softmax(top_val, axis=-1)
    comb = jnp.sum(jax.nn.one_hot(top_idx, N_EXPERTS, dtype=jnp.float32) * top_w[..., None], axis=1)
    y = jnp.zeros_like(t)
    for e in range(N_EXPERTS):
        y = y + comb[:, e:e + 1].astype(t.dtype) * swiglu(t, w_gate[e], w_up[e], w_down[e])
    return y.reshape(b, n, d)


def channel_mixer(t, layer, ffn_w_gate, ffn_w_up, ffn_w_down, moe_w_router, moe_w_gate, moe_w_up, moe_w_down):
    i = layer // 2
    if layer % 2 == 0:
        return swiglu(t, ffn_w_gate[i], ffn_w_up[i], ffn_w_down[i])
    return moe_ffn(t, moe_w_router[i], moe_w_gate[i], moe_w_up[i], moe_w_down[i])


def setup_inputs(seed: int = 0) -> dict:
    key = jax.random.key(seed)
    ks = jax.random.split(key, 27)
    nl, nd, nm = DEPTH, (DEPTH + 1) // 2, DEPTH // 2

    def nrm(k, shape, scale):
        return scale * jax.random.normal(k, shape, jnp.float32)

    def gain(k, shape):
        return 1.0 + 0.05 * jax.random.normal(k, shape, jnp.float32)

    return {
        'x': nrm(ks[0], (BATCH, SEQ, D_MODEL), 1.0),
        'c': nrm(ks[1], (BATCH, D_MODEL), 1.0),
        'ctx': nrm(ks[2], (BATCH, CTX_LEN, D_MODEL), 1.0),
        'c_ctx': nrm(ks[3], (D_MODEL,), 1.0),
        'w_mod': nrm(ks[4], (nl, D_MODEL, 6 * D_MODEL), D_MODEL ** -0.5),
        'b_mod': nrm(ks[5], (nl, 6 * D_MODEL), 0.02),
        'g_pre_mix': gain(ks[6], (nl, D_MODEL)),
        'g_post_mix': gain(ks[7], (nl, D_MODEL)),
        'g_pre_ffn': gain(ks[8], (nl, D_MODEL)),
        'g_post_ffn': gain(ks[9], (nl, D_MODEL)),
        'w_in': nrm(ks[10], (nl, D_MODEL, D_IN_PROJ), D_MODEL ** -0.5),
        'w_out': nrm(ks[11], (nl, D_MIX, D_MODEL), D_MIX ** -0.5),
        'w_fourier': nrm(ks[12], (nl, GROUP_W, GROUP_W), GROUP_W ** -0.5),
        'win_sink': nrm(ks[13], (nl, WIN_HEADS), 1.0),
        'mla_g_q': gain(ks[14], (nl, MLA_Q_RANK)),
        'mla_g_kv': gain(ks[15], (nl, MLA_KV_RANK)),
        'mla_w_uq': nrm(ks[16], (nl, MLA_Q_RANK, MLA_HEADS * MLA_QK), MLA_Q_RANK ** -0.5),
        'mla_w_ukv': nrm(ks[17], (nl, MLA_KV_RANK, MLA_HEADS * (MLA_NOPE + MLA_V)), MLA_KV_RANK ** -0.5),
        'sgu_w': nrm(ks[18], (nl, SGU_GROUPS, SGU_CHUNK, SGU_CHUNK), SGU_CHUNK ** -0.5),
        'sgu_b': 1.0 + nrm(ks[19], (nl, SGU_GROUPS, SGU_CHUNK), 0.1),
        'ffn_w_gate': nrm(ks[20], (nd, D_MODEL, D_FF), D_MODEL ** -0.5),
        'ffn_w_up': nrm(ks[21], (nd, D_MODEL, D_FF), D_MODEL ** -0.5),
        'ffn_w_down': nrm(ks[22], (nd, D_FF, D_MODEL), D_FF ** -0.5),
        'moe_w_router': nrm(ks[23], (nm, D_MODEL, N_EXPERTS), D_MODEL ** -0.5),
        'moe_w_gate': nrm(ks[24], (nm, N_EXPERTS, D_MODEL, D_FF), D_MODEL ** -0.5),
        'moe_w_up': nrm(ks[25], (nm, N_EXPERTS, D_MODEL, D_FF), D_MODEL ** -0.5),
        'moe_w_down': nrm(ks[26], (nm, N_EXPERTS, D_FF, D_MODEL), D_FF ** -0.5),
    }


def reference(x, c, ctx, c_ctx, w_mod, b_mod, g_pre_mix, g_post_mix, g_pre_ffn, g_post_ffn,
              w_in, w_out, w_fourier, win_sink, mla_g_q, mla_g_kv, mla_w_uq, mla_w_ukv,
              sgu_w, sgu_b, ffn_w_gate, ffn_w_up, ffn_w_down,
              moe_w_router, moe_w_gate, moe_w_up, moe_w_down):
    rows = x.shape[1] // GRID_W
    cos_w, sin_w = axial_rope_tables(rows, WIN_HEAD_DIM)
    cos_m, sin_m = axial_rope_tables(rows, MLA_ROPE)
    hx, hc = x, ctx
    for layer in range(DEPTH):
        last = layer == DEPTH - 1
        sh_a, sc_a, gt_a, sh_f, sc_f, gt_f = adaln(c, w_mod[layer], b_mod[layer])
        csh_a, csc_a, cgt_a, csh_f, csc_f, cgt_f = adaln(c_ctx[None, :], w_mod[layer], b_mod[layer])
        ax = modulate(rms_norm(hx, g_pre_mix[layer]), sh_a, sc_a)
        ac = modulate(rms_norm(hc, g_pre_mix[layer]), csh_a, csc_a)
        mx, mc = token_mixer(ax, ac, cos_w, sin_w, cos_m, sin_m, w_in[layer], w_fourier[layer], win_sink[layer],
                             mla_g_q[layer], mla_g_kv[layer], mla_w_uq[layer], mla_w_ukv[layer],
                             sgu_w[layer], sgu_b[layer], w_out[layer], not last)
        hx = hx + gt_a * rms_norm(mx, g_post_mix[layer])
        fx = modulate(rms_norm(hx, g_pre_ffn[layer]), sh_f, sc_f)
        hx = hx + gt_f * rms_norm(channel_mixer(fx, layer, ffn_w_gate, ffn_w_up, ffn_w_down, moe_w_router,
                                                moe_w_gate, moe_w_up, moe_w_down), g_post_ffn[layer])
        if not last:
            hc = hc + cgt_a * rms_norm(mc, g_post_mix[layer])
            fc = modulate(rms_norm(hc, g_pre_ffn[layer]), csh_f, csc_f)
            hc = hc + cgt_f * rms_norm(channel_mixer(fc, layer, ffn_w_gate, ffn_w_up, ffn_w_down, moe_w_router,
                                                    moe_w_gate, moe_w_up, moe_w_down), g_post_ffn[layer])
    return hx
```

```cpp
#include <hip/hip_runtime.h>
#include <stdint.h>
#include <stdio.h>

typedef unsigned short bf16_t;
#ifndef MK_REP
#define MK_REP 0
#endif
constexpr int TL = 32768, TC = 1024, RR = TL + TC, DM = 1024, NKEY = 8448, DFF = 3584, NE = 8, DIN = 1696;
constexpr int NSORT = 264 * 256;
constexpr float EPS = 1e-6f;

__device__ __forceinline__ float bf2f(bf16_t v) { return __uint_as_float(((unsigned)v) << 16); }
__device__ __forceinline__ bf16_t f2bf(float f) { unsigned u = __float_as_uint(f); u += 0x7fffu + ((u >> 16) & 1u); return (bf16_t)(u >> 16); }
__device__ __forceinline__ int row_cond(int r) { return r < TL ? (r >> 13) : 4; }
__device__ __forceinline__ int row_batch(int r) { return r < TL ? (r >> 13) : ((r - TL) >> 8); }
__device__ __forceinline__ int row_key(int r) { return r < TL ? (r & 8191) : 8192 + ((r - TL) & 255); }
__device__ __forceinline__ float silu_f(float x) { return x / (1.f + __expf(-x)); }
__device__ __forceinline__ float gelu_f(float x) { return 0.5f * x * (1.f + erff(x * 0.70710678118654752f)); }

constexpr size_t al256(size_t x) { return (x + 255) / 256 * 256; }
constexpr size_t OFF_CTL = 0;
constexpr size_t OFF_MOD = OFF_CTL + 65536;
constexpr size_t OFF_ROPEW = OFF_MOD + al256(2 * 5 * 6144 * 4);
constexpr size_t OFF_ROPEM = OFF_ROPEW + 128 * 16 * 8;
constexpr size_t OFF_TW = OFF_ROPEM + 128 * 8 * 8;
constexpr size_t OFF_CS8K = OFF_TW + 64 * 128 * 8;
constexpr size_t OFF_FA = OFF_CS8K + 8192 * 8;
constexpr size_t OFF_GM = OFF_FA + 256 * 128 * 2;
constexpr size_t OFF_FC = OFF_GM + 128 * 128 * 2;
constexpr size_t OFF_M12 = OFF_FC + 512 * 256 * 2;
constexpr size_t OFF_HXC = OFF_M12 + 2 * 512 * 256 * 4;
constexpr size_t OFF_WOF = OFF_HXC + 1024 * 1024 * 4;
constexpr size_t OFF_TOKE = OFF_WOF + (size_t)2 * 512 * 1024 * 4;
constexpr size_t OFF_TOKW = OFF_TOKE + TL * 2 * 4;
constexpr size_t OFF_TOKS = OFF_TOKW + TL * 2 * 4;
constexpr size_t OFF_ROWIDX = OFF_TOKS + TL * 2 * 4;
constexpr size_t OFF_TILEE = OFF_ROWIDX + NSORT * 4;
constexpr size_t OFF_SSQQ = OFF_TILEE + al256(272 * 4);
constexpr size_t OFF_SSQKV = OFF_SSQQ + (size_t)RR * 16;
constexpr size_t OFF_LNS = OFF_SSQKV + (size_t)RR * 16;
constexpr size_t OFF_XN = OFF_LNS + (size_t)RR * 32;
constexpr size_t OFF_W = OFF_XN + (size_t)RR * 1024 * 2;
constexpr size_t W_BYTES = (size_t)2 * 1792 * 1024 * 2 + (size_t)2 * 1024 * 384 * 2 + (size_t)2 * 1024 * 1280 * 2 + (size_t)7168 * 1024 * 2 + (size_t)1024 * 3584 * 2 + (size_t)8 * 7168 * 1024 + (size_t)8 * 1024 * 3584;
constexpr size_t OFF_S = OFF_W + W_BYTES;
constexpr size_t S_CAT = 0;
constexpr size_t S_ABUF = S_CAT + (size_t)RR * 1280 * 2;
constexpr size_t S_QW = S_ABUF + (size_t)RR * 256 * 2;
constexpr size_t S_KW = S_QW + (size_t)RR * 256 * 2;
constexpr size_t S_VW = S_KW + (size_t)4 * NKEY * 128 * 2;
constexpr size_t S_C2 = S_VW + (size_t)4 * NKEY * 128 * 2;
constexpr size_t S_KM = S_C2 + (size_t)RR * 384 * 2;
constexpr size_t S_VM = S_KM + (size_t)16 * NKEY * 96 * 2;
constexpr size_t S_U = S_VM + (size_t)16 * NKEY * 64 * 2;
constexpr size_t S_VG = S_U + (size_t)RR * 256 * 2;
constexpr size_t S_QM = S_VG + (size_t)RR * 256 * 2;
constexpr size_t S_UP = S_QM + (size_t)RR * 384 * 2;
constexpr size_t S_END_MIX = S_UP + (size_t)4 * 128 * 2 * 64 * 256 * 2;
constexpr size_t S_MX = S_ABUF;
constexpr size_t S_H = 0;
constexpr size_t S_YS = S_H + (size_t)RR * 3584 * 2;
constexpr size_t S_END = S_YS + (size_t)NSORT * 1024 * 2;
static_assert(S_END_MIX <= S_END, "S region");
static_assert(S_MX + (size_t)RR * 1024 * 2 <= S_END_MIX, "MX overlay");
static_assert((size_t)NSORT * 3584 <= (size_t)RR * 3584 * 2, "fp8 H fits");
constexpr size_t WS_NEED = OFF_S + S_END;

constexpr int CW_CNT = 4096;
constexpr int CW_CUR = 4112;
constexpr int CW_OFF = 4128;
constexpr int CW_NT = 4144;

struct Params {
    const float *x, *c, *ctx, *c_ctx, *w_mod, *b_mod, *g_pre_mix, *g_post_mix, *g_pre_ffn, *g_post_ffn, *w_in, *w_out, *w_fourier, *win_sink,
        *mla_g_q, *mla_g_kv, *mla_w_uq, *mla_w_ukv, *sgu_w, *sgu_b, *ffn_w_gate, *ffn_w_up, *ffn_w_down, *moe_w_router, *moe_w_gate, *moe_w_up, *moe_w_down;
    float* out; char* ws;
    int wv, pad_;
};
#define WSP(T, off) ((T*)(p.ws + (off)))
#define SP(T, off) ((T*)(p.ws + OFF_S + (off)))

__device__ __forceinline__ float sum4(const float* q) { return (q[0] + q[1]) + (q[2] + q[3]); }
__device__ __forceinline__ int ld_i(const int* q) { return __hip_atomic_load(q, __ATOMIC_RELAXED, __HIP_MEMORY_SCOPE_AGENT); }
__device__ __forceinline__ float ld_f(const float* q) { return __hip_atomic_load(q, __ATOMIC_RELAXED, __HIP_MEMORY_SCOPE_AGENT); }
__device__ __forceinline__ int bid_() { int b = blockIdx.x; asm volatile("" : "+s"(b)); return b; }
__device__ __forceinline__ int lane_() { int l; asm volatile("v_mbcnt_lo_u32_b32 %0, -1, 0\n\tv_mbcnt_hi_u32_b32 %0, -1, %0" : "=v"(l)); return l; }
__device__ __forceinline__ int tid_(int wv) { return (wv << 6) | lane_(); }
namespace pg8 {
#define PG8_LAS __attribute__((address_space(3)))
typedef short bf16x8 __attribute__((ext_vector_type(8)));
typedef float f32x4 __attribute__((ext_vector_type(4)));
typedef unsigned u32x4 __attribute__((ext_vector_type(4)));
typedef unsigned u32x2 __attribute__((ext_vector_type(2)));
typedef int v8i_t __attribute__((ext_vector_type(8)));
typedef int v4i_t __attribute__((ext_vector_type(4)));
constexpr int BM = 256, BK = 64, HALF = 128, HTB = HALF * BK * 2, STAGE_BYTES = 8 * HTB, NXCD = 8, WGM = 8;
__host__ __device__ __forceinline__ int lds_byte(int r, int c) { const int st = (r >> 4) * 2 + (c >> 5), rr = r & 15, cc = c & 31, ob = rr * 64 + cc * 2; return st * 1024 + (ob ^ (((ob >> 9) & 1) << 5)); }
__host__ __device__ __forceinline__ void stage_rc(int b, int& R, int& C) { const int st = b / 1024, sb = b % 1024, swz = sb ^ (((sb >> 9) & 1) << 5); R = (st >> 1) * 16 + swz / 64; C = (st & 1) * 32 + (swz % 64) / 2; }
__host__ __device__ __forceinline__ int perm32(int rho) { const int n = rho >> 4, i = rho & 15; return 8 * (i >> 2) + 4 * n + (i & 3); }
struct Unit { int pm, pn; };
struct Gemm { int lda, ldb, K, wv; };
__device__ __forceinline__ unsigned cvt_pk_bf16(float lo, float hi) { unsigned r; asm volatile("v_cvt_pk_bf16_f32 %0, %1, %2" : "=v"(r) : "v"(lo), "v"(hi)); return r; }

struct OrderBase {
    int nM, nN, nwg, G, c;
    __device__ void init(int nM_, int nN_, int G_, int c_) { nM = nM_; nN = nN_; nwg = nM * nN; G = G_; c = c_; }
    __device__ bool next(int i, Unit& u) const {
        const long L = (long)i * G + c; if (L >= nwg) return false;
        int wgid = (int)L; { const int q = nwg / NXCD, r = nwg % NXCD, xcd = wgid % NXCD, off = wgid / NXCD; wgid = (xcd < r ? xcd * (q + 1) : r * (q + 1) + (xcd - r) * q) + off; }
        const int nig = WGM * nN, gid = wgid / nig, fm = gid * WGM, gsz = (nM - fm) < WGM ? (nM - fm) : WGM;
        u.pm = fm + ((wgid % nig) % gsz); u.pn = (wgid % nig) / gsz; return true;
    }
};

__device__ __forceinline__ void glds16_s(const char* sbase, unsigned voff, unsigned lds_addr) {
    unsigned keep;
    asm volatile("s_mov_b32 %0, m0\n\ts_mov_b32 m0, %3\n\ts_nop 0\n\tglobal_load_lds_dwordx4 %1, %2\n\ts_mov_b32 m0, %0" : "=&s"(keep) : "v"(voff), "s"(sbase), "s"(lds_addr) : "memory");
}
template <class Epi, class Sched, bool GATHER, bool FP8 = false>
__device__ __forceinline__ void gemm_phase(PG8_LAS unsigned char* lds, const Gemm g, const Sched& S, const Epi& E) {
    int wid_ = g.wv; asm volatile("" : "+s"(wid_));
    const int tid = tid_(g.wv), wid = wid_, lane = tid & 63, wr = wid >> 2, wc = wid & 3, fr = lane & 15, fq = lane >> 4;
    const int K = g.K, nt = K / BK;
    int mxs = 0x7f7f7f7f; asm volatile("" : "+v"(mxs));
    unsigned voffA[2], voffB[2]; int RA[2];
#pragma unroll
    for (int i = 0; i < 2; ++i) { int R, C; stage_rc(tid * 16 + i * 8192, R, C); const int Rb = Epi::PERM ? ((R & ~31) + perm32(R & 31)) : R;
        RA[i] = R; voffA[i] = GATHER ? (unsigned)(C * 2) : (unsigned)(R * g.lda + C) * 2u; voffB[i] = (unsigned)(Rb * g.ldb + C) * 2u; }
    const size_t kstep = (size_t)(BK * 2);
    const size_t hstepA = GATHER ? 0 : (size_t)HALF * g.lda * 2, hstepB = (size_t)HALF * g.ldb * 2, rstepA = (size_t)64 * g.lda * 2, rstepB = (size_t)64 * g.ldb * 2;
    const unsigned ldsw = (unsigned)wid * 1024u, ldsbase = (unsigned)(uintptr_t)lds;
    const int aoff = lds_byte(wr * 64 + fr, fq * 8), boff = lds_byte(wc * 32 + fr, fq * 8);
    unsigned gC[2] = {0, 0}, gN[2] = {0, 0};
#define PG8_SA(b, h) (((b) * 2 + (h)) * HTB)
#define PG8_SB(b, h) ((4 + (b) * 2 + (h)) * HTB)
#define PG8_STAGE_B(bufoff, gbase) do { _Pragma("unroll") for (int _i = 0; _i < 2; ++_i) { \
        if constexpr (FP8) glds16_s((const char*)(gbase) + _i * rstepB, voffB[0], ldsbase + (unsigned)(bufoff) + ldsw + _i * 8192u); \
        else __builtin_amdgcn_global_load_lds((const unsigned*)((const char*)(gbase) + _i * rstepB + voffB[0]), (PG8_LAS unsigned*)(lds + (bufoff) + ldsw + _i * 8192), 16, 0, 0); } } while (0)
#define PG8_STAGE_A(bufoff, gbase, h, usenext) do { _Pragma("unroll") for (int _i = 0; _i < 2; ++_i) { \
        const unsigned _o = GATHER ? voffA[0] + ((((usenext) ? gN[h] : gC[h]) >> (16 * _i)) & 0xffffu) * (unsigned)(g.lda * 2) : voffA[0]; \
        if constexpr (FP8) glds16_s((const char*)(gbase) + (h) * hstepA + (GATHER ? 0 : _i) * rstepA, _o, ldsbase + (unsigned)(bufoff) + ldsw + _i * 8192u); \
        else __builtin_amdgcn_global_load_lds((const unsigned*)((const char*)(gbase) + (h) * hstepA + (GATHER ? 0 : _i) * rstepA + _o), (PG8_LAS unsigned*)(lds + (bufoff) + ldsw + _i * 8192), 16, 0, 0); } } while (0)
#define PG8_LDA(dst, b, h) do { _Pragma("unroll") for (int m = 0; m < 4; ++m) { if constexpr (FP8) { const v4i_t lo_ = *(const PG8_LAS v4i_t*)(lds + PG8_SA(b, h) + aoff + m * 2048), hi_ = *(const PG8_LAS v4i_t*)(lds + PG8_SA(b, h) + aoff + m * 2048 + 1024); \
        dst##8[m] = __builtin_shufflevector(lo_, hi_, 0, 1, 2, 3, 4, 5, 6, 7); } else { _Pragma("unroll") for (int k = 0; k < 2; ++k) dst[m][k] = *(const PG8_LAS bf16x8*)(lds + PG8_SA(b, h) + aoff + m * 2048 + k * 1024); } } } while (0)
#define PG8_LDB(dst, b, h) do { _Pragma("unroll") for (int n = 0; n < 2; ++n) { if constexpr (FP8) { const v4i_t lo_ = *(const PG8_LAS v4i_t*)(lds + PG8_SB(b, h) + boff + n * 2048), hi_ = *(const PG8_LAS v4i_t*)(lds + PG8_SB(b, h) + boff + n * 2048 + 1024); \
        dst##8[n] = __builtin_shufflevector(lo_, hi_, 0, 1, 2, 3, 4, 5, 6, 7); } else { _Pragma("unroll") for (int k = 0; k < 2; ++k) dst[n][k] = *(const PG8_LAS bf16x8*)(lds + PG8_SB(b, h) + boff + n * 2048 + k * 1024); } } } while (0)
#define PG8_MMA(ai, bj, At, Bt) do { __builtin_amdgcn_s_setprio(1); _Pragma("unroll") for (int m = 0; m < 4; ++m) _Pragma("unroll") for (int n = 0; n < 2; ++n) { \
        if constexpr (FP8) acc[ai][bj][m][n] = __builtin_amdgcn_mfma_scale_f32_16x16x128_f8f6f4(Bt##8[n], At##8[m], acc[ai][bj][m][n], 0, 0, 0, mxs, 0, mxs); \
        else { _Pragma("unroll") for (int k = 0; k < 2; ++k) acc[ai][bj][m][n] = __builtin_amdgcn_mfma_f32_16x16x32_bf16(Bt[n][k], At[m][k], acc[ai][bj][m][n], 0, 0, 0); } } \
        __builtin_amdgcn_s_setprio(0); } while (0)
#define PG8_WAIT_V(n) asm volatile("s_waitcnt vmcnt(" #n ")" ::: "memory")
#define PG8_WAIT_L(n) asm volatile("s_waitcnt lgkmcnt(" #n ")" ::: "memory")
#define PG8_BAR __builtin_amdgcn_s_barrier()
#define PG8_SCHED __builtin_amdgcn_sched_barrier(0)
    Unit cur, nxt; int ui = 0;
    if (!S.next(0, cur)) return;
    f32x4 acc[2][2][4][2];
#pragma unroll
    for (int a = 0; a < 2; ++a)
#pragma unroll
        for (int b = 0; b < 2; ++b)
#pragma unroll
            for (int m = 0; m < 4; ++m)
#pragma unroll
                for (int n = 0; n < 2; ++n) acc[a][b][m][n] = (f32x4){0.f, 0.f, 0.f, 0.f};
    bf16x8 At[4][2], B0[2][2], B1[2][2]; v8i_t At8[4], B08[2], B18[2];
    const char* cA = S.a_base(cur); const char* cB = S.b_base(cur);
    if constexpr (GATHER) {
#pragma unroll
        for (int h = 0; h < 2; ++h) gC[h] = (unsigned)S.row(cur, h * HALF + RA[0]) | ((unsigned)S.row(cur, h * HALF + RA[1]) << 16);
    }
    PG8_STAGE_B(PG8_SB(0, 0), cB); PG8_STAGE_B(PG8_SB(0, 1), cB + hstepB); PG8_STAGE_A(PG8_SA(0, 0), cA, 0, false); PG8_STAGE_A(PG8_SA(0, 1), cA, 1, false);
    if (wr == 1) PG8_BAR;
    PG8_WAIT_V(2); PG8_BAR;
    PG8_STAGE_B(PG8_SB(1, 0), cB + kstep); PG8_STAGE_A(PG8_SA(1, 0), cA + kstep, 0, false); PG8_STAGE_B(PG8_SB(1, 1), cB + hstepB + kstep);
    PG8_WAIT_V(6); PG8_BAR;
    for (;;) {
        const bool has_next = S.next(ui + 1, nxt);
        if (!has_next) nxt = cur;
        const char* nA = S.a_base(nxt); const char* nB = S.b_base(nxt);
        if constexpr (GATHER) { int R0_, R1_, C_; const int t3_ = tid_(g.wv); stage_rc(t3_ * 16, R0_, C_); stage_rc(t3_ * 16 + 8192, R1_, C_);
#pragma unroll
            for (int h = 0; h < 2; ++h) gN[h] = (unsigned)S.row(nxt, h * HALF + R0_) | ((unsigned)S.row(nxt, h * HALF + R1_) << 16);
        }
        asm volatile(".p2align 8");
#pragma unroll 1
        for (int t = 0; t < nt; t += 2) {
            const bool last = (t == nt - 2);
            const char* a1 = cA + (size_t)(t + 1) * kstep;
            const char* a2 = last ? nA : cA + (size_t)(t + 2) * kstep; const char* b2 = last ? nB : cB + (size_t)(t + 2) * kstep;
            const char* a3 = a2 + kstep; const char* b3 = b2 + kstep;
            PG8_LDB(B0, 0, 0); PG8_LDB(B1, 0, 1); PG8_SCHED; PG8_LDA(At, 0, 0); PG8_STAGE_A(PG8_SA(1, 1), a1, 1, false);
            PG8_WAIT_V(8); PG8_WAIT_L(0); PG8_BAR; PG8_MMA(0, 0, At, B0); PG8_MMA(0, 1, At, B1); PG8_BAR; PG8_SCHED;
            PG8_LDA(At, 0, 1); PG8_STAGE_B(PG8_SB(0, 0), b2); PG8_STAGE_B(PG8_SB(0, 1), b2 + hstepB); PG8_STAGE_A(PG8_SA(0, 0), a2, 0, last);
            PG8_WAIT_V(8); PG8_WAIT_L(0); PG8_BAR; PG8_MMA(1, 0, At, B0); PG8_MMA(1, 1, At, B1); PG8_BAR; PG8_SCHED;
            PG8_LDB(B0, 1, 0); PG8_LDB(B1, 1, 1); PG8_SCHED; PG8_LDA(At, 1, 0); PG8_STAGE_A(PG8_SA(0, 1), a2, 1, last);
            PG8_WAIT_V(8); PG8_WAIT_L(0); PG8_BAR; PG8_MMA(0, 0, At, B0); PG8_MMA(0, 1, At, B1); PG8_BAR; PG8_SCHED;
            PG8_LDA(At, 1, 1); PG8_STAGE_B(PG8_SB(1, 0), b3); PG8_STAGE_B(PG8_SB(1, 1), b3 + hstepB); PG8_STAGE_A(PG8_SA(1, 0), a3, 0, last);
            PG8_WAIT_V(8); PG8_WAIT_L(0); PG8_BAR; PG8_MMA(1, 0, At, B0); PG8_MMA(1, 1, At, B1); PG8_BAR; PG8_SCHED;
        }
        if (wr == 0) PG8_BAR;
        { const int t2_ = tid_(g.wv), fr_ = t2_ & 15, fq_ = (t2_ >> 4) & 3;
          E(acc, cur, wr, wc, fr_, fq_); }
        if (!has_next) break;
#pragma unroll
        for (int a = 0; a < 2; ++a)
#pragma unroll
            for (int b = 0; b < 2; ++b)
#pragma unroll
                for (int m = 0; m < 4; ++m)
#pragma unroll
                    for (int n = 0; n < 2; ++n) acc[a][b][m][n] = (f32x4){0.f, 0.f, 0.f, 0.f};
        cur = nxt; cA = nA; cB = nB; ++ui;
        if constexpr (GATHER) { gC[0] = gN[0]; gC[1] = gN[1]; }
        if (wr == 1) PG8_BAR;
    }
    PG8_WAIT_V(0);
    PG8_BAR;
#undef PG8_SA
#undef PG8_SB
#undef PG8_STAGE_A
#undef PG8_STAGE_B
#undef PG8_LDA
#undef PG8_LDB
#undef PG8_MMA
#undef PG8_WAIT_V
#undef PG8_WAIT_L
#undef PG8_BAR
#undef PG8_SCHED
}
}

constexpr int OPT_THREADS = 512, OPT_LDS = 147456;
__device__ __forceinline__ bf16_t* ys_row(const Params& p, int srow) { return SP(bf16_t, S_YS) + (size_t)srow * 1024; }
__device__ __forceinline__ unsigned fp8x4(float a, float b, float c, float d) { int r = __builtin_amdgcn_cvt_pk_fp8_f32(a, b, 0, false); return (unsigned)__builtin_amdgcn_cvt_pk_fp8_f32(c, d, r, true); }
__device__ __forceinline__ float clamp448(float v) { return __builtin_amdgcn_fmed3f(v, -448.f, 448.f); }
constexpr size_t W_IN = 0;
constexpr size_t W_UP = W_IN + (size_t)2 * 1792 * 1024 * 2;
constexpr size_t W_O = W_UP + (size_t)2 * 1024 * 384 * 2;
constexpr size_t W_GU = W_O + (size_t)2 * 1024 * 1280 * 2;
constexpr size_t W_D = W_GU + (size_t)7168 * 1024 * 2;
constexpr size_t W_MGU = W_D + (size_t)1024 * 3584 * 2;
constexpr size_t W_MD = W_MGU + (size_t)8 * 7168 * 1024;
constexpr size_t W_END = W_MD + (size_t)8 * 1024 * 3584;
static_assert(W_END == W_BYTES, "weights region");
#ifndef MK_TEST
#define MK_TEST 0
#endif
#ifndef DENSE_FP8
#define DENSE_FP8 2
#endif
constexpr float WSCALE = 64.f, HSCALE = 8.f;
#define WP(off) ((bf16_t*)(p.ws + OFF_W + (off)))

struct CvtJob { bf16_t* dst; int ldd; const float* s0; const float* s1; int lds_, kind; const float* scale; const float* scale2; bool f8; };
__device__ __forceinline__ const float* cvt_src(const CvtJob& j, int k, int n, float& sc) {
    sc = 1.f;
    if (j.kind == 0) return j.s0 + (size_t)k * j.lds_ + n;
    if (j.kind == 1) { if (n < 1184) return j.s0 + (size_t)k * j.lds_ + n; if (n >= 1280) return j.s0 + (size_t)k * j.lds_ + n - 96; return nullptr; }
    if (j.kind == 2) { const int tl = n >> 8, jj = n & 255; return (jj < 128 ? j.s0 : j.s1) + (size_t)k * j.lds_ + tl * 128 + (jj & 127); }
    if (n < 384 && k < 256) { sc = j.scale[k]; return j.s0 + (size_t)k * 384 + n; }
    if (n >= 512 && k >= 256) { sc = j.scale2[k - 256]; return j.s1 + (size_t)(k - 256) * 512 + (n - 512); }
    return nullptr;
}
__device__ __forceinline__ void cvt_wave_store(const float4 (&v)[16], bool f8, void* dst, int ldd, int n0, int k0, unsigned char* T, int lane) {
    const int kq = lane >> 4, nc = (lane & 15) * 4;
    if (f8) {
#pragma unroll
        for (int i = 0; i < 4; ++i) { const int kb = 16 * i + 4 * kq;
            *(unsigned*)(T + (nc + 0) * 68 + kb) = fp8x4(v[4 * i].x, v[4 * i + 1].x, v[4 * i + 2].x, v[4 * i + 3].x);
            *(unsigned*)(T + (nc + 1) * 68 + kb) = fp8x4(v[4 * i].y, v[4 * i + 1].y, v[4 * i + 2].y, v[4 * i + 3].y);
            *(unsigned*)(T + (nc + 2) * 68 + kb) = fp8x4(v[4 * i].z, v[4 * i + 1].z, v[4 * i + 2].z, v[4 * i + 3].z);
            *(unsigned*)(T + (nc + 3) * 68 + kb) = fp8x4(v[4 * i].w, v[4 * i + 1].w, v[4 * i + 2].w, v[4 * i + 3].w); }
        asm volatile("s_waitcnt lgkmcnt(0)" ::: "memory");
#pragma unroll
        for (int r = 0; r < 8; ++r) { const int n = r * 8 + (lane >> 3), kc = (lane & 7) * 8; uint2 w; w.x = *(const unsigned*)(T + n * 68 + kc); w.y = *(const unsigned*)(T + n * 68 + kc + 4);
            *(uint2*)((unsigned char*)dst + (size_t)(n0 + n) * ldd + k0 + kc) = w; }
    } else {
#pragma unroll
        for (int i = 0; i < 4; ++i) { const int kb = (16 * i + 4 * kq) * 2;
            *(unsigned*)(T + (nc + 0) * 132 + kb) = pg8::cvt_pk_bf16(v[4 * i].x, v[4 * i + 1].x); *(unsigned*)(T + (nc + 0) * 132 + kb + 4) = pg8::cvt_pk_bf16(v[4 * i + 2].x, v[4 * i + 3].x);
            *(unsigned*)(T + (nc + 1) * 132 + kb) = pg8::cvt_pk_bf16(v[4 * i].y, v[4 * i + 1].y); *(unsigned*)(T + (nc + 1) * 132 + kb + 4) = pg8::cvt_pk_bf16(v[4 * i + 2].y, v[4 * i + 3].y);
            *(unsigned*)(T + (nc + 2) * 132 + kb) = pg8::cvt_pk_bf16(v[4 * i].z, v[4 * i + 1].z); *(unsigned*)(T + (nc + 2) * 132 + kb + 4) = pg8::cvt_pk_bf16(v[4 * i + 2].z, v[4 * i + 3].z);
            *(unsigned*)(T + (nc + 3) * 132 + kb) = pg8::cvt_pk_bf16(v[4 * i].w, v[4 * i + 1].w); *(unsigned*)(T + (nc + 3) * 132 + kb + 4) = pg8::cvt_pk_bf16(v[4 * i + 2].w, v[4 * i + 3].w); }
        asm volatile("s_waitcnt lgkmcnt(0)" ::: "memory");
#pragma unroll
        for (int r = 0; r < 8; ++r) { const int n = r * 8 + (lane >> 3), kc = (lane & 7) * 16; uint4 w;
            w.x = *(const unsigned*)(T + n * 132 + kc); w.y = *(const unsigned*)(T + n * 132 + kc + 4); w.z = *(const unsigned*)(T + n * 132 + kc + 8); w.w = *(const unsigned*)(T + n * 132 + kc + 12);
            *(uint4*)((bf16_t*)dst + (size_t)(n0 + n) * ldd + k0 + (lane & 7) * 8) = w; }
    }
    asm volatile("s_waitcnt lgkmcnt(0)" ::: "memory");
}
__device__ __forceinline__ void cvt_wave_tile(const CvtJob& j, int n0, int k0, unsigned char* T  , int lane) {
    const int kq = lane >> 4, nc = (lane & 15) * 4;
    float4 v[16]; float sc[16];
#pragma unroll
    for (int q = 0; q < 16; ++q) { const float* src = cvt_src(j, k0 + 16 * (q >> 2) + 4 * kq + (q & 3), n0 + nc, sc[q]); v[q] = src ? *(const float4*)src : make_float4(0.f, 0.f, 0.f, 0.f); }
#pragma unroll
    for (int q = 0; q < 16; ++q) { const float s_ = j.f8 ? WSCALE : sc[q]; v[q].x *= s_; v[q].y *= s_; v[q].z *= s_; v[q].w *= s_; }
    cvt_wave_store(v, j.f8, j.dst, j.ldd, n0, k0, T, lane);
}
typedef __attribute__((address_space(3))) unsigned char lds_t;
__device__ __forceinline__ float silu_fast(float x) { return x * __builtin_amdgcn_rcpf(1.f + __expf(-x)); }

__device__ __forceinline__ void cvt_decode(const Params& p, int ti, CvtJob& j, int& n0, int& k0) {
    constexpr int T_IN = 448, T_UP = 96, T_GU = 1792, T_D = 896;
    int idx = ti, kt; j = CvtJob{};
    if (idx < 2 * T_IN) { const int l = idx / T_IN; idx %= T_IN; j.dst = WP(W_IN) + (size_t)l * 1792 * 1024; j.ldd = 1024; j.s0 = p.w_in + (size_t)l * 1024 * DIN; j.lds_ = DIN; j.kind = 1; kt = 16; }
    else if ((idx -= 2 * T_IN) < 2 * T_UP) { const int l = idx / T_UP; idx %= T_UP; j.dst = WP(W_UP) + (size_t)l * 1024 * 384; j.ldd = 384; j.s0 = p.mla_w_uq + (size_t)l * 256 * 384; j.s1 = p.mla_w_ukv + (size_t)l * 128 * 512;
        j.scale = p.mla_g_q + l * 256; j.scale2 = p.mla_g_kv + l * 128; j.kind = 3; kt = 6; }
    else if ((idx -= 2 * T_UP) < T_GU) { j.dst = WP(W_GU); j.ldd = 1024; j.s0 = p.ffn_w_gate; j.s1 = p.ffn_w_up; j.lds_ = DFF; j.kind = 2; j.f8 = (DENSE_FP8 == 1); kt = 16; }
    else if ((idx -= T_GU) < T_D) { j.dst = WP(W_D); j.ldd = DFF; j.s0 = p.ffn_w_down; j.lds_ = 1024; j.kind = 0; j.f8 = (DENSE_FP8 != 0); kt = 56; }
    else if ((idx -= T_D) < 8 * T_GU) { const int e = idx / T_GU; idx %= T_GU; j.dst = (bf16_t*)(p.ws + OFF_W + W_MGU + (size_t)e * 7168 * 1024); j.ldd = 1024; j.s0 = p.moe_w_gate + (size_t)e * 1024 * DFF; j.s1 = p.moe_w_up + (size_t)e * 1024 * DFF; j.lds_ = DFF; j.kind = 2; j.f8 = true; kt = 16; }
    else { idx -= 8 * T_GU; const int e = idx / T_D; idx %= T_D; j.dst = (bf16_t*)(p.ws + OFF_W + W_MD + (size_t)e * 1024 * DFF); j.ldd = DFF; j.s0 = p.moe_w_down + (size_t)e * DFF * 1024; j.lds_ = 1024; j.kind = 0; j.f8 = true; kt = 56; }
    const int ntn = j.kind == 1 ? 28 : (j.kind == 3 ? 16 : (j.kind == 2 ? 112 : 16)); (void)kt;
    n0 = (idx % ntn) * 64; k0 = (idx / ntn) * 64;
}
constexpr int CVT_TOT = 2 * 448 + 2 * 96 + 1792 + 896 + 8 * (1792 + 896), CVT_MOE0 = 2 * 448 + 2 * 96 + 1792 + 896;
__device__ __forceinline__ void phase_cvt(const Params& p, lds_t* lds, int begin, int end, int wb, int nwb) {
    const int t = tid_(p.wv), lane = t & 63;
    unsigned char* T = (unsigned char*)lds + p.wv * 9216;
    for (int ti = begin + wb * 8 + p.wv; ti < end; ti += nwb * 8) { CvtJob j; int n0, k0; cvt_decode(p, ti, j, n0, k0); cvt_wave_tile(j, n0, k0, T, lane); }
    __syncthreads();
}
__device__ __forceinline__ void cvt_in_tail(const Params& p, lds_t* lds, int nunits, int begin, int end) {
    const int G = gridDim.x, c = bid_(), heavy = nunits % G;
    if (G != 256 || heavy == 0 || c < heavy) return;
    phase_cvt(p, lds, CVT_MOE0 + begin, CVT_MOE0 + end, c - heavy, G - heavy);
}

struct SchedDense : pg8::OrderBase {
    const char *A, *B; size_t ta, tb;
    __device__ const char* a_base(const pg8::Unit& u) const { return A + (size_t)u.pm * ta; }
    __device__ const char* b_base(const pg8::Unit& u) const { return B + (size_t)u.pn * tb; }
    __device__ int row(const pg8::Unit&, int) const { return 0; }
};
struct SchedMoE : pg8::OrderBase {
    const char *A, *B; size_t ta, tb, te; int t0; const int* tile_e; const int* rowidx;
    __device__ const char* a_base(const pg8::Unit& u) const { return A + (size_t)u.pm * ta; }
    __device__ const char* b_base(const pg8::Unit& u) const { return B + (size_t)__builtin_amdgcn_readfirstlane(ld_i(tile_e + t0 + u.pm)) * te + (size_t)u.pn * tb; }
    __device__ int row(const pg8::Unit& u, int r) const { return rowidx[(t0 + u.pm) * 256 + r]; }
};
struct EpiSwiGLU {
    static constexpr bool PERM = true;
    bf16_t* H;
    __device__ __forceinline__ void operator()(const pg8::f32x4 (&acc)[2][2][4][2], const pg8::Unit& u, int wr, int wc, int fr, int fq) const {
#pragma unroll
        for (int ai = 0; ai < 2; ++ai)
#pragma unroll
            for (int m = 0; m < 4; ++m) {
                const int row = u.pm * 256 + ai * 128 + wr * 64 + m * 16 + fr;
                const pg8::f32x4 g0 = acc[ai][0][m][0], g1 = acc[ai][0][m][1], u0 = acc[ai][1][m][0], u1 = acc[ai][1][m][1];
                pg8::u32x4 w;
                w.x = pg8::cvt_pk_bf16(silu_fast(g0[0]) * u0[0], silu_fast(g0[1]) * u0[1]); w.y = pg8::cvt_pk_bf16(silu_fast(g0[2]) * u0[2], silu_fast(g0[3]) * u0[3]);
                w.z = pg8::cvt_pk_bf16(silu_fast(g1[0]) * u1[0], silu_fast(g1[1]) * u1[1]); w.w = pg8::cvt_pk_bf16(silu_fast(g1[2]) * u1[2], silu_fast(g1[3]) * u1[3]);
                *(pg8::u32x4*)(H + (size_t)row * DFF + u.pn * 128 + wc * 32 + 8 * fq) = w;
            }
    }
};
template <bool WS = true> struct EpiSwiGLU8T {
    static constexpr bool PERM = true;
    unsigned char* H;
    __device__ __forceinline__ void operator()(const pg8::f32x4 (&acc)[2][2][4][2], const pg8::Unit& u, int wr, int wc, int fr, int fq) const {
        constexpr float IS = WS ? 1.f / WSCALE : 1.f;
#pragma unroll
        for (int ai = 0; ai < 2; ++ai)
#pragma unroll
            for (int m = 0; m < 4; ++m) {
                const int row = u.pm * 256 + ai * 128 + wr * 64 + m * 16 + fr;
                const pg8::f32x4 g0 = acc[ai][0][m][0] * IS, g1 = acc[ai][0][m][1] * IS, u0 = acc[ai][1][m][0] * (IS * HSCALE), u1 = acc[ai][1][m][1] * (IS * HSCALE);
                pg8::u32x2 w;
                w.x = fp8x4(clamp448(silu_fast(g0[0]) * u0[0]), clamp448(silu_fast(g0[1]) * u0[1]), clamp448(silu_fast(g0[2]) * u0[2]), clamp448(silu_fast(g0[3]) * u0[3]));
                w.y = fp8x4(clamp448(silu_fast(g1[0]) * u1[0]), clamp448(silu_fast(g1[1]) * u1[1]), clamp448(silu_fast(g1[2]) * u1[2]), clamp448(silu_fast(g1[3]) * u1[3]));
                *(pg8::u32x2*)(H + (size_t)row * DFF + u.pn * 128 + wc * 32 + 8 * fq) = w;
            }
    }
};
typedef EpiSwiGLU8T<true> EpiSwiGLU8;
template <bool MOE, bool SCALED = MOE> struct EpiRowsBf16 {
    static constexpr bool PERM = true;
    Params p; bf16_t* O; int t0;
    __device__ __forceinline__ void operator()(const pg8::f32x4 (&acc)[2][2][4][2], const pg8::Unit& u, int wr, int wc, int fr, int fq) const {
#pragma unroll
        for (int ai = 0; ai < 2; ++ai)
#pragma unroll
            for (int m = 0; m < 4; ++m) {
                const int row = u.pm * 256 + ai * 128 + wr * 64 + m * 16 + fr;
                bf16_t* rp = MOE ? ys_row(p, t0 * 256 + row) : O + (size_t)row * 1024;
#pragma unroll
                for (int bj = 0; bj < 2; ++bj) { constexpr float SC = SCALED ? 1.f / (WSCALE * HSCALE) : 1.f; const pg8::f32x4 v0 = acc[ai][bj][m][0] * SC, v1 = acc[ai][bj][m][1] * SC; pg8::u32x4 w;
                    w.x = pg8::cvt_pk_bf16(v0[0], v0[1]); w.y = pg8::cvt_pk_bf16(v0[2], v0[3]); w.z = pg8::cvt_pk_bf16(v1[0], v1[1]); w.w = pg8::cvt_pk_bf16(v1[2], v1[3]);
                    *(pg8::u32x4*)(rp + u.pn * 256 + bj * 128 + wc * 32 + 8 * fq) = w; }
            }
    }
};
__device__ __forceinline__ void phase_ffn_gu_dense(const Params& p, lds_t* lds) {
#if DENSE_FP8 == 1
    SchedDense S; S.init(RR / 256, 28, gridDim.x, bid_()); S.A = (const char*)WSP(bf16_t, OFF_XN); S.B = (const char*)WP(W_GU); S.ta = (size_t)256 * 1024; S.tb = (size_t)256 * 1024;
    EpiSwiGLU8 E{(unsigned char*)SP(bf16_t, S_H)};
    pg8::gemm_phase<EpiSwiGLU8, SchedDense, false, true>(lds, pg8::Gemm{512, 512, 512, p.wv}, S, E);
#elif DENSE_FP8 == 2
    SchedDense S; S.init(RR / 256, 28, gridDim.x, bid_()); S.A = (const char*)WSP(bf16_t, OFF_XN); S.B = (const char*)WP(W_GU); S.ta = (size_t)256 * 1024 * 2; S.tb = (size_t)256 * 1024 * 2;
    EpiSwiGLU8T<false> E{(unsigned char*)SP(bf16_t, S_H)};
    pg8::gemm_phase<EpiSwiGLU8T<false>, SchedDense, false>(lds, pg8::Gemm{1024, 1024, 1024, p.wv}, S, E);
#else
    SchedDense S; S.init(RR / 256, 28, gridDim.x, bid_()); S.A = (const char*)WSP(bf16_t, OFF_XN); S.B = (const char*)WP(W_GU); S.ta = (size_t)256 * 1024 * 2; S.tb = (size_t)256 * 1024 * 2;
    EpiSwiGLU E{SP(bf16_t, S_H)};
    pg8::gemm_phase<EpiSwiGLU, SchedDense, false>(lds, pg8::Gemm{1024, 1024, 1024, p.wv}, S, E);
#endif
}
__device__ __forceinline__ void phase_ffn_dn_dense(const Params& p, lds_t* lds) {
#if DENSE_FP8
    SchedDense S; S.init(RR / 256, 4, gridDim.x, bid_()); S.A = (const char*)SP(bf16_t, S_H); S.B = (const char*)WP(W_D); S.ta = (size_t)256 * DFF; S.tb = (size_t)256 * DFF;
    EpiRowsBf16<false, true> E{p, WSP(bf16_t, OFF_XN), 0};
    pg8::gemm_phase<EpiRowsBf16<false, true>, SchedDense, false, true>(lds, pg8::Gemm{DFF / 2, DFF / 2, DFF / 2, p.wv}, S, E);
#else
    SchedDense S; S.init(RR / 256, 4, gridDim.x, bid_()); S.A = (const char*)SP(bf16_t, S_H); S.B = (const char*)WP(W_D); S.ta = (size_t)256 * DFF * 2; S.tb = (size_t)256 * DFF * 2;
    EpiRowsBf16<false> E{p, WSP(bf16_t, OFF_XN), 0};
    pg8::gemm_phase<EpiRowsBf16<false>, SchedDense, false>(lds, pg8::Gemm{DFF, DFF, DFF, p.wv}, S, E);
#endif
}
__device__ __forceinline__ void phase_moe_gu(const Params& p, lds_t* lds) {
    const int NT = ld_i((const int*)p.ws + CW_NT);
    SchedMoE S; S.init(NT, 28, gridDim.x, bid_()); S.A = (const char*)SP(bf16_t, S_YS); S.B = (const char*)(p.ws + OFF_W + W_MGU); S.ta = (size_t)256 * 1024; S.tb = (size_t)256 * 1024; S.te = (size_t)7168 * 1024;
    S.t0 = 0; S.tile_e = WSP(int, OFF_TILEE); S.rowidx = WSP(int, OFF_ROWIDX);
    EpiSwiGLU8 E{(unsigned char*)SP(bf16_t, S_H)};
    pg8::gemm_phase<EpiSwiGLU8, SchedMoE, false, true>(lds, pg8::Gemm{512, 512, 512, p.wv}, S, E);
}
__device__ __forceinline__ void phase_moe_dn(const Params& p, lds_t* lds) {
    const int NT = ld_i((const int*)p.ws + CW_NT);
    SchedMoE S; S.init(NT, 4, gridDim.x, bid_()); S.A = (const char*)SP(bf16_t, S_H); S.B = (const char*)(p.ws + OFF_W + W_MD); S.ta = (size_t)256 * DFF; S.tb = (size_t)256 * DFF; S.te = (size_t)1024 * DFF;
    S.t0 = 0; S.tile_e = WSP(int, OFF_TILEE); S.rowidx = WSP(int, OFF_ROWIDX);
    EpiRowsBf16<true> E{p, nullptr, 0};
    pg8::gemm_phase<EpiRowsBf16<true>, SchedMoE, false, true>(lds, pg8::Gemm{DFF / 2, DFF / 2, DFF / 2, p.wv}, S, E);
}

typedef float f32x2 __attribute__((ext_vector_type(2)));
__device__ __forceinline__ f32x2 gelu_pk(f32x2 v) {
    const f32x2 av = __builtin_elementwise_abs(v), d = av * 0.2316418882f + 1.0f;
    f32x2 t; t.x = __builtin_amdgcn_rcpf(d.x); t.y = __builtin_amdgcn_rcpf(d.y);
    f32x2 q = t * 0.5307027145f + (-0.7265760135f); q = q * t + 0.7107068705f; q = q * t + (-0.142248368f); q = q * t + 0.127414796f; q = q * t;
    const f32x2 s = (v * v) * (-0.72134752044f);
    f32x2 e; e.x = __builtin_amdgcn_exp2f(s.x); e.y = __builtin_amdgcn_exp2f(s.y);
    const f32x2 m = v * (q * e), r = v - m;
    f32x2 o; o.x = v.x < 0.f ? m.x : r.x; o.y = v.y < 0.f ? m.y : r.y; return o;
}
__device__ __forceinline__ pg8::u32x4 pack8(const float* v) { pg8::u32x4 w; w.x = pg8::cvt_pk_bf16(v[0], v[1]); w.y = pg8::cvt_pk_bf16(v[2], v[3]); w.z = pg8::cvt_pk_bf16(v[4], v[5]); w.w = pg8::cvt_pk_bf16(v[6], v[7]); return w; }
__device__ __forceinline__ void rope8(float* v, const float2* cs) {
    const float4 a = *(const float4*)cs, b = *(const float4*)(cs + 2);
    const float c[4] = {a.x, a.z, b.x, b.z}, sn[4] = {a.y, a.w, b.y, b.w};
#pragma unroll
    for (int q = 0; q < 4; ++q) { const float x1 = v[2 * q], x2 = v[2 * q + 1]; v[2 * q] = x1 * c[q] - x2 * sn[q]; v[2 * q + 1] = x1 * sn[q] + x2 * c[q]; }
}
__device__ __forceinline__ const float2* rope_ptr(const float2* tab, int nf, int pos, int pi0) { const int co = pi0 < nf ? (pos >> 6) : (pos & 63); return tab + co * nf + (pi0 < nf ? pi0 : pi0 - nf); }

__device__ __forceinline__ void rope8r(float* v, const float4 a, const float4 b) {
    const float c[4] = {a.x, a.z, b.x, b.z}, sn[4] = {a.y, a.w, b.y, b.w};
#pragma unroll
    for (int q = 0; q < 4; ++q) { const float x1 = v[2 * q], x2 = v[2 * q + 1]; v[2 * q] = x1 * c[q] - x2 * sn[q]; v[2 * q + 1] = x1 * sn[q] + x2 * c[q]; }
}
struct EpiInProj {
    static constexpr bool PERM = true;
    Params p;
    __device__ __forceinline__ void operator()(const pg8::f32x4 (&acc)[2][2][4][2], const pg8::Unit& u, int wr, int wc, int fr, int fq) const {
        const int pn = u.pn;
        const bool lat_t = u.pm < TL / 256, roped = lat_t && (pn == 1 || pn == 2 || (pn == 4 && wc == 0));
        const int nf = pn == 4 ? 8 : 16, pb = pn == 4 ? 4 * fq : (wc & 1) * 16 + 4 * fq; const bool rowt = pb < nf;
        float4 ra[4], rb[4];
#pragma unroll
        for (int q = 0; q < 4; ++q) { ra[q] = make_float4(1.f, 0.f, 1.f, 0.f); rb[q] = ra[q]; }
        if (roped) { const float2* tab = pn == 4 ? WSP(float2, OFF_ROPEM) : WSP(float2, OFF_ROPEW);
#pragma unroll
            for (int q = 0; q < 4; ++q) { const int coord = rowt ? ((u.pm * 4 + (q & 1) * 2 + wr) & 127) : (q * 16 + fr); const float2* t = tab + coord * nf + (rowt ? pb : pb - nf);
                ra[q] = *(const float4*)t; rb[q] = *(const float4*)(t + 2); } }
#pragma unroll
        for (int ai = 0; ai < 2; ++ai)
#pragma unroll
            for (int m = 0; m < 4; ++m) {
                const int r = u.pm * 256 + ai * 128 + wr * 64 + m * 16 + fr;
                const int bb = row_batch(r), key = row_key(r);
                const float4 ca = rowt ? ra[ai] : ra[m], cb = rowt ? rb[ai] : rb[m];
                float s1 = 0.f, s2 = 0.f;
#pragma unroll
                for (int bj = 0; bj < 2; ++bj) {
                    const int c0 = bj * 128 + wc * 32 + 8 * fq;
                    float v[8];
#pragma unroll
                    for (int e = 0; e < 4; ++e) { v[e] = acc[ai][bj][m][0][e]; v[4 + e] = acc[ai][bj][m][1][e]; }
                    if (pn == 0) { *(pg8::u32x4*)(SP(bf16_t, S_ABUF) + (size_t)r * 256 + c0) = pack8(v); }
                    else if (pn == 1) { rope8r(v, ca, cb);
#pragma unroll
                        for (int e = 0; e < 8; ++e) v[e] *= 0.125f;
                        *(pg8::u32x4*)(SP(bf16_t, S_QW) + (size_t)r * 256 + c0) = pack8(v); }
                    else if (pn == 2) {
                        if (bj == 0) { rope8r(v, ca, cb); *(pg8::u32x4*)(SP(bf16_t, S_KW) + ((size_t)bb * NKEY + key) * 128 + c0) = pack8(v); }
                        else *(pg8::u32x4*)(SP(bf16_t, S_VW) + ((size_t)bb * NKEY + key) * 128 + (c0 - 128)) = pack8(v); }
                    else if (pn == 3) {
#pragma unroll
                        for (int e = 0; e < 8; ++e) s2 += v[e] * v[e];
                        *(pg8::u32x4*)(SP(bf16_t, S_C2) + (size_t)r * 384 + c0) = pack8(v); }
                    else if (pn == 4) {
                        if (bj == 0) {
#pragma unroll
                            for (int e = 0; e < 8; ++e) s2 += v[e] * v[e];
                            *(pg8::u32x4*)(SP(bf16_t, S_C2) + (size_t)r * 384 + 256 + c0) = pack8(v); }
                        else if (wc == 0) { rope8r(v, ca, cb); const pg8::u32x4 w = pack8(v);
#pragma unroll
                            for (int h = 0; h < 4; ++h) *(pg8::u32x4*)(SP(bf16_t, S_KM) + (((size_t)bb * 4 + h) * NKEY + key) * 96 + 64 + 8 * fq) = w; } }
                    else {
#pragma unroll
                        for (int e = 0; e < 8; e += 2) { const f32x2 gq = gelu_pk((f32x2){v[e], v[e + 1]}); v[e] = gq.x; v[e + 1] = gq.y; }
                        if (pn == 6) {
#pragma unroll
                            for (int e = 0; e < 8; ++e) { s1 += v[e]; s2 += v[e] * v[e]; } }
                        *(pg8::u32x4*)(SP(bf16_t, pn == 5 ? S_U : S_VG) + (size_t)r * 256 + c0) = pack8(v); }
                }
                if (pn == 3 || pn == 4 || pn == 6) {
                    { const int l4_ = lane_() << 2; s1 += __int_as_float(__builtin_amdgcn_ds_bpermute(l4_ ^ 64, __float_as_int(s1))); s1 += __int_as_float(__builtin_amdgcn_ds_bpermute(l4_ ^ 128, __float_as_int(s1))); s2 += __int_as_float(__builtin_amdgcn_ds_bpermute(l4_ ^ 64, __float_as_int(s2))); s2 += __int_as_float(__builtin_amdgcn_ds_bpermute(l4_ ^ 128, __float_as_int(s2))); }
                    if (fq == 0) { if (pn == 3) WSP(float, OFF_SSQQ)[(size_t)r * 4 + wc] = s2; else if (pn == 4) WSP(float, OFF_SSQKV)[(size_t)r * 4 + wc] = s2;
                        else { WSP(float, OFF_LNS)[(size_t)r * 8 + wc * 2] = s1; WSP(float, OFF_LNS)[(size_t)r * 8 + wc * 2 + 1] = s2; } }
                }
            }
    }
};
template <int KV> struct EpiUp {
    static constexpr bool PERM = true;
    Params p;
    __device__ __forceinline__ void operator()(const pg8::f32x4 (&acc)[2][2][4][2], const pg8::Unit& u, int wr, int wc, int fr, int fq) const {
        const int pn = u.pn;
        float rs8[8];
#pragma unroll
        for (int q = 0; q < 8; ++q) { const int r = u.pm * 256 + (q >> 2) * 128 + wr * 64 + (q & 3) * 16 + fr; const float4 sq4 = *(const float4*)(WSP(float, KV ? OFF_SSQKV : OFF_SSQQ) + (size_t)r * 4);
            rs8[q] = rsqrtf(((sq4.x + sq4.y) + (sq4.z + sq4.w)) * (KV ? 1.f / 128.f : 1.f / 256.f) + EPS) * (KV ? 1.f : 0.10206207261596575f); }
#pragma unroll
        for (int ai = 0; ai < 2; ++ai)
#pragma unroll
            for (int m = 0; m < 4; ++m) {
                const int r = u.pm * 256 + ai * 128 + wr * 64 + m * 16 + fr;
                const bool lat = r < TL; const int pos = r & 8191, bb = row_batch(r), key = row_key(r);
                const float rs = rs8[ai * 4 + m];
#pragma unroll
                for (int bj = 0; bj < 2; ++bj) {
                    const int c0 = bj * 128 + wc * 32 + 8 * fq, n = pn * 256 + c0;
                    float v[8];
#pragma unroll
                    for (int e = 0; e < 4; ++e) { v[e] = acc[ai][bj][m][0][e] * rs; v[4 + e] = acc[ai][bj][m][1][e] * rs; }
                    if (!KV) { if (n < 384) { const int i = n % 96;
                            if (i >= 64 && lat) rope8(v, rope_ptr(WSP(float2, OFF_ROPEM), 8, pos, (i - 64) >> 1));
                            *(pg8::u32x4*)(SP(bf16_t, S_QM) + (size_t)r * 384 + n) = pack8(v); } }
                    else { const int h = n >> 7, j0 = n & 127;
                        if (j0 < 64) *(pg8::u32x4*)(SP(bf16_t, S_KM) + (((size_t)bb * 4 + h) * NKEY + key) * 96 + j0) = pack8(v);
                        else *(pg8::u32x4*)(SP(bf16_t, S_VM) + (((size_t)bb * 4 + h) * NKEY + key) * 64 + (j0 - 64)) = pack8(v); }
                }
            }
    }
};
__device__ __forceinline__ void phase_inproj(const Params& p, lds_t* lds, int l) {
    SchedDense S; S.init(RR / 256, 7, gridDim.x, bid_()); S.A = (const char*)WSP(bf16_t, OFF_XN); S.B = (const char*)(WP(W_IN) + (size_t)l * 1792 * 1024); S.ta = (size_t)256 * 1024 * 2; S.tb = (size_t)256 * 1024 * 2;
    EpiInProj E{p};
    pg8::gemm_phase<EpiInProj, SchedDense, false>(lds, pg8::Gemm{1024, 1024, 1024, p.wv}, S, E);
}
__device__ __forceinline__ void phase_up(const Params& p, lds_t* lds, int l) {
    { SchedDense S; S.init(RR / 256, 2, gridDim.x, bid_()); S.A = (const char*)SP(bf16_t, S_C2); S.B = (const char*)(WP(W_UP) + (size_t)l * 1024 * 384); S.ta = (size_t)256 * 384 * 2; S.tb = (size_t)256 * 384 * 2;
      EpiUp<0> E{p}; pg8::gemm_phase<EpiUp<0>, SchedDense, false>(lds, pg8::Gemm{384, 384, 256, p.wv}, S, E); }
    { SchedDense S; S.init(RR / 256, 2, gridDim.x, (int)gridDim.x - 1 - bid_()); S.A = (const char*)(SP(bf16_t, S_C2) + 256); S.B = (const char*)(WP(W_UP) + (size_t)l * 1024 * 384 + (size_t)512 * 384 + 256); S.ta = (size_t)256 * 384 * 2; S.tb = (size_t)256 * 384 * 2;
      EpiUp<1> E{p}; pg8::gemm_phase<EpiUp<1>, SchedDense, false>(lds, pg8::Gemm{384, 384, 128, p.wv}, S, E); }
}
__device__ __forceinline__ void phase_outproj(const Params& p, lds_t* lds, int l) {
    SchedDense S; S.init(l == 0 ? RR / 256 : TL / 256, 4, gridDim.x, bid_()); S.A = (const char*)SP(bf16_t, S_CAT); S.B = (const char*)(WP(W_O) + (size_t)l * 1024 * 1280); S.ta = (size_t)256 * 1280 * 2; S.tb = (size_t)256 * 1280 * 2;
    EpiRowsBf16<false> E{p, SP(bf16_t, S_MX), 0};
    pg8::gemm_phase<EpiRowsBf16<false>, SchedDense, false>(lds, pg8::Gemm{1280, 1280, 1280, p.wv}, S, E);
}


namespace att {
using bf16x8 = __attribute__((ext_vector_type(8))) short;
using s16x4 = __attribute__((ext_vector_type(4))) short;
using f32x16 = __attribute__((ext_vector_type(16))) float;
using u32x4 = __attribute__((ext_vector_type(4))) unsigned;
#define KSWZ(row, colB) ((row) * 256 + ((colB) ^ (((row) & 15) << 4)))
#define SBAR() __builtin_amdgcn_sched_barrier(0)
constexpr float THR = 8.f, LOG2E = 1.4426950408889634f;
constexpr int SHM_K = 64 * 256, SHM_V = 64 * 64 * 2;
constexpr int NBUF = 3;
constexpr int ATT_LDS = NBUF * SHM_K + NBUF * SHM_V + 8 * 64 * 4;
__device__ __forceinline__ int crow(int r, int hi) { return (r & 3) + 8 * (r >> 2) + 4 * hi; }
__device__ __forceinline__ unsigned cvtpk(float lo, float hi) { unsigned r; asm volatile("v_cvt_pk_bf16_f32 %0, %1, %2" : "=v"(r) : "v"(lo), "v"(hi)); return r; }
__device__ __forceinline__ void partialSM(f32x16& p0, f32x16& p1, float& m_reg, float& mn, float& alpha) {
    float pmax = p0[0];
#pragma unroll
    for (int r = 1; r < 16; ++r) pmax = fmaxf(pmax, p0[r]);
#pragma unroll
    for (int r = 0; r < 16; ++r) pmax = fmaxf(pmax, p1[r]);
    { auto rr = __builtin_amdgcn_permlane32_swap(__float_as_uint(pmax), __float_as_uint(pmax), false, false); pmax = fmaxf(__uint_as_float(rr[0]), __uint_as_float(rr[1])); }
    if (__builtin_expect(__all(pmax - m_reg <= THR), 1)) { mn = m_reg; alpha = 1.f; }
    else { mn = fmaxf(m_reg, pmax); alpha = __builtin_amdgcn_exp2f((m_reg - mn) * LOG2E); m_reg = mn; }
    const float mnC = -mn * LOG2E;
#pragma unroll
    for (int r = 0; r < 16; ++r) p0[r] = fmaf(p0[r], LOG2E, mnC);
#pragma unroll
    for (int r = 0; r < 16; ++r) p1[r] = fmaf(p1[r], LOG2E, mnC);
#pragma unroll
    for (int r = 0; r < 16; ++r) p0[r] = __builtin_amdgcn_exp2f(p0[r]);
}
__device__ __forceinline__ void finishSM(f32x16& p0, f32x16& p1, bf16x8& pa0, bf16x8& pa1, bf16x8& pa2, bf16x8& pa3) {
#pragma unroll
    for (int r = 0; r < 16; ++r) p1[r] = __builtin_amdgcn_exp2f(p1[r]);
#define PK4(P, BASE, OUT) do { u32x4 w = {cvtpk(P[BASE + 0], P[BASE + 1]), cvtpk(P[BASE + 2], P[BASE + 3]), cvtpk(P[BASE + 4], P[BASE + 5]), cvtpk(P[BASE + 6], P[BASE + 7])}; OUT = *reinterpret_cast<bf16x8*>(&w); } while (0)
    PK4(p0, 0, pa0); PK4(p0, 8, pa1); PK4(p1, 0, pa2); PK4(p1, 8, pa3);
#undef PK4
}
template <int DQK>
__device__ __forceinline__ void qkt(f32x16& p0, f32x16& p1, const char* Ks, const bf16x8* qr, int r32, int hi) {
    p0 = f32x16{}; p1 = f32x16{};
#pragma unroll
    for (int d0 = 0; d0 < DQK / 16; ++d0) { const int cb = (d0 * 16 + hi * 8) * 2;
        const bf16x8 b0 = *reinterpret_cast<const bf16x8*>(Ks + KSWZ(r32, cb));
        const bf16x8 b1 = *reinterpret_cast<const bf16x8*>(Ks + KSWZ(32 + r32, cb));
        p0 = __builtin_amdgcn_mfma_f32_32x32x16_bf16(b0, qr[d0], p0, 0, 0, 0);
        p1 = __builtin_amdgcn_mfma_f32_32x32x16_bf16(b1, qr[d0], p1, 0, 0, 0); }
}
__device__ __forceinline__ void maskband(f32x16& p0, f32x16& p1, int kp0, int qp, int hi) {
#pragma unroll
    for (int r = 0; r < 16; ++r) { const int d0 = kp0 + crow(r, hi) - qp; if (d0 > 128 || d0 < -128) p0[r] = -1e30f; const int d1 = d0 + 32; if (d1 > 128 || d1 < -128) p1[r] = -1e30f; }
}
__device__ __forceinline__ int v_st(int k, int c) { const int kk = k; return ((kk >> 3) * 2 + (c >> 5)) * 512 + ((kk & 7) * 32 + (c & 31)) * 2; }
__device__ __forceinline__ int v_rd_base(int lane) { return ((lane & 3) << 3) | (((lane >> 2) & 3) << 6) | (((lane >> 4) & 1) << 5) | (((lane >> 5) & 1) << 8); }
constexpr int v_rd_off(int d0, int ks, int half) { return d0 * 512 + ks * 2048 + half * 1024; }
template <int OFF> __device__ __forceinline__ s16x4 tr_read(int vb) { s16x4 r; asm volatile("ds_read_b64_tr_b16 %0, %1 offset:%2" : "=&v"(r) : "v"(vb), "i"(OFF) : "memory"); return r; }
template <int D0> __device__ __forceinline__ void pv_one(f32x16& od, int vb, bf16x8 pa0, bf16x8 pa1, bf16x8 pa2, bf16x8 pa3) {
    const s16x4 l0 = tr_read<v_rd_off(D0, 0, 0)>(vb), h0 = tr_read<v_rd_off(D0, 0, 1)>(vb), l1 = tr_read<v_rd_off(D0, 1, 0)>(vb), h1 = tr_read<v_rd_off(D0, 1, 1)>(vb);
    const s16x4 l2 = tr_read<v_rd_off(D0, 2, 0)>(vb), h2 = tr_read<v_rd_off(D0, 2, 1)>(vb), l3 = tr_read<v_rd_off(D0, 3, 0)>(vb), h3 = tr_read<v_rd_off(D0, 3, 1)>(vb);
    asm volatile("s_waitcnt lgkmcnt(0)" ::: "memory"); SBAR();
#define PK(L, H) (bf16x8){L[0], L[1], L[2], L[3], H[0], H[1], H[2], H[3]}
    od = __builtin_amdgcn_mfma_f32_32x32x16_bf16(pa0, PK(l0, h0), od, 0, 0, 0);
    od = __builtin_amdgcn_mfma_f32_32x32x16_bf16(pa1, PK(l1, h1), od, 0, 0, 0);
    od = __builtin_amdgcn_mfma_f32_32x32x16_bf16(pa2, PK(l2, h2), od, 0, 0, 0);
    od = __builtin_amdgcn_mfma_f32_32x32x16_bf16(pa3, PK(l3, h3), od, 0, 0, 0);
#undef PK
}
__device__ __forceinline__ void pv_pair(f32x16& o0, f32x16& o1, int vb, bf16x8 pa0, bf16x8 pa1, bf16x8 pa2, bf16x8 pa3) {
    const s16x4 l0 = tr_read<v_rd_off(0, 0, 0)>(vb), h0 = tr_read<v_rd_off(0, 0, 1)>(vb), l1 = tr_read<v_rd_off(0, 1, 0)>(vb), h1 = tr_read<v_rd_off(0, 1, 1)>(vb);
    const s16x4 l2 = tr_read<v_rd_off(0, 2, 0)>(vb), h2 = tr_read<v_rd_off(0, 2, 1)>(vb), l3 = tr_read<v_rd_off(0, 3, 0)>(vb), h3 = tr_read<v_rd_off(0, 3, 1)>(vb);
    const s16x4 m0 = tr_read<v_rd_off(1, 0, 0)>(vb), n0 = tr_read<v_rd_off(1, 0, 1)>(vb), m1 = tr_read<v_rd_off(1, 1, 0)>(vb), n1 = tr_read<v_rd_off(1, 1, 1)>(vb);
    const s16x4 m2 = tr_read<v_rd_off(1, 2, 0)>(vb), n2 = tr_read<v_rd_off(1, 2, 1)>(vb), m3 = tr_read<v_rd_off(1, 3, 0)>(vb), n3 = tr_read<v_rd_off(1, 3, 1)>(vb);
#define PK(L, H) (bf16x8){L[0], L[1], L[2], L[3], H[0], H[1], H[2], H[3]}
    asm volatile("s_waitcnt lgkmcnt(8)" ::: "memory"); SBAR();
    o0 = __builtin_amdgcn_mfma_f32_32x32x16_bf16(pa0, PK(l0, h0), o0, 0, 0, 0); o0 = __builtin_amdgcn_mfma_f32_32x32x16_bf16(pa1, PK(l1, h1), o0, 0, 0, 0);
    o0 = __builtin_amdgcn_mfma_f32_32x32x16_bf16(pa2, PK(l2, h2), o0, 0, 0, 0); o0 = __builtin_amdgcn_mfma_f32_32x32x16_bf16(pa3, PK(l3, h3), o0, 0, 0, 0);
    asm volatile("s_waitcnt lgkmcnt(0)" ::: "memory"); SBAR();
    o1 = __builtin_amdgcn_mfma_f32_32x32x16_bf16(pa0, PK(m0, n0), o1, 0, 0, 0); o1 = __builtin_amdgcn_mfma_f32_32x32x16_bf16(pa1, PK(m1, n1), o1, 0, 0, 0);
    o1 = __builtin_amdgcn_mfma_f32_32x32x16_bf16(pa2, PK(m2, n2), o1, 0, 0, 0); o1 = __builtin_amdgcn_mfma_f32_32x32x16_bf16(pa3, PK(m3, n3), o1, 0, 0, 0);
#undef PK
}
struct Unit {
    const bf16_t* Q; int ldq;
    const bf16_t* K; int ldk;
    const bf16_t* V; int ldv;
    bf16_t* O; int ldo;
    int NT, n1, k1, k2;
    int qpos0;
    float sink; int has_sink, wv;
};
template <int DQK, bool WIN>
__device__ __forceinline__ void attn_unit(const Unit& U, char* lds) {
    constexpr int NCH = DQK / 8;
    const int tid = tid_(U.wv), wid = U.wv, lane = tid & 63, r32 = lane & 31, hi = lane >> 5;
    char* V_lds = lds; char* K_lds = lds + NBUF * SHM_V;
    float* ws = (float*)(lds + NBUF * SHM_V + NBUF * SHM_K) + wid * 64; float* li_l = ws; float* al_l = ws + 32;
    float m_reg = -1e30f; f32x16 o[2] = {}, lacc = {}; bf16x8 qr[DQK / 16];
    const bf16x8 ones = {0x3F80, 0x3F80, 0x3F80, 0x3F80, 0x3F80, 0x3F80, 0x3F80, 0x3F80};
    const bf16_t* Qw = U.Q + (size_t)(wid * 32 + r32) * U.ldq + hi * 8;
#pragma unroll
    for (int d0 = 0; d0 < DQK / 16; ++d0) qr[d0] = *reinterpret_cast<const bf16x8*>(Qw + d0 * 16);
    const int kc0 = tid, kr0 = kc0 / NCH, kcol0 = (kc0 % NCH) * 8;
    const int kc1 = tid + 512, kr1 = kc1 / NCH, kcol1 = (kc1 % NCH) * 8; const bool has1 = kc1 < 64 * NCH;
    const int vr = tid >> 3, vc = (tid & 7) * 8, vst = v_st(vr, vc);
    const int kst0 = KSWZ(kr0, kcol0 * 2), kst1 = KSWZ(kr1, kcol1 * 2);
    const int vb0 = (int)(uintptr_t)V_lds + v_rd_base(lane);
    const int qp = U.qpos0 + wid * 32 + r32;
    struct { bf16x8 k0, k1, v; } sr_[2];
#define TKEY(j) ((j) < U.n1 ? U.k1 + 64 * (j) : U.k2 + 64 * ((j) - U.n1))
#define SLOAD(i, j) do { const int _k0 = TKEY(j); sr_[i].k0 = *reinterpret_cast<const bf16x8*>(U.K + (size_t)(_k0 + kr0) * U.ldk + kcol0); \
    if (has1) sr_[i].k1 = *reinterpret_cast<const bf16x8*>(U.K + (size_t)(_k0 + kr1) * U.ldk + kcol1); \
    sr_[i].v = *reinterpret_cast<const bf16x8*>(U.V + (size_t)(_k0 + vr) * U.ldv + vc); } while (0)
#define SWRITE(b, i) do { *(bf16x8*)(V_lds + (b) * SHM_V + vst) = sr_[i].v; *(bf16x8*)(K_lds + (b) * SHM_K + kst0) = sr_[i].k0; \
    if (has1) *(bf16x8*)(K_lds + (b) * SHM_K + kst1) = sr_[i].k1; } while (0)
#define RESC(a) do { if (__any((a) < 1.f)) { if (hi == 0) al_l[r32] = (a); asm volatile("s_waitcnt lgkmcnt(0)" ::: "memory"); \
    _Pragma("unroll") for (int r = 0; r < 16; ++r) { const float a_ = al_l[crow(r, hi)]; o[0][r] *= a_; o[1][r] *= a_; lacc[r] *= a_; } } } while (0)
#define MASK(P0, P1, j) do { if (WIN && (j) >= U.n1) maskband(P0, P1, TKEY(j), qp, hi); } while (0)
#define PVD(vbase) do { pv_one<0>(o[0], vbase, pa0, pa1, pa2, pa3); pv_one<1>(o[1], vbase, pa0, pa1, pa2, pa3); \
    lacc = __builtin_amdgcn_mfma_f32_32x32x16_bf16(pa0, ones, lacc, 0, 0, 0); lacc = __builtin_amdgcn_mfma_f32_32x32x16_bf16(pa1, ones, lacc, 0, 0, 0); \
    lacc = __builtin_amdgcn_mfma_f32_32x32x16_bf16(pa2, ones, lacc, 0, 0, 0); lacc = __builtin_amdgcn_mfma_f32_32x32x16_bf16(pa3, ones, lacc, 0, 0, 0); } while (0)
    f32x16 pA0, pA1, pB0, pB1; float mnA, mnB, alA, alB; bf16x8 pa0, pa1, pa2, pa3; const int NT = U.NT;
    SLOAD(0, 0); asm volatile("s_waitcnt vmcnt(0)" ::: "memory"); SWRITE(0, 0); __syncthreads();
    qkt<DQK>(pA0, pA1, K_lds, qr, r32, hi); MASK(pA0, pA1, 0); partialSM(pA0, pA1, m_reg, mnA, alA);
    SLOAD(1, 1); if (2 < NT) SLOAD(0, 2);
    SWRITE(1, 1); __syncthreads();
    int bc = 1, bp = 0, bn = 2;
    for (int j = 1; j + 1 < NT; j += 2) {
        SLOAD(1, j + 2);
        SBAR(); qkt<DQK>(pB0, pB1, K_lds + bc * SHM_K, qr, r32, hi); MASK(pB0, pB1, j);
        finishSM(pA0, pA1, pa0, pa1, pa2, pa3); SBAR();
        PVD(vb0 + bp * SHM_V); partialSM(pB0, pB1, m_reg, mnB, alB);
        SWRITE(bn, 0);
        RESC(alB); __syncthreads();
        { const int t_ = bp; bp = bc; bc = bn; bn = t_; }
        if (j + 3 < NT) SLOAD(0, j + 3);
        SBAR(); qkt<DQK>(pA0, pA1, K_lds + bc * SHM_K, qr, r32, hi); MASK(pA0, pA1, j + 1);
        finishSM(pB0, pB1, pa0, pa1, pa2, pa3); SBAR();
        PVD(vb0 + bp * SHM_V); partialSM(pA0, pA1, m_reg, mnA, alA);
        SWRITE(bn, 1);
        RESC(alA); __syncthreads();
        { const int t_ = bp; bp = bc; bc = bn; bn = t_; }
    }
    SBAR(); qkt<DQK>(pB0, pB1, K_lds + bc * SHM_K, qr, r32, hi); MASK(pB0, pB1, NT - 1);
    finishSM(pA0, pA1, pa0, pa1, pa2, pa3); SBAR();
    PVD(vb0 + bp * SHM_V); partialSM(pB0, pB1, m_reg, mnB, alB);
    RESC(alB);
    finishSM(pB0, pB1, pa0, pa1, pa2, pa3); SBAR();
    PVD(vb0 + bc * SHM_V);
    if (WIN && U.has_sink) {
        if (hi == 0) li_l[r32] = __builtin_amdgcn_exp2f((U.sink - m_reg) * LOG2E); asm volatile("s_waitcnt lgkmcnt(0)" ::: "memory");
#pragma unroll
        for (int r = 0; r < 16; ++r) lacc[r] += li_l[crow(r, hi)]; }
    float rli[16];
#pragma unroll
    for (int r = 0; r < 16; ++r) rli[r] = __builtin_amdgcn_rcpf(lacc[r]);
    bf16_t* Ow = U.O + (size_t)(wid * 32) * U.ldo;
#pragma unroll
    for (int r = 0; r < 16; ++r) { const int orow = crow(r, hi);
#pragma unroll
        for (int d0 = 0; d0 < 2; ++d0) Ow[(size_t)orow * U.ldo + d0 * 32 + r32] = f2bf(o[d0][r] * rli[r]); }
    __syncthreads();
#undef TKEY
#undef SLOAD
#undef SWRITE
#undef RESC
#undef MASK
#undef PVD
}

typedef __bf16 bf16x2_t __attribute__((ext_vector_type(2)));
typedef float f32x2_t __attribute__((ext_vector_type(2)));
__device__ __forceinline__ unsigned cvtpk2(float lo, float hi) { f32x2_t f = {lo, hi}; bf16x2_t b = __builtin_convertvector(f, bf16x2_t); return *reinterpret_cast<unsigned*>(&b); }
__device__ __forceinline__ void sl_pk(const f32x16& p, bf16x8& lo, bf16x8& hi) {
#define PK4(BASE, OUT) do { u32x4 w = {cvtpk2(p[BASE + 0], p[BASE + 1]), cvtpk2(p[BASE + 2], p[BASE + 3]), cvtpk2(p[BASE + 4], p[BASE + 5]), cvtpk2(p[BASE + 6], p[BASE + 7])}; OUT = *reinterpret_cast<bf16x8*>(&w); } while (0)
    PK4(0, lo); PK4(8, hi);
#undef PK4
}
template <int DQK>
__device__ __forceinline__ void attn_mla2(const Unit& U, char* lds) {
    constexpr int NCH = DQK / 8; constexpr float PLIM = 1073741824.f;
    const int tid = tid_(U.wv), wid = U.wv, lane = tid & 63, r32 = lane & 31, hi = lane >> 5;
    char* V_lds = lds; char* K_lds = lds + 4 * SHM_V;
    float* ws = (float*)(lds + 4 * SHM_V + 4 * SHM_K) + wid * 64; float* li_l = ws; float* al_l = ws + 32;
    float mA, mB, lA, lB; f32x16 oA[2], oB[2]; bf16x8 qA[DQK / 16], qB[DQK / 16]; bool refA, refB, force = false;
    { const bf16_t* Qw = U.Q + (size_t)(wid * 64 + r32) * U.ldq + hi * 8;
#pragma unroll
      for (int d0 = 0; d0 < DQK / 16; ++d0) { qA[d0] = *reinterpret_cast<const bf16x8*>(Qw + d0 * 16); qB[d0] = *reinterpret_cast<const bf16x8*>(Qw + (size_t)32 * U.ldq + d0 * 16);
#pragma unroll
        for (int e = 0; e < 8; ++e) { qA[d0][e] = (short)f2bf(bf2f((bf16_t)qA[d0][e]) * LOG2E); qB[d0][e] = (short)f2bf(bf2f((bf16_t)qB[d0][e]) * LOG2E); } } }
    const int kc0 = tid, kr0 = kc0 / NCH, kcol0 = (kc0 % NCH) * 8;
    const int kc1 = tid + 512, kr1 = kc1 / NCH, kcol1 = (kc1 % NCH) * 8; const bool has1 = kc1 < 64 * NCH;
    const int vr = tid >> 3, vc = (tid & 7) * 8, vst = v_st(vr, vc);
    const int kst0 = KSWZ(kr0, kcol0 * 2), kst1 = KSWZ(kr1, kcol1 * 2);
    const int vb0 = (int)(uintptr_t)V_lds + v_rd_base(lane);
    bf16x8 sk0, sk1, sv;
    typedef __attribute__((address_space(1))) const char* g_c_p; typedef __attribute__((address_space(1))) const bf16x8* g_b8_p;
    const unsigned ko0 = (unsigned)(kr0 * U.ldk + kcol0) * 2u, ko1 = (unsigned)(kr1 * U.ldk + kcol1) * 2u, vo = (unsigned)(vr * U.ldv + vc) * 2u;
#define SLOAD4(j) do { unsigned long long kj_ = (unsigned long long)((const char*)U.K + (size_t)(64 * (j)) * U.ldk * 2), vj_ = (unsigned long long)((const char*)U.V + (size_t)(64 * (j)) * U.ldv * 2); \
    asm volatile("" : "+s"(kj_), "+s"(vj_)); g_c_p Kj_ = (g_c_p)kj_; g_c_p Vj_ = (g_c_p)vj_; \
    sk0 = *(g_b8_p)(Kj_ + ko0); if (has1) sk1 = *(g_b8_p)(Kj_ + ko1); sv = *(g_b8_p)(Vj_ + vo); } while (0)
#define SWRITE4(b) do { *(bf16x8*)(V_lds + (b) * SHM_V + vst) = sv; *(bf16x8*)(K_lds + (b) * SHM_K + kst0) = sk0; if (has1) *(bf16x8*)(K_lds + (b) * SHM_K + kst1) = sk1; } while (0)
#define SOFTMAX4(S0, S1, q, m, refnz, l, o, f0, f1, f2, f3, Ks) do { \
    float ps_ = 0.f; \
    if (refnz) { _Pragma("unroll") for (int r = 0; r < 16; ++r) { S0[r] -= (m); S1[r] -= (m); } } \
    _Pragma("unroll") for (int r = 0; r < 16; ++r) S0[r] = __builtin_amdgcn_exp2f(S0[r]); \
    _Pragma("unroll") for (int r = 0; r < 16; ++r) S1[r] = __builtin_amdgcn_exp2f(S1[r]); \
    _Pragma("unroll") for (int r = 0; r < 16; ++r) ps_ += S0[r]; \
    _Pragma("unroll") for (int r = 0; r < 16; ++r) ps_ += S1[r]; \
    { auto rr_ = __builtin_amdgcn_permlane32_swap(__float_as_uint(ps_), __float_as_uint(ps_), false, false); ps_ = __uint_as_float(rr_[0]) + __uint_as_float(rr_[1]); } \
    if (__builtin_expect(force || (MK_TEST == 1 && first_) || __any(!(ps_ <= PLIM)), 0)) { \
        qkt<DQK>(S0, S1, Ks, q, r32, hi); \
        float pm_ = S0[0]; \
        _Pragma("unroll") for (int r = 1; r < 16; ++r) pm_ = fmaxf(pm_, S0[r]); \
        _Pragma("unroll") for (int r = 0; r < 16; ++r) pm_ = fmaxf(pm_, S1[r]); \
        { auto rr_ = __builtin_amdgcn_permlane32_swap(__float_as_uint(pm_), __float_as_uint(pm_), false, false); pm_ = fmaxf(__uint_as_float(rr_[0]), __uint_as_float(rr_[1])); } \
        const float mn_ = fmaxf(m, pm_), al_ = __builtin_amdgcn_exp2f((m) - mn_); m = mn_; l *= al_; refnz = true; \
        if (hi == 0) al_l[r32] = al_; asm volatile("s_waitcnt lgkmcnt(0)" ::: "memory"); \
        _Pragma("unroll") for (int r = 0; r < 16; ++r) { const float a_ = al_l[crow(r, hi)]; o[0][r] *= a_; o[1][r] *= a_; } \
        ps_ = 0.f; \
        _Pragma("unroll") for (int r = 0; r < 16; ++r) { S0[r] = __builtin_amdgcn_exp2f(S0[r] - mn_); ps_ += S0[r]; } \
        _Pragma("unroll") for (int r = 0; r < 16; ++r) { S1[r] = __builtin_amdgcn_exp2f(S1[r] - mn_); ps_ += S1[r]; } \
        { auto rr_ = __builtin_amdgcn_permlane32_swap(__float_as_uint(ps_), __float_as_uint(ps_), false, false); ps_ = __uint_as_float(rr_[0]) + __uint_as_float(rr_[1]); } \
    } \
    l += ps_; \
    { bf16x8 t0_, t1_; sl_pk(S0, t0_, t1_); f0 = t0_; f1 = t1_; sl_pk(S1, t0_, t1_); f2 = t0_; f3 = t1_; } \
} while (0)
    const int NT = U.NT;
#define TILE4(b) do { \
        f32x16 pA0 = {}, pA1 = {}, pB0 = {}, pB1 = {}; \
        const char* Ks = K_lds + (b) * SHM_K; \
        _Pragma("unroll") for (int d0 = 0; d0 < DQK / 16; ++d0) { const int cb = (d0 * 16 + hi * 8) * 2; \
            const bf16x8 k0 = *reinterpret_cast<const bf16x8*>(Ks + KSWZ(r32, cb)), k1 = *reinterpret_cast<const bf16x8*>(Ks + KSWZ(32 + r32, cb)); \
            pA0 = __builtin_amdgcn_mfma_f32_32x32x16_bf16(k0, qA[d0], pA0, 0, 0, 0); pA1 = __builtin_amdgcn_mfma_f32_32x32x16_bf16(k1, qA[d0], pA1, 0, 0, 0); \
            pB0 = __builtin_amdgcn_mfma_f32_32x32x16_bf16(k0, qB[d0], pB0, 0, 0, 0); pB1 = __builtin_amdgcn_mfma_f32_32x32x16_bf16(k1, qB[d0], pB1, 0, 0, 0); } \
        bf16x8 pa0, pa1, pa2, pa3, pb0, pb1, pb2, pb3; \
        SOFTMAX4(pA0, pA1, qA, mA, refA, lA, oA, pa0, pa1, pa2, pa3, Ks); \
        pv_one<0>(oA[0], vb0 + (b) * SHM_V, pa0, pa1, pa2, pa3); pv_one<1>(oA[1], vb0 + (b) * SHM_V, pa0, pa1, pa2, pa3); \
        SOFTMAX4(pB0, pB1, qB, mB, refB, lB, oB, pb0, pb1, pb2, pb3, Ks); \
        pv_one<0>(oB[0], vb0 + (b) * SHM_V, pb0, pb1, pb2, pb3); pv_one<1>(oB[1], vb0 + (b) * SHM_V, pb0, pb1, pb2, pb3); \
    } while (0)
    int* fl = (int*)(lds + 4 * SHM_V + 4 * SHM_K + 8 * 64 * 4);
#pragma unroll 1
    for (int pass = 0; pass < 2; ++pass) {
    mA = mB = force ? -1e30f : 0.f; lA = lB = 0.f; refA = refB = false; oA[0] = oA[1] = oB[0] = oB[1] = f32x16{};
    SLOAD4(0); asm volatile("s_waitcnt vmcnt(0)" ::: "memory"); SWRITE4(0); __syncthreads();
    asm volatile(".p2align 8");
#pragma unroll 1
    for (int j = 0; j < NT; ++j) {
        const bool first_ = j == 0;
        const int b0 = j & 1;
        if (j + 1 < NT) SLOAD4(j + 1);
        TILE4(b0);
        if (j + 1 < NT) SWRITE4(b0 ^ 1);
        __syncthreads();
    }
    if (pass) break;
    { const bool bad = (MK_TEST == 2) || __any(!(lA > 1e-30f) || !(lB > 1e-30f));
      if (lane == 0) fl[wid] = bad ? 1 : 0; __syncthreads();
      const bool redo = __any(fl[lane & 7] != 0); __syncthreads();
      if (!redo) break; force = true; }
    }
#pragma unroll
    for (int t = 0; t < 2; ++t) {
        if (hi == 0) li_l[r32] = t ? lB : lA; asm volatile("s_waitcnt lgkmcnt(0)" ::: "memory");
        bf16_t* Ow = U.O + (size_t)(wid * 64 + t * 32) * U.ldo;
#pragma unroll
        for (int r = 0; r < 16; ++r) { const int orow = crow(r, hi); const float rl = __builtin_amdgcn_rcpf(li_l[orow]);
#pragma unroll
            for (int d0 = 0; d0 < 2; ++d0) Ow[(size_t)orow * U.ldo + d0 * 32 + r32] = f2bf((t ? oB[d0][r] : oA[d0][r]) * rl); }
        asm volatile("s_waitcnt lgkmcnt(0)" ::: "memory");
    }
    __syncthreads();
#undef SLOAD4
#undef SWRITE4
#undef SOFTMAX4
#undef TILE4
}
}

__device__ __forceinline__ void phase_mla(const Params& p, lds_t* lds, int l) {
    for (int L = bid_(); L < 256; L += gridDim.x) {
        const int u = gridDim.x == 256 ? ((((L & 7) + 8 * ((L >> 3) & 1)) << 4) | (L >> 4)) : L;
        const int qb = u & 15, h = (u >> 4) & 3, b = u >> 6; const int r0 = b * 8192 + qb * 512;
        att::Unit U{}; U.Q = SP(bf16_t, S_QM) + (size_t)r0 * 384 + h * 96; U.NT = 132; U.O = SP(bf16_t, S_CAT) + (size_t)r0 * 1280 + 768 + h * 64;
        U.K = SP(bf16_t, S_KM) + ((size_t)b * 4 + h) * NKEY * 96; U.V = SP(bf16_t, S_VM) + ((size_t)b * 4 + h) * NKEY * 64;
        U.ldq = 384; U.ldk = 96; U.ldv = 64; U.ldo = 1280; U.wv = p.wv;
        att::attn_mla2<96>(U, (char*)lds);
    }
    if (l == 0) for (int c = bid_(); c < 16; c += gridDim.x) {
        const int h = c & 3, b = c >> 2; const int r0 = TL + b * 256;
        att::Unit U{}; U.Q = SP(bf16_t, S_QM) + (size_t)r0 * 384 + h * 96; U.NT = 4; U.n1 = 4; U.k1 = 8192; U.O = SP(bf16_t, S_CAT) + (size_t)r0 * 1280 + 768 + h * 64;
        U.K = SP(bf16_t, S_KM) + ((size_t)b * 4 + h) * NKEY * 96; U.V = SP(bf16_t, S_VM) + ((size_t)b * 4 + h) * NKEY * 64;
        U.ldq = 384; U.ldk = 96; U.ldv = 64; U.ldo = 1280; U.wv = p.wv;
        att::attn_unit<96, false>(U, (char*)lds);
    }
}
__device__ __forceinline__ void phase_win(const Params& p, lds_t* lds, int l) {
    const int nun = 512 + (l == 0 ? 16 : 0);
    for (int u = bid_(); u < nun; u += gridDim.x) {
        att::Unit U{}; int b, h, r0;
        if (u < 512) { const int qb = u & 31; h = (u >> 5) & 3; b = u >> 7; r0 = b * 8192 + qb * 256; const int q0 = qb * 256;
            const int klo = q0 - 128 < 0 ? 0 : q0 - 128, khi = q0 + 384 > 8192 ? 8192 : q0 + 384;
            U.n1 = 4; U.k1 = 8192; U.k2 = klo; U.NT = 4 + (khi - klo) / 64; U.qpos0 = q0; }
        else { h = (u - 512) & 3; b = (u - 512) >> 2; r0 = TL + b * 256; U.n1 = 4; U.k1 = 8192; U.k2 = 0; U.NT = 4; U.qpos0 = 0; }
        U.Q = SP(bf16_t, S_QW) + (size_t)r0 * 256 + h * 64; U.ldq = 256;
        U.K = SP(bf16_t, S_KW) + (size_t)b * NKEY * 128 + (h >> 1) * 64; U.ldk = 128; U.V = SP(bf16_t, S_VW) + (size_t)b * NKEY * 128 + (h >> 1) * 64; U.ldv = 128;
        U.O = SP(bf16_t, S_CAT) + (size_t)r0 * 1280 + 512 + h * 64; U.ldo = 1280; U.sink = p.win_sink[l * 4 + h]; U.has_sink = 1; U.wv = p.wv;
        att::attn_unit<64, true>(U, (char*)lds);
    }
}


namespace sg {
using bf16x8 = __attribute__((ext_vector_type(8))) short;
using s16x4 = __attribute__((ext_vector_type(4))) short;
using f32x16 = __attribute__((ext_vector_type(16))) float;
__device__ __forceinline__ int crow(int r, int hi) { return (r & 3) + 8 * (r >> 2) + 4 * hi; }
__device__ __forceinline__ int b_off(int k, int n8, int NB32) { return ((k >> 3) * NB32 + (n8 >> 2)) * 512 + (k & 7) * 64 + (n8 & 3) * 16; }
__device__ __forceinline__ int tr_lane(int lane, int NB32) { return (((lane & 15) >> 2) * 64) + (((lane >> 4) & 1) * 32) + ((lane & 3) * 8) + (lane >> 5) * NB32 * 512; }
__device__ __forceinline__ s16x4 tr_read(int addr) { s16x4 r; asm volatile("ds_read_b64_tr_b16 %0, %1" : "=&v"(r) : "v"(addr) : "memory"); return r; }
template <int MT, int KS, bool SWAP = false>
__device__ __forceinline__ void mma_block(f32x16 (&acc)[MT][2], const bf16x8 (&af)[MT][KS], int base, int NB32, int nb0) {
#pragma unroll
    for (int ks = 0; ks < KS; ++ks) {
        const int a0 = base + ((2 * ks) * NB32 + nb0) * 512;
        const s16x4 l0 = tr_read(a0), h0 = tr_read(a0 + 256), l1 = tr_read(a0 + 512), h1 = tr_read(a0 + 512 + 256);
        asm volatile("s_waitcnt lgkmcnt(0)" ::: "memory"); __builtin_amdgcn_sched_barrier(0);
        const bf16x8 b0 = (bf16x8){l0[0], l0[1], l0[2], l0[3], h0[0], h0[1], h0[2], h0[3]}, b1 = (bf16x8){l1[0], l1[1], l1[2], l1[3], h1[0], h1[1], h1[2], h1[3]};
#pragma unroll
        for (int mt = 0; mt < MT; ++mt) {
            if constexpr (SWAP) { acc[mt][0] = __builtin_amdgcn_mfma_f32_32x32x16_bf16(b0, af[mt][ks], acc[mt][0], 0, 0, 0); acc[mt][1] = __builtin_amdgcn_mfma_f32_32x32x16_bf16(b1, af[mt][ks], acc[mt][1], 0, 0, 0); }
            else { acc[mt][0] = __builtin_amdgcn_mfma_f32_32x32x16_bf16(af[mt][ks], b0, acc[mt][0], 0, 0, 0); acc[mt][1] = __builtin_amdgcn_mfma_f32_32x32x16_bf16(af[mt][ks], b1, acc[mt][1], 0, 0, 0); } }
    }
}
template <int KR, int NC>
__device__ __forceinline__ void stage_b(char* lds, const bf16_t* src, size_t ld, int tid) {
    constexpr int CH = NC / 8, TOT = KR * CH;
#pragma unroll
    for (int c = tid; c < TOT; c += 512) { const int k = c / CH, n8 = c % CH;
        *(bf16x8*)(lds + b_off(k, n8, NC / 32)) = *(const bf16x8*)(src + (size_t)k * ld + n8 * 8); }
}
}

__device__ __forceinline__ void phase_fft_a(const Params& p, lds_t* lds_) {
    char* lds = (char*)lds_;
    const int tid = tid_(p.wv), w = p.wv, lane = tid & 63, r32 = lane & 31, hi = lane >> 5, kb = w & 3;
    sg::bf16x8 af[2][8];
#pragma unroll
    for (int mt = 0; mt < 2; ++mt)
#pragma unroll
        for (int ks = 0; ks < 8; ++ks) af[mt][ks] = *(const sg::bf16x8*)(WSP(bf16_t, OFF_FA) + (size_t)(kb * 64 + mt * 32 + r32) * 128 + ks * 16 + 8 * hi);
    const int base = (int)(uintptr_t)lds + sg::tr_lane(lane, 4);
    for (int u = bid_(); u < 512; u += gridDim.x) {
        const int b = u >> 7, T = u & 127;
        sg::stage_b<128, 128>(lds, SP(bf16_t, S_ABUF) + (size_t)b * 8192 * 256 + T * 128, 16384, tid);
        __syncthreads();
        sg::f32x16 acc[2][2] = {};
        sg::mma_block<2, 8>(acc, af, base, 4, 2 * (w >> 2));
        const int n2 = T >> 1, cb = (T & 1) * 128 + 64 * (w >> 2) + r32;
#pragma unroll
        for (int r = 0; r < 16; ++r) { const int k1 = kb * 32 + sg::crow(r, hi); const float2 t = WSP(float2, OFF_TW)[n2 * 128 + k1];
            bf16_t* o = SP(bf16_t, S_UP) + ((((size_t)b * 128 + k1) * 2) * 64 + n2) * 256 + cb;
#pragma unroll
            for (int nt = 0; nt < 2; ++nt) { const float ur = acc[0][nt][r], ui = acc[1][nt][r]; o[nt * 32] = f2bf(ur * t.x + ui * t.y); o[64 * 256 + nt * 32] = f2bf(ui * t.x - ur * t.y); } }
        __syncthreads();
    }
}
__device__ __forceinline__ void phase_fft_c(const Params& p, lds_t* lds_) {
    char* lds = (char*)lds_;
    const int tid = tid_(p.wv), w = p.wv, lane = tid & 63, r32 = lane & 31, hi = lane >> 5, rio = w & 1;
    sg::bf16x8 af[2][8];
#pragma unroll
    for (int mt = 0; mt < 2; ++mt)
#pragma unroll
        for (int ks = 0; ks < 8; ++ks) af[mt][ks] = *(const sg::bf16x8*)(WSP(bf16_t, OFF_GM) + (size_t)(rio * 64 + mt * 32 + r32) * 128 + ks * 16 + 8 * hi);
    const int base = (int)(uintptr_t)lds + sg::tr_lane(lane, 8);
    for (int u = bid_(); u < 512; u += gridDim.x) {
        const int b = u >> 7, k1 = u & 127;
        sg::stage_b<128, 256>(lds, SP(bf16_t, S_UP) + (size_t)u * 128 * 256, 256, tid);
        __syncthreads();
        sg::f32x16 acc[2][2] = {};
        sg::mma_block<2, 8>(acc, af, base, 8, 2 * (w >> 1));
#pragma unroll
        for (int mt = 0; mt < 2; ++mt)
#pragma unroll
            for (int r = 0; r < 16; ++r) { const int k2 = mt * 32 + sg::crow(r, hi);
                bf16_t* o = SP(bf16_t, S_CAT) + ((size_t)b * 8192 + k1 + 128 * k2) * 1280 + rio * 256 + 64 * (w >> 1) + r32;
                o[0] = f2bf(acc[mt][0][r]); o[32] = f2bf(acc[mt][1][r]); }
        __syncthreads();
    }
}
__device__ __forceinline__ void phase_dft_ctx(const Params& p, lds_t* lds_) {
    char* lds = (char*)lds_;
    const int tid = tid_(p.wv), w = p.wv, lane = tid & 63, r32 = lane & 31, hi = lane >> 5;
    const int base = (int)(uintptr_t)lds + sg::tr_lane(lane, 4);
    for (int u = (int)gridDim.x - 64 - bid_(); u < 32; u += gridDim.x) { if (u < 0) continue;
        const int b = u >> 3, mb = (u >> 1) & 3, nh = u & 1;
        sg::bf16x8 af[1][16];
#pragma unroll
        for (int ks = 0; ks < 16; ++ks) af[0][ks] = *(const sg::bf16x8*)(WSP(bf16_t, OFF_FC) + (size_t)(mb * 128 + 32 * (w & 3) + r32) * 256 + ks * 16 + 8 * hi);
        sg::stage_b<256, 128>(lds, SP(bf16_t, S_ABUF) + ((size_t)TL + b * 256) * 256 + nh * 128, 256, tid);
        __syncthreads();
        sg::f32x16 acc[1][2] = {};
        sg::mma_block<1, 16>(acc, af, base, 4, 2 * (w >> 2));
#pragma unroll
        for (int r = 0; r < 16; ++r) { const int row = mb * 128 + 32 * (w & 3) + sg::crow(r, hi), ri = row >> 8, k = row & 255;
            bf16_t* o = SP(bf16_t, S_CAT) + ((size_t)TL + b * 256 + k) * 1280 + ri * 256 + nh * 128 + 64 * (w >> 2) + r32;
            o[0] = f2bf(acc[0][0][r]); o[32] = f2bf(acc[0][1][r]); }
        __syncthreads();
    }
}
__device__ __forceinline__ void phase_sgu(const Params& p, lds_t* lds_, int l) {
    char* lds = (char*)lds_;
    const int tid = tid_(p.wv), w = p.wv, lane = tid & 63, r32 = lane & 31, hi = lane >> 5, g = w >> 1, mh = w & 1;
    sg::bf16x8 af[2][8];
#pragma unroll
    for (int mt = 0; mt < 2; ++mt)
#pragma unroll
        for (int ks = 0; ks < 8; ++ks) { const float* src = p.sgu_w + ((size_t)(l * 4 + g) * 128 + mh * 64 + mt * 32 + r32) * 128 + ks * 16 + 8 * hi;
            const float4 a = *(const float4*)src, b = *(const float4*)(src + 4); const float v[8] = {a.x, a.y, a.z, a.w, b.x, b.y, b.z, b.w}; const pg8::u32x4 pk = pack8(v); af[mt][ks] = *(const sg::bf16x8*)&pk; }
    const int base = (int)(uintptr_t)lds + sg::tr_lane(lane, 8);
    const int nch = l == 0 ? RR / 128 : TL / 128;
    for (int u = (int)gridDim.x - 1 - bid_(); u < nch; u += gridDim.x) {
        const int r0 = u * 128;
#pragma unroll
        for (int c = tid; c < 128 * 32; c += 512) { const int q = c >> 5, n8 = c & 31;
            const float* st = WSP(float, OFF_LNS) + (size_t)(r0 + q) * 8; const float4 sa = *(const float4*)st, sb = *(const float4*)(st + 4);
            const float s1 = (sa.x + sa.z) + (sb.x + sb.z), s2 = (sa.y + sa.w) + (sb.y + sb.w), mu = s1 * (1.f / 256.f), rstd = rsqrtf(fmaxf(s2 * (1.f / 256.f) - mu * mu, 0.f) + EPS);
            const pg8::u32x4 raw = *(const pg8::u32x4*)(SP(bf16_t, S_VG) + (size_t)(r0 + q) * 256 + n8 * 8); float v[8];
#pragma unroll
            for (int e = 0; e < 4; ++e) { v[2 * e] = (__uint_as_float(raw[e] << 16) - mu) * rstd; v[2 * e + 1] = (__uint_as_float(raw[e] & 0xffff0000u) - mu) * rstd; }
            *(pg8::u32x4*)(lds + sg::b_off(q, n8, 8)) = pack8(v); }
        __syncthreads();
        sg::f32x16 acc[2][2] = {};
        sg::mma_block<2, 8, true>(acc, af, base, 8, 2 * g);
        bf16_t* simg = (bf16_t*)(lds + 65536);
#pragma unroll
        for (int mt = 0; mt < 2; ++mt) { const int pp = mh * 64 + mt * 32 + r32; const float bias = p.sgu_b[(l * 4 + g) * 128 + pp];
#pragma unroll
            for (int nt = 0; nt < 2; ++nt)
#pragma unroll
                for (int t4 = 0; t4 < 4; ++t4) { pg8::u32x2 w; w.x = pg8::cvt_pk_bf16(acc[mt][nt][4 * t4] + bias, acc[mt][nt][4 * t4 + 1] + bias); w.y = pg8::cvt_pk_bf16(acc[mt][nt][4 * t4 + 2] + bias, acc[mt][nt][4 * t4 + 3] + bias);
                    *(pg8::u32x2*)(simg + pp * 256 + g * 64 + nt * 32 + 8 * t4 + 4 * hi) = w; } }
        __syncthreads();
#pragma unroll
        for (int c = tid; c < 128 * 32; c += 512) { const int pp = c >> 5, n8 = c & 31; const size_t row = (size_t)r0 + pp;
            const pg8::u32x4 sv = *(const pg8::u32x4*)(simg + pp * 256 + n8 * 8), uv = *(const pg8::u32x4*)(SP(bf16_t, S_U) + row * 256 + n8 * 8); float v[8];
#pragma unroll
            for (int e = 0; e < 4; ++e) { v[2 * e] = __uint_as_float(sv[e] << 16) * __uint_as_float(uv[e] << 16); v[2 * e + 1] = __uint_as_float(sv[e] & 0xffff0000u) * __uint_as_float(uv[e] & 0xffff0000u); }
            *(pg8::u32x4*)(SP(bf16_t, S_CAT) + row * 1280 + 1024 + n8 * 8) = pack8(v); }
    }
    __syncthreads();
}
enum { PH_CVT = 0, PH_FFN_GU, PH_FFN_DN, PH_MOE_GU, PH_MOE_DN, PH_INPROJ, PH_UP, PH_OUTPROJ, PH_MLA, PH_WIN, PH_FFTA, PH_FFTC, PH_DFTC, PH_SGU, PH_PROA, PH_PROB, PH_NORM1, PH_POSTMIX, PH_ASSIGN, PH_POSTFFN };

__device__ __forceinline__ float wave_sum(float v) {
    const int l4 = lane_() << 2;
#pragma unroll
    for (int o = 32; o > 0; o >>= 1) v += __int_as_float(__builtin_amdgcn_ds_bpermute(l4 ^ (o << 2), __float_as_int(v)));
    return v;
}
__device__ __forceinline__ const float* hx_in_row(const Params& p, int l, int r) {
    if (l == 0) return r < TL ? p.x + (size_t)r * 1024 : p.ctx + (size_t)(r - TL) * 1024;
    return r < TL ? p.out + (size_t)r * 1024 : WSP(float, OFF_HXC) + (size_t)(r - TL) * 1024;
}
__device__ __forceinline__ float* hx_row(const Params& p, int r) { return r < TL ? p.out + (size_t)r * 1024 : WSP(float, OFF_HXC) + (size_t)(r - TL) * 1024; }
__device__ __forceinline__ void store4bf(bf16_t* dst, const float4 v) { pg8::u32x2 w; w.x = pg8::cvt_pk_bf16(v.x, v.y); w.y = pg8::cvt_pk_bf16(v.z, v.w); *(pg8::u32x2*)dst = w; }
__device__ __forceinline__ float4 load4bf(const bf16_t* src) { const pg8::u32x2 w = *(const pg8::u32x2*)src; return make_float4(__uint_as_float(w.x << 16), __uint_as_float(w.x & 0xffff0000u), __uint_as_float(w.y << 16), __uint_as_float(w.y & 0xffff0000u)); }
__device__ __forceinline__ float4 hx_load4(const Params& p, int kind, int r, int k) {
    if (kind == 0) return *(const float4*)((r < TL ? p.x + (size_t)r * 1024 : p.ctx + (size_t)(r - TL) * 1024) + k);
    if (r < TL) return load4bf((const bf16_t*)((const char*)p.out + (size_t)r * 4096 + 2048) + k);
    return *(const float4*)(WSP(float, OFF_HXC) + (size_t)(r - TL) * 1024 + k);
}
__device__ __forceinline__ void hx_store4(const Params& p, int r, int k, const float4 v) {
    if (r < TL) store4bf((bf16_t*)((char*)p.out + (size_t)r * 4096 + 2048) + k, v);
    else *(float4*)(WSP(float, OFF_HXC) + (size_t)(r - TL) * 1024 + k) = v;
}
#define F4OP(dst, expr) do { (dst).x = (expr(x)); (dst).y = (expr(y)); (dst).z = (expr(z)); (dst).w = (expr(w)); } while (0)
__device__ __forceinline__ float half_sum(float v) {
    const int l4 = lane_() << 2;
#pragma unroll
    for (int o = 16; o > 0; o >>= 1) v += __int_as_float(__builtin_amdgcn_ds_bpermute(l4 ^ (o << 2), __float_as_int(v)));
    return v;
}
__device__ __forceinline__ float qsum(float v) {
    const int l4 = lane_() << 2;
#pragma unroll
    for (int o = 8; o > 0; o >>= 1) v += __int_as_float(__builtin_amdgcn_ds_bpermute(l4 ^ (o << 2), __float_as_int(v)));
    return v;
}
#define SQ4(v) ((v).x * (v).x + (v).y * (v).y + (v).z * (v).z + (v).w * (v).w)
struct V8 { float v[8]; };
__device__ __forceinline__ V8 ld8_f32(const float* q) { const float4 a = *(const float4*)q, b = *(const float4*)(q + 4); return V8{{a.x, a.y, a.z, a.w, b.x, b.y, b.z, b.w}}; }
__device__ __forceinline__ V8 ld8_bf16(const bf16_t* q) { const pg8::u32x4 w = *(const pg8::u32x4*)q; V8 r;
#pragma unroll
    for (int e = 0; e < 4; ++e) { r.v[2 * e] = __uint_as_float(w[e] << 16); r.v[2 * e + 1] = __uint_as_float(w[e] & 0xffff0000u); } return r; }
__device__ __forceinline__ void st8_bf16(bf16_t* q, const V8& a) { *(pg8::u32x4*)q = pack8(a.v); }
__device__ __forceinline__ void st8_f32nt(float* q, const V8& a) { __builtin_nontemporal_store((pg8::f32x4){a.v[0], a.v[1], a.v[2], a.v[3]}, (pg8::f32x4*)q); __builtin_nontemporal_store((pg8::f32x4){a.v[4], a.v[5], a.v[6], a.v[7]}, (pg8::f32x4*)(q + 4)); }
__device__ __forceinline__ void st8_fp8(unsigned char* q, const V8& a) { pg8::u32x2 w; w.x = fp8x4(clamp448(a.v[0]), clamp448(a.v[1]), clamp448(a.v[2]), clamp448(a.v[3])); w.y = fp8x4(clamp448(a.v[4]), clamp448(a.v[5]), clamp448(a.v[6]), clamp448(a.v[7])); *(pg8::u32x2*)q = w; }
__device__ __forceinline__ float sq8(const V8& a) { float s = 0;
#pragma unroll
    for (int e = 0; e < 8; ++e) s += a.v[e] * a.v[e]; return s; }
__device__ __forceinline__ V8 hx_load8(const Params& p, int kind, int r, int k) {
    if (kind == 0) return ld8_f32((r < TL ? p.x + (size_t)r * 1024 : p.ctx + (size_t)(r - TL) * 1024) + k);
    if (r < TL) return ld8_bf16((const bf16_t*)((const char*)p.out + (size_t)r * 4096 + 2048) + k);
    return ld8_f32(WSP(float, OFF_HXC) + (size_t)(r - TL) * 1024 + k);
}
__device__ __forceinline__ void hx_store8(const Params& p, int r, int k, const V8& a) {
    if (r < TL) st8_bf16((bf16_t*)((char*)p.out + (size_t)r * 4096 + 2048) + k, a);
    else { *(float4*)(WSP(float, OFF_HXC) + (size_t)(r - TL) * 1024 + k) = make_float4(a.v[0], a.v[1], a.v[2], a.v[3]); *(float4*)(WSP(float, OFF_HXC) + (size_t)(r - TL) * 1024 + k + 4) = make_float4(a.v[4], a.v[5], a.v[6], a.v[7]); }
}
typedef __attribute__((address_space(3))) float lds_fl;
__device__ __forceinline__ V8 lds8(const lds_fl* q) { const pg8::f32x4 a = *(const __attribute__((address_space(3))) pg8::f32x4*)q, b = *(const __attribute__((address_space(3))) pg8::f32x4*)(q + 4); return V8{{a[0], a[1], a[2], a[3], b[0], b[1], b[2], b[3]}}; }
constexpr int EW_PAR_OFF = 49152;
__device__ __forceinline__ int seg_end(int r0, int rend) { const int nb = r0 < TL ? ((((r0 >> 13) + 1) << 13) < TL ? (((r0 >> 13) + 1) << 13) : TL) : RR; return nb < rend ? nb : rend; }
__device__ __forceinline__ void phase_norm1(const Params& p, lds_t* lds, int l) {
    const int tid = tid_(p.wv), lane = tid & 63, sl0 = lane & 15, q = p.wv * 4 + (lane >> 4), G = gridDim.x, RPB = (RR + G - 1) / G;
    lds_fl* par = (lds_fl*)(lds + EW_PAR_OFF);
    const int rbeg = bid_() * RPB, rend = rbeg + RPB < RR ? rbeg + RPB : RR;
    for (int r0 = rbeg; r0 < rend;) { const int r1 = seg_end(r0, rend); const float* mod = WSP(float, OFF_MOD) + ((size_t)l * 5 + row_cond(r0)) * 6144;
        __syncthreads();
        for (int i = tid; i < 1024; i += 512) { par[i] = p.g_pre_mix[l * 1024 + i]; par[1024 + i] = 1.f + mod[1024 + i]; par[2048 + i] = mod[i]; }
        __syncthreads();
        for (int rw = r0 + p.wv * 4; rw < r1; rw += 32) {
            int sl = sl0; asm volatile("" : "+v"(sl));
            const int rr = rw + (lane >> 4); const bool ok = rr < r1; const int r = ok ? rr : r0;
            V8 v[8]; float ss = 0;
#pragma unroll
            for (int i = 0; i < 8; ++i) { v[i] = hx_load8(p, l == 0 ? 0 : 1, r, sl * 8 + 128 * i); ss += sq8(v[i]); }
            const float rstd = rsqrtf(qsum(ss) * (1.f / 1024.f) + EPS);
#pragma unroll
            for (int i = 0; i < 8; ++i) { const int k = sl * 8 + 128 * i; const V8 gg = lds8(par + k), sc = lds8(par + 1024 + k), sh = lds8(par + 2048 + k); V8 y;
#pragma unroll
                for (int e = 0; e < 8; ++e) y.v[e] = v[i].v[e] * rstd * gg.v[e] * sc.v[e] + sh.v[e];
                if (ok) st8_bf16(WSP(bf16_t, OFF_XN) + (size_t)r * 1024 + k, y); }
        }
        r0 = r1; }
    __syncthreads(); (void)q;
}
__device__ __forceinline__ void phase_postmix(const Params& p, lds_t* lds, int l) {
    const int tid = tid_(p.wv), lane = tid & 63, sl0 = lane & 15, G = gridDim.x, g = (bid_() * 8 + p.wv) * 4 + (lane >> 4);
    const int nrows = l == 0 ? RR : TL, RPB = (nrows + G - 1) / G;
    if (l == 1) for (int i = bid_() * 512 + tid; i < NSORT; i += G * 512) WSP(int, OFF_ROWIDX)[i] = 0;
    int wcnt[8] = {0, 0, 0, 0, 0, 0, 0, 0};
    typedef __attribute__((address_space(3))) pg8::f32x4 lds_f4;
    const lds_f4* wrl = (const lds_f4*)lds;
    lds_fl* par = (lds_fl*)(lds + EW_PAR_OFF);
    if (l == 1) { for (int i = tid; i < 2048; i += 512) ((lds_f4*)lds)[i] = ((const pg8::f32x4*)p.moe_w_router)[i]; }
    const int rbeg = bid_() * RPB, rend = rbeg + RPB < nrows ? rbeg + RPB : nrows;
    for (int r0 = rbeg; r0 < rend;) { const int r1 = seg_end(r0, rend); const float* mod = WSP(float, OFF_MOD) + ((size_t)l * 5 + row_cond(r0)) * 6144;
        __syncthreads();
        for (int i = tid; i < 1024; i += 512) { par[i] = p.g_post_mix[l * 1024 + i] * mod[2048 + i]; par[1024 + i] = p.g_pre_ffn[l * 1024 + i] * (1.f + mod[4096 + i]); par[2048 + i] = mod[3072 + i]; }
        __syncthreads();
        for (int rw = r0 + p.wv * 4; rw < r1; rw += 32) {
            int sl = sl0; asm volatile("" : "+v"(sl));
            const int rr = rw + (lane >> 4); const bool ok = rr < r1; const int r = ok ? rr : r0;
            pg8::u32x4 mp[8]; V8 hv[8]; float ss = 0;
#pragma unroll
            for (int i = 0; i < 8; ++i) mp[i] = *(const pg8::u32x4*)(SP(bf16_t, S_MX) + (size_t)r * 1024 + sl * 8 + 128 * i);
#pragma unroll
            for (int i = 0; i < 8; ++i) hv[i] = hx_load8(p, l == 0 ? 0 : 1, r, sl * 8 + 128 * i);
#pragma unroll
            for (int i = 0; i < 8; ++i)
#pragma unroll
                for (int e = 0; e < 4; ++e) { const float a_ = __uint_as_float(mp[i][e] << 16), b_ = __uint_as_float(mp[i][e] & 0xffff0000u); ss += a_ * a_ + b_ * b_; }
            const float rstd = rsqrtf(qsum(ss) * (1.f / 1024.f) + EPS); float s2 = 0;
#pragma unroll
            for (int i = 0; i < 8; ++i) { const int k = sl * 8 + 128 * i; const V8 gg = lds8(par + k);
#pragma unroll
                for (int e = 0; e < 4; ++e) { hv[i].v[2 * e] += gg.v[2 * e] * (__uint_as_float(mp[i][e] << 16) * rstd); hv[i].v[2 * e + 1] += gg.v[2 * e + 1] * (__uint_as_float(mp[i][e] & 0xffff0000u) * rstd); }
                if (ok) hx_store8(p, r, k, hv[i]);
                s2 += sq8(hv[i]); }
            const float rstd2 = rsqrtf(qsum(s2) * (1.f / 1024.f) + EPS);
            float lg[8] = {0, 0, 0, 0, 0, 0, 0, 0};
#pragma unroll
            for (int i = 0; i < 8; ++i) { const int k = sl * 8 + 128 * i; const V8 gg = lds8(par + 1024 + k), sh = lds8(par + 2048 + k); V8 fx;
#pragma unroll
                for (int e = 0; e < 8; ++e) fx.v[e] = hv[i].v[e] * rstd2 * gg.v[e] + sh.v[e];
                if (ok) { if (l == 1 || DENSE_FP8 == 1) st8_fp8((unsigned char*)WSP(bf16_t, OFF_XN) + (size_t)r * 1024 + k, fx); else st8_bf16(WSP(bf16_t, OFF_XN) + (size_t)r * 1024 + k, fx); }
                hv[i] = fx; }
            if (l == 1) {
#pragma unroll
                for (int i = 0; i < 8; ++i) { const lds_f4* wr = wrl + (sl * 8 + 128 * i) * 2;
#pragma unroll
                    for (int e = 0; e < 8; ++e) { const float f = hv[i].v[e]; const pg8::f32x4 wa = wr[e * 2], wb = wr[e * 2 + 1];
                        lg[0] += f * wa[0]; lg[1] += f * wa[1]; lg[2] += f * wa[2]; lg[3] += f * wa[3]; lg[4] += f * wb[0]; lg[5] += f * wb[1]; lg[6] += f * wb[2]; lg[7] += f * wb[3]; } }
#pragma unroll
                for (int e = 0; e < 8; ++e) lg[e] = qsum(lg[e]);
                int e0 = 0; float v0 = lg[0];
#pragma unroll
                for (int e = 1; e < 8; ++e) if (lg[e] > v0) { v0 = lg[e]; e0 = e; }
                int e1 = -1; float v1 = -3.0e38f;
#pragma unroll
                for (int e = 0; e < 8; ++e) if (e != e0 && lg[e] > v1) { v1 = lg[e]; e1 = e; }
                if (ok) {
#pragma unroll
                    for (int e = 0; e < 8; ++e) wcnt[e] += (e0 == e) + (e1 == e);
                    if (sl == 0) { const float w1 = __expf(v1 - v0), inv = 1.f / (1.f + w1);
                        WSP(int, OFF_TOKE)[r * 2] = e0; WSP(int, OFF_TOKE)[r * 2 + 1] = e1; WSP(float, OFF_TOKW)[r * 2] = inv; WSP(float, OFF_TOKW)[r * 2 + 1] = w1 * inv; } }
            }
        }
        r0 = r1; }
    if (l == 1) {
        __syncthreads();
        int* lc = (int*)(lds + 40960);
        if (sl0 == 0) { int4* dst = (int4*)(WSP(int, OFF_LNS) + (size_t)g * 8); dst[0] = make_int4(wcnt[0], wcnt[1], wcnt[2], wcnt[3]); dst[1] = make_int4(wcnt[4], wcnt[5], wcnt[6], wcnt[7]);
            const int o_ = p.wv * 4 + (lane >> 4);
#pragma unroll
            for (int e = 0; e < 8; ++e) lc[o_ * 8 + e] = wcnt[e]; }
        __syncthreads();
        if (tid < 8) { int t_ = 0;
#pragma unroll
            for (int o_ = 0; o_ < 32; ++o_) t_ += lc[o_ * 8 + tid];
            WSP(int, OFF_LNS)[(size_t)G * 32 * 8 + bid_() * 8 + tid] = t_; }
    }
    __syncthreads();
}
__device__ __forceinline__ void phase_moe_assign(const Params& p) {
    const int tid = tid_(p.wv), lane = tid & 63, gw = bid_() * 8 + p.wv, nown = gridDim.x * 32;
    const int* cntW = WSP(int, OFF_LNS); const int* cntB = cntW + (size_t)gridDim.x * 32 * 8;
    int tot[8] = {0, 0, 0, 0, 0, 0, 0, 0}, pre[8] = {0, 0, 0, 0, 0, 0, 0, 0};
    const int myb = bid_();
    for (int b = lane; b < (int)gridDim.x; b += 64) { const int4 a = *(const int4*)(cntB + (size_t)b * 8), c4 = *(const int4*)(cntB + (size_t)b * 8 + 4); const int c[8] = {a.x, a.y, a.z, a.w, c4.x, c4.y, c4.z, c4.w}; const int m = b < myb ? 1 : 0;
#pragma unroll
        for (int e = 0; e < 8; ++e) { tot[e] += c[e]; pre[e] += m * c[e]; } }
    if (lane < 32) { const int go = myb * 32 + lane; const int4 a = *(const int4*)(cntW + (size_t)go * 8), c4 = *(const int4*)(cntW + (size_t)go * 8 + 4); const int c[8] = {a.x, a.y, a.z, a.w, c4.x, c4.y, c4.z, c4.w}; const int m = go < 4 * gw ? 1 : 0;
#pragma unroll
        for (int e = 0; e < 8; ++e) pre[e] += m * c[e]; }
#pragma unroll
    for (int e = 0; e < 8; ++e)
#pragma unroll
        for (int o = 32; o > 0; o >>= 1) { tot[e] += __builtin_amdgcn_ds_bpermute((lane << 2) ^ (o << 2), tot[e]); pre[e] += __builtin_amdgcn_ds_bpermute((lane << 2) ^ (o << 2), pre[e]); }
    int off[9]; { int o = 0;
#pragma unroll
        for (int e = 0; e < 8; ++e) { off[e] = o; o += ((tot[e] + 255) >> 8) << 8; } off[8] = o; }
    int* cw = (int*)p.ws;
    if (gw == 0 && lane == 0) cw[CW_NT] = off[8] >> 8;
    for (int t = bid_() * 512 + tid; t < 272; t += gridDim.x * 512) { int e = 0;
#pragma unroll
        for (int q = 1; q < 8; ++q) if (t * 256 >= off[q]) e = q;
        WSP(int, OFF_TILEE)[t] = e; }
    int base[8];
#pragma unroll
    for (int e = 0; e < 8; ++e) base[e] = off[e] + pre[e];
    const int j = lane & 15, G = gridDim.x, RPB = (TL + G - 1) / G, rbeg = bid_() * RPB, rend = rbeg + RPB < TL ? rbeg + RPB : TL;
    const unsigned char* xn8 = (const unsigned char*)WSP(bf16_t, OFF_XN); unsigned char* xs8 = (unsigned char*)SP(bf16_t, S_YS);
    for (int r0 = rbeg; r0 < rend;) { const int r1 = seg_end(r0, rend);
        for (int k0 = 0; r0 + p.wv * 4 + 32 * k0 < r1; k0 += 8) {
            const int r = r0 + p.wv * 4 + (lane >> 4) + 32 * (k0 + (j >> 1)); const bool ok = r < r1;
            const int e = ok ? WSP(int, OFF_TOKE)[r * 2 + (j & 1)] : -1; int pos = 0;
#pragma unroll
            for (int q = 0; q < 8; ++q) { const unsigned long long mk = __ballot(e == q); if (e == q) pos = base[q] + __popcll(mk & ((1ull << lane) - 1ull)); base[q] += __popcll(mk); }
            if (ok) { WSP(int, OFF_ROWIDX)[pos] = r; WSP(int, OFF_TOKS)[r * 2 + (j & 1)] = pos; }
#pragma unroll
            for (int q = 0; q < 64; ++q) { const int rq = __builtin_amdgcn_readlane(r, q), pq = __builtin_amdgcn_readlane(pos, q), okq = __builtin_amdgcn_readlane((int)ok, q);
                if (okq) *(uint4*)(xs8 + (size_t)pq * 1024 + lane * 16) = *(const uint4*)(xn8 + (size_t)rq * 1024 + lane * 16); }
        }
        r0 = r1; }
}
__device__ __forceinline__ void phase_postffn(const Params& p, lds_t* lds, int l) {
    const int tid = tid_(p.wv), lane = tid & 63, sl0 = lane & 15, G = gridDim.x;
    const int nrows = l == 0 ? RR : TL, RPB = (nrows + G - 1) / G;
    lds_fl* par = (lds_fl*)(lds + EW_PAR_OFF);
    const int rbeg = bid_() * RPB, rend = rbeg + RPB < nrows ? rbeg + RPB : nrows;
    for (int r0 = rbeg; r0 < rend;) { const int r1 = seg_end(r0, rend); const float* mod = WSP(float, OFF_MOD) + ((size_t)l * 5 + row_cond(r0)) * 6144; const float* mod1 = WSP(float, OFF_MOD) + ((size_t)5 + row_cond(r0)) * 6144;
        __syncthreads();
        for (int i = tid; i < 1024; i += 512) { par[i] = p.g_post_ffn[l * 1024 + i] * mod[5120 + i]; if (l == 0) { par[1024 + i] = p.g_pre_mix[1024 + i] * (1.f + mod1[1024 + i]); par[2048 + i] = mod1[i]; } }
        __syncthreads();
        for (int rw = r0 + p.wv * 4; rw < r1; rw += 32) {
            int sl = sl0; asm volatile("" : "+v"(sl));
            const int rr = rw + (lane >> 4); const bool ok = rr < r1; const int r = ok ? rr : r0;
            V8 y[8], hv[8]; float ss = 0;
            if (l == 0) {
#pragma unroll
                for (int i = 0; i < 8; ++i) y[i] = ld8_bf16(WSP(bf16_t, OFF_XN) + (size_t)r * 1024 + sl * 8 + 128 * i);
#pragma unroll
                for (int i = 0; i < 8; ++i) hv[i] = hx_load8(p, 1, r, sl * 8 + 128 * i);
            } else { const bf16_t* y0 = ys_row(p, WSP(int, OFF_TOKS)[r * 2]); const bf16_t* y1 = ys_row(p, WSP(int, OFF_TOKS)[r * 2 + 1]); const float w0 = WSP(float, OFF_TOKW)[r * 2], w1 = WSP(float, OFF_TOKW)[r * 2 + 1];
                pg8::u32x4 ya[8], yb[8];
#pragma unroll
                for (int i = 0; i < 8; ++i) { ya[i] = *(const pg8::u32x4*)(y0 + sl * 8 + 128 * i); yb[i] = *(const pg8::u32x4*)(y1 + sl * 8 + 128 * i); }
#pragma unroll
                for (int i = 0; i < 8; ++i) hv[i] = hx_load8(p, 1, r, sl * 8 + 128 * i);
#pragma unroll
                for (int i = 0; i < 8; ++i)
#pragma unroll
                    for (int e = 0; e < 4; ++e) { y[i].v[2 * e] = w0 * __uint_as_float(ya[i][e] << 16) + w1 * __uint_as_float(yb[i][e] << 16); y[i].v[2 * e + 1] = w0 * __uint_as_float(ya[i][e] & 0xffff0000u) + w1 * __uint_as_float(yb[i][e] & 0xffff0000u); } }
#pragma unroll
            for (int i = 0; i < 8; ++i) ss += sq8(y[i]);
            const float rstd = rsqrtf(qsum(ss) * (1.f / 1024.f) + EPS); float s2 = 0;
#pragma unroll
            for (int i = 0; i < 8; ++i) { const int k = sl * 8 + 128 * i; const V8 gg = lds8(par + k);
#pragma unroll
                for (int e = 0; e < 8; ++e) hv[i].v[e] += gg.v[e] * (y[i].v[e] * rstd);
                if (l == 0 && ok) hx_store8(p, r, k, hv[i]); s2 += sq8(hv[i]); }
            if (l == 1) {
                asm volatile("s_waitcnt vmcnt(0)" ::: "memory");
                if (ok) {
#pragma unroll
                    for (int i = 0; i < 8; ++i) st8_f32nt(p.out + (size_t)r * 1024 + sl * 8 + 128 * i, hv[i]); } }
            if (l == 0) { const float rstd2 = rsqrtf(qsum(s2) * (1.f / 1024.f) + EPS);
#pragma unroll
                for (int i = 0; i < 8; ++i) { const int k = sl * 8 + 128 * i; const V8 gg = lds8(par + 1024 + k), sh = lds8(par + 2048 + k); V8 v;
#pragma unroll
                    for (int e = 0; e < 8; ++e) v.v[e] = hv[i].v[e] * rstd2 * gg.v[e] + sh.v[e];
                    if (ok) st8_bf16(WSP(bf16_t, OFF_XN) + (size_t)r * 1024 + k, v); } }
        }
        r0 = r1; }
    __syncthreads();
}
constexpr size_t S_MODP = 0;
__device__ __forceinline__ void phase_pro_a(const Params& p, lds_t* lds) {
    const int gt = bid_() * 512 + tid_(p.wv), ng = gridDim.x * 512;
    const double PI2 = 6.283185307179586476925;
    for (int i = gt; i < 8192; i += ng) {
        if (i < 128 * 16) { const int co = i >> 4, j = i & 15; const double a = (double)co * pow(10000.0, -(double)j / 16.0); WSP(float2, OFF_ROPEW)[i] = make_float2((float)cos(a), (float)sin(a)); }
        if (i < 128 * 8) { const int co = i >> 3, j = i & 7; const double a = (double)co * pow(10000.0, -(double)j / 8.0); WSP(float2, OFF_ROPEM)[i] = make_float2((float)cos(a), (float)sin(a)); }
        if (i < 64 * 128) { const int n2 = i >> 7, k1 = i & 127; const double a = PI2 * (double)(k1 * n2) / 8192.0; WSP(float2, OFF_TW)[i] = make_float2((float)cos(a), (float)sin(a)); }
    }
    for (int i = gt; i < 512 * 256; i += ng) {
        if (i < 256 * 128) { const int m = i >> 7, n1 = i & 127, kb = m >> 6, ri = (m >> 5) & 1, k1 = kb * 32 + (m & 31); float sn, cs; sincospif((float)((k1 * n1) & 127) * (1.f / 64.f), &sn, &cs);
            WSP(bf16_t, OFF_FA)[i] = f2bf((ri ? -sn : cs) * (1.f / 724.0773439350247f)); }
        if (i < 128 * 128) { const int m = i >> 7, kc = i & 127, rio = m >> 6, k2 = m & 63, rii = kc >> 6, n2 = kc & 63; float sn, cs; sincospif((float)((n2 * k2) & 63) * (1.f / 32.f), &sn, &cs);
            WSP(bf16_t, OFF_GM)[i] = f2bf(rio == rii ? cs : (rio == 0 ? sn : -sn)); }
        { const int row = i >> 8, n = i & 255, ri = row >> 8, k = row & 255; float sn, cs; sincospif((float)((k * n) & 255) * (1.f / 128.f), &sn, &cs);
            WSP(bf16_t, OFF_FC)[i] = f2bf((ri ? -sn : cs) * (1.f / 128.f)); }
    }
    { const int t = tid_(p.wv); float2* trig = (float2*)lds;
      if (t < 64) { float sn, cs; sincospif((float)t * (1.f / 32.f), &sn, &cs); trig[t] = make_float2(cs, sn); }
      __syncthreads();
      for (int i = gt; i < 2 * 512 * 256; i += ng) { const int j = i & 255, row = (i >> 8) & 511, l = i >> 17, ri = row >> 8, g = (row >> 6) & 3, c = row & 63; float acc = 0;
#pragma unroll 8
        for (int cp = 0; cp < 64; ++cp) { const float2 tv = trig[(c * cp) & 63]; acc += (ri ? tv.y : tv.x) * p.w_fourier[(size_t)l * 65536 + (g * 64 + cp) * 256 + j]; }
        WSP(float, OFF_M12)[i] = acc; }
      __syncthreads(); }
    { const int t = tid_(p.wv), w = p.wv, lane = t & 63; float* sil = (float*)lds  , *red = (float*)lds + 5 * 1024;
      if (bid_() < 2 * 96) { for (int i = t; i < 5 * 1024; i += 512) { const int k = i / 5, r = i % 5; sil[i] = silu_f(r < 4 ? p.c[r * 1024 + k] : p.c_ctx[k]); } }
      __syncthreads();
      for (int it = bid_(); it < 2 * 96; it += gridDim.x) { const int l = it / 96, n = (it % 96) * 64 + lane; const float* W = p.w_mod + (size_t)l * 1024 * 6144 + n;
        float acc[5] = {0, 0, 0, 0, 0};
#pragma unroll 8
        for (int kk = 0; kk < 128; ++kk) { const int k = w * 128 + kk; const float wv = W[(size_t)k * 6144];
#pragma unroll
            for (int r = 0; r < 5; ++r) acc[r] += sil[k * 5 + r] * wv; }
        __syncthreads();
#pragma unroll
        for (int r = 0; r < 5; ++r) red[(w * 5 + r) * 64 + lane] = acc[r];
        __syncthreads();
        if (t < 320) { const int r = t >> 6; float a = p.b_mod[l * 6144 + n];
#pragma unroll
            for (int ww = 0; ww < 8; ++ww) a += red[(ww * 5 + r) * 64 + lane];
            WSP(float, OFF_MOD)[((size_t)l * 5 + r) * 6144 + n] = a; } }
      __syncthreads(); }
    phase_cvt(p, lds, 0, gridDim.x == 256 ? CVT_MOE0 : CVT_TOT, bid_(), gridDim.x);
}
__device__ __forceinline__ void phase_pro_b(const Params& p, lds_t* lds) {
    const int tid = tid_(p.wv), hk = tid >> 8, o4 = (tid & 255) * 4;
    typedef __attribute__((address_space(3))) float lds_f;
    lds_f* mrow = (lds_f*)lds;
    for (int it = bid_(); it < 2 * 64; it += gridDim.x) { const int l = it >> 6, k0 = (it & 63) * 8;
        __syncthreads();
        for (int i = tid; i < 8 * 256; i += 512) mrow[i] = ld_f(WSP(float, OFF_M12) + ((size_t)l * 512 + k0) * 256 + i);
        __syncthreads();
        const float* wo = p.w_out + (size_t)l * 1024 * 1024 + o4; const lds_f* m = mrow + hk * 4 * 256;
        float4 acc[4];
#pragma unroll
        for (int q = 0; q < 4; ++q) acc[q] = make_float4(0.f, 0.f, 0.f, 0.f);
#pragma unroll 8
        for (int j = 0; j < 256; ++j) { const float4 w4 = *(const float4*)(wo + (size_t)j * 1024);
#pragma unroll
            for (int q = 0; q < 4; ++q) { const float mv = m[q * 256 + j]; acc[q].x += mv * w4.x; acc[q].y += mv * w4.y; acc[q].z += mv * w4.z; acc[q].w += mv * w4.w; } }
#pragma unroll
        for (int q = 0; q < 4; ++q) *(float4*)(WSP(float, OFF_WOF) + ((size_t)l * 512 + k0 + hk * 4 + q) * 1024 + o4) = acc[q];
    }
    __syncthreads();
}
__device__ __forceinline__ void phase_cvt_wof(const Params& p, lds_t* lds) {
    const int t = tid_(p.wv), lane = t & 63, gw = bid_() * 8 + p.wv, nw = gridDim.x * 8, kq = lane >> 4, oc = (lane & 15) * 4;
    unsigned char* T = (unsigned char*)lds + p.wv * 9216;
    for (int ti = gw; ti < 2 * 20 * 16; ti += nw) { const int l = ti / 320, kb = (ti % 320) / 16, ob = ti % 16, k0 = kb * 64, o0 = ob * 64;
        const float* src = k0 < 512 ? WSP(float, OFF_WOF) + ((size_t)l * 512 + k0) * 1024 : p.w_out + (size_t)l * 1024 * 1024 + (size_t)(k0 - 256) * 1024;
        float4 v[16];
#pragma unroll
        for (int q = 0; q < 16; ++q) v[q] = *(const float4*)(src + (size_t)(16 * (q >> 2) + 4 * kq + (q & 3)) * 1024 + o0 + oc);
        cvt_wave_store(v, false, WP(W_O) + (size_t)l * 1024 * 1280, 1280, o0, k0, T, lane);
    }
    __syncthreads();
}

#define XB_TMO      128
#define XB_XCNT(j)  (256  + 64 * (j))
#define XB_XSUB(j)  (1280 + 64 * (j))
#define XB_XGEN(j)  (2304 + 64 * (j))
#define XB_TOP      3328
#define XB_TOPGEN   3392
#define XCD_BAR_WORDS 3456
#define XB_SPIN_CAP (1u << 20)
#define LAS __attribute__((address_space(3)))
__device__ __forceinline__ unsigned xb_ld(unsigned* p)              { return __hip_atomic_load(p, __ATOMIC_RELAXED, __HIP_MEMORY_SCOPE_AGENT); }
__device__ __forceinline__ unsigned xb_add(unsigned* p, unsigned v) { return __hip_atomic_fetch_add(p, v, __ATOMIC_RELAXED, __HIP_MEMORY_SCOPE_AGENT); }
__device__ __forceinline__ unsigned xb_xcc_id() { return (unsigned)__builtin_amdgcn_s_getreg((3 << 11) | 20) & 0xFu; }
#define XB_SPIN(cond, bar) do { unsigned _sp = 0; while (cond) { __builtin_amdgcn_s_sleep(1); \
    if ((++_sp & 255u) == 0u) { if (xb_ld(&(bar)[XB_TMO])) break; if (_sp > XB_SPIN_CAP) { atomicAdd(&(bar)[XB_TMO], 1u); break; } } } } while (0)
struct XcdBarrier { unsigned* bar; unsigned x; volatile LAS unsigned* st; int wv; };
__device__ __forceinline__ XcdBarrier xcd_barrier_post(unsigned* bar, volatile LAS unsigned* st, int wv) {
    XcdBarrier b; b.bar = bar; b.x = xb_xcc_id(); b.st = st; b.wv = wv;
    if (tid_(wv) == 0) (void)xb_add(&bar[XB_XCNT(b.x)], 1u);
    return b;
}
__device__ __forceinline__ void xcd_barrier_complete(unsigned* bar, unsigned x, unsigned& nloc, unsigned& nx) {
    const unsigned G = gridDim.x * gridDim.y * gridDim.z;
    unsigned sum, cnt, mine, sp = 0u;
    for (;;) {
        sum = 0u; cnt = 0u; mine = 0u;
#pragma unroll
        for (unsigned j = 0; j < 16; ++j) { const unsigned c = xb_ld(&bar[XB_XCNT(j)]); sum += c; cnt += (c > 0u) ? 1u : 0u; mine = (j == x) ? c : mine; }
        if (sum == G) break;
        __builtin_amdgcn_s_sleep(1);
        if ((++sp & 255u) == 0u) { if (xb_ld(&bar[XB_TMO])) break; if (sp > XB_SPIN_CAP) { atomicAdd(&bar[XB_TMO], 1u); break; } }
    }
    nloc = mine > 0u ? mine : 1u; nx = cnt > 0u ? cnt : 1u;
}
__device__ __forceinline__ void xcd_barrier(const XcdBarrier& b) {
    asm volatile("s_waitcnt vmcnt(0)" ::: "memory");
    __syncthreads();
    if (tid_(b.wv) == 0) {
        unsigned* bar = b.bar; unsigned bx = b.x; asm volatile("" : "+s"(bx));
        __builtin_amdgcn_s_waitcnt(0);
        unsigned nloc = b.st[0], nx = b.st[1];
        if (nloc == 0u) { xcd_barrier_complete(bar, bx, nloc, nx); b.st[0] = nloc; b.st[1] = nx; }
        const unsigned old = xb_add(&bar[XB_XSUB(bx)], 1u);
        const unsigned gen = old / nloc;
        if (old + 1u == (gen + 1u) * nloc) {
            __builtin_amdgcn_fence(__ATOMIC_RELEASE, "agent");
            asm volatile("s_waitcnt vmcnt(0)" ::: "memory");
            const unsigned og = xb_add(&bar[XB_TOP], 1u);
            const unsigned tg = og / nx;
            if (og + 1u == (tg + 1u) * nx) xb_add(&bar[XB_TOPGEN], 1u);
            else XB_SPIN(xb_ld(&bar[XB_TOPGEN]) == tg, bar);
            __builtin_amdgcn_fence(__ATOMIC_ACQUIRE, "agent");
            xb_add(&bar[XB_XGEN(bx)], 1u);
            asm volatile("s_waitcnt vmcnt(0)" ::: "memory");
        } else {
            XB_SPIN(xb_ld(&bar[XB_XGEN(bx)]) == gen, bar);
            __builtin_amdgcn_fence(__ATOMIC_ACQUIRE, "agent");
            asm volatile("s_waitcnt vmcnt(0)" ::: "memory");
        }
    }
    __syncthreads();
}


constexpr int LDS_BAR_OFF = 131072 + 8192;
__global__ void __launch_bounds__(OPT_THREADS, 2) mk_fwd(Params p) {
    extern __shared__ __attribute__((aligned(16))) unsigned char lds_raw[];
    lds_t* lds = (lds_t*)lds_raw;
    p.wv = __builtin_amdgcn_readfirstlane(threadIdx.x >> 6);
    volatile LAS unsigned* bst = (volatile LAS unsigned*)(lds + LDS_BAR_OFF);
    { const int t0_ = tid_(p.wv); if (t0_ < 4) bst[t0_] = 0u; }
    __syncthreads();
    XcdBarrier bar = xcd_barrier_post((unsigned*)p.ws, bst, p.wv);
#define LP() ({ Params q_ = p; unsigned long long w_ = (unsigned long long)(uintptr_t)q_.ws; asm volatile("" : "+s"(w_)); \
    q_.ws = (char*)(uintptr_t)(((unsigned long long)(unsigned)__builtin_amdgcn_readfirstlane((int)(w_ >> 32)) << 32) | (unsigned)__builtin_amdgcn_readfirstlane((int)w_)); q_; })
#define REPN(bit) ([]() { int n_ = 1 + ((MK_REP >> (bit)) & 1); asm volatile("" : "+s"(n_)); return n_; }())
#define REP(bit, stmt) do { const int n__ = REPN(bit); _Pragma("unroll 1") for (int rep_ = 0; rep_ < n__; ++rep_) { stmt; } } while (0)
    REP(0, phase_pro_a(LP(), lds));
    xcd_barrier(bar);
    REP(8, phase_pro_b(LP(), lds)); REP(13, phase_norm1(LP(), lds, 0));
    xcd_barrier(bar);
#pragma unroll 1
    for (int l = 0; l < 2; ++l) {
        REP(1, phase_inproj(LP(), lds, l)); if (l == 0) cvt_in_tail(LP(), lds, 132 * 7, 0, 1800);
        xcd_barrier(bar);
        if (l == 0) phase_cvt_wof(LP(), lds);
        REP(2, phase_up(LP(), lds, l)); REP(10, phase_fft_a(LP(), lds)); REP(11, phase_sgu(LP(), lds, l)); if (l == 0) phase_dft_ctx(LP(), lds);
        xcd_barrier(bar);
        REP(3, phase_mla(LP(), lds, l)); REP(4, phase_win(LP(), lds, l)); REP(12, phase_fft_c(LP(), lds));
        xcd_barrier(bar);
        REP(5, phase_outproj(LP(), lds, l)); if (l == 0) cvt_in_tail(LP(), lds, 132 * 4, 1800, 5500);
        xcd_barrier(bar);
        if (l == 0) { REP(9, phase_postmix(LP(), lds, l)); } else phase_postmix(LP(), lds, l);
        xcd_barrier(bar);
        if (l == 0) {
            REP(6, phase_ffn_gu_dense(LP(), lds)); cvt_in_tail(LP(), lds, 132 * 28, 5500, 8500); xcd_barrier(bar);
            REP(6, phase_ffn_dn_dense(LP(), lds)); cvt_in_tail(LP(), lds, 132 * 4, 8500, CVT_TOT - CVT_MOE0); xcd_barrier(bar);
        } else {
            phase_moe_assign(LP()); xcd_barrier(bar);
            REP(7, phase_moe_gu(p, lds)); xcd_barrier(bar);
            REP(7, phase_moe_dn(p, lds)); xcd_barrier(bar);
        }
        phase_postffn(LP(), lds, l);
        if (l == 0) xcd_barrier(bar);
    }
#ifdef MK_XBAR
#pragma unroll 1
    for (int i = 0; i < MK_XBAR; ++i) xcd_barrier(bar);
#endif
}

template <int PH>
__global__ void __launch_bounds__(OPT_THREADS, 2) opt_k(Params p, int l, int a0) {
    extern __shared__ __attribute__((aligned(16))) unsigned char lds_raw[];
    lds_t* lds = (lds_t*)lds_raw;
    p.wv = __builtin_amdgcn_readfirstlane(threadIdx.x >> 6);
    if constexpr (PH == PH_CVT) phase_cvt(p, lds, 0, CVT_TOT, blockIdx.x, gridDim.x);
    if constexpr (PH == PH_FFN_GU) phase_ffn_gu_dense(p, lds);
    if constexpr (PH == PH_FFN_DN) phase_ffn_dn_dense(p, lds);
    if constexpr (PH == PH_MOE_GU) phase_moe_gu(p, lds);
    if constexpr (PH == PH_MOE_DN) phase_moe_dn(p, lds);
    if constexpr (PH == PH_INPROJ) phase_inproj(p, lds, l);
    if constexpr (PH == PH_UP) phase_up(p, lds, l);
    if constexpr (PH == PH_OUTPROJ) phase_outproj(p, lds, l);
    if constexpr (PH == PH_MLA) phase_mla(p, lds, l);
    if constexpr (PH == PH_WIN) phase_win(p, lds, l);
    if constexpr (PH == PH_FFTA) phase_fft_a(p, lds);
    if constexpr (PH == PH_FFTC) phase_fft_c(p, lds);
    if constexpr (PH == PH_DFTC) phase_dft_ctx(p, lds);
    if constexpr (PH == PH_SGU) phase_sgu(p, lds, l);
    if constexpr (PH == PH_PROA) phase_pro_a(p, lds);
    if constexpr (PH == PH_PROB) { phase_pro_b(p, lds); }
    if constexpr (PH == PH_NORM1) { if (l == 0 && a0 == 1) phase_cvt_wof(p, lds); }
    if constexpr (PH == PH_NORM1) phase_norm1(p, lds, l);
    if constexpr (PH == PH_POSTMIX) phase_postmix(p, lds, l);
    if constexpr (PH == PH_ASSIGN) phase_moe_assign(p);
    if constexpr (PH == PH_POSTFFN) phase_postffn(p, lds, l);
}
template <int PH> static void launch_opt(const Params& p, int l, int a0, hipStream_t stream) {
    static bool init = false;
    if (!init) { (void)hipFuncSetAttribute((const void*)opt_k<PH>, hipFuncAttributeMaxDynamicSharedMemorySize, OPT_LDS); init = true; }
    hipLaunchKernelGGL(opt_k<PH>, dim3(256), dim3(OPT_THREADS), OPT_LDS, stream, p, l, a0);
}

constexpr bool USE_MK = true;
extern "C" void kernel_launch(void* const* d_in, const int* in_sizes, int n_in, void* d_out, int out_size, void* d_ws, size_t ws_size, hipStream_t stream) {
    if (n_in != 27 || ws_size < WS_NEED) { fprintf(stderr, "kernel_launch: bad args n_in %d ws %zu need %zu\n", n_in, ws_size, WS_NEED); return; }
    Params p{};
    const float** pp = (const float**)&p;
    for (int i = 0; i < 27; ++i) pp[i] = (const float*)d_in[i];
    p.out = (float*)d_out; p.ws = (char*)d_ws;
    if (USE_MK) {
        static int grid = 0;
        if (!grid) {
            int dev = 0, cus = 0, per_cu = 0;
            hipGetDevice(&dev); hipDeviceGetAttribute(&cus, hipDeviceAttributeMultiprocessorCount, dev);
            if (hipFuncSetAttribute((const void*)mk_fwd, hipFuncAttributeMaxDynamicSharedMemorySize, OPT_LDS) != hipSuccess) { fprintf(stderr, "kernel_launch: hipFuncSetAttribute failed\n"); return; }
            if (hipOccupancyMaxActiveBlocksPerMultiprocessor(&per_cu, (const void*)mk_fwd, OPT_THREADS, OPT_LDS) != hipSuccess || per_cu < 1) fprintf(stderr, "kernel_launch: note: occupancy query says %d blocks per CU; launching one per CU anyway\n", per_cu);
            grid = cus > 0 ? cus : 256;
        }
        hipMemsetAsync(d_ws, 0, 65536, stream);
        hipLaunchKernelGGL(mk_fwd, dim3(grid), dim3(OPT_THREADS), OPT_LDS, stream, p);
        return;
    }
    hipMemsetAsync(d_ws, 0, 65536, stream);
    launch_opt<PH_PROA>(p, 0, 0, stream);
    launch_opt<PH_PROB>(p, 0, 0, stream);
    launch_opt<PH_NORM1>(p, 0, 1, stream);
    for (int l = 0; l < 2; ++l) {
        launch_opt<PH_INPROJ>(p, l, 0, stream);
        launch_opt<PH_UP>(p, l, 0, stream);
        launch_opt<PH_SGU>(p, l, 0, stream);
        launch_opt<PH_FFTA>(p, l, 0, stream);
        launch_opt<PH_FFTC>(p, l, 0, stream);
        if (l == 0) launch_opt<PH_DFTC>(p, l, 0, stream);
        launch_opt<PH_WIN>(p, l, 0, stream);
        launch_opt<PH_MLA>(p, l, 0, stream);
        launch_opt<PH_OUTPROJ>(p, l, 0, stream);
        launch_opt<PH_POSTMIX>(p, l, 0, stream);
        if (l == 0) {
            launch_opt<PH_FFN_GU>(p, l, 0, stream);
            launch_opt<PH_FFN_DN>(p, l, 0, stream);
        } else {
            launch_opt<PH_ASSIGN>(p, l, 0, stream);
            launch_opt<PH_MOE_GU>(p, l, 0, stream);
            launch_opt<PH_MOE_DN>(p, l, 0, stream);
        }
        launch_opt<PH_POSTFFN>(p, l, 0, stream);
    }
}
```

```cpp
#include <hip/hip_runtime.h>
#include <stdint.h>
#include <stdio.h>

typedef unsigned short bf16_t;
#ifndef MK_REP
#define MK_REP 0
#endif
constexpr int TL = 32768, TC = 1024, RR = TL + TC, DM = 1024, NKEY = 8448, DFF = 3584, NE = 8, DIN = 1696;
constexpr int NSORT = 264 * 256;
constexpr float EPS = 1e-6f;

__device__ __forceinline__ float bf2f(bf16_t v) { return __uint_as_float(((unsigned)v) << 16); }
__device__ __forceinline__ bf16_t f2bf(float f) { unsigned u = __float_as_uint(f); u += 0x7fffu + ((u >> 16) & 1u); return (bf16_t)(u >> 16); }
__device__ __forceinline__ int row_cond(int r) { return r < TL ? (r >> 13) : 4; }
__device__ __forceinline__ int row_batch(int r) { return r < TL ? (r >> 13) : ((r - TL) >> 8); }
__device__ __forceinline__ int row_key(int r) { return r < TL ? (r & 8191) : 8192 + ((r - TL) & 255); }
__device__ __forceinline__ float silu_f(float x) { return x / (1.f + __expf(-x)); }
__device__ __forceinline__ float gelu_f(float x) { return 0.5f * x * (1.f + erff(x * 0.70710678118654752f)); }

constexpr size_t al256(size_t x) { return (x + 255) / 256 * 256; }
constexpr size_t OFF_CTL = 0;
constexpr size_t OFF_MOD = OFF_CTL + 65536;
constexpr size_t OFF_ROPEW = OFF_MOD + al256(2 * 5 * 6144 * 4);
constexpr size_t OFF_ROPEM = OFF_ROPEW + 128 * 16 * 8;
constexpr size_t OFF_TW = OFF_ROPEM + 128 * 8 * 8;
constexpr size_t OFF_CS8K = OFF_TW + 64 * 128 * 8;
constexpr size_t OFF_FA = OFF_CS8K + 8192 * 8;
constexpr size_t OFF_GM = OFF_FA + 256 * 128 * 2;
constexpr size_t OFF_FC = OFF_GM + 128 * 128 * 2;
constexpr size_t OFF_M12 = OFF_FC + 512 * 256 * 2;
constexpr size_t OFF_HXC = OFF_M12 + 2 * 512 * 256 * 4;
constexpr size_t OFF_WOF = OFF_HXC + 1024 * 1024 * 4;
constexpr size_t OFF_TOKE = OFF_WOF + (size_t)2 * 512 * 1024 * 4;
constexpr size_t OFF_TOKW = OFF_TOKE + TL * 2 * 4;
constexpr size_t OFF_TOKS = OFF_TOKW + TL * 2 * 4;
constexpr size_t OFF_ROWIDX = OFF_TOKS + TL * 2 * 4;
constexpr size_t OFF_TILEE = OFF_ROWIDX + NSORT * 4;
constexpr size_t OFF_SSQQ = OFF_TILEE + al256(272 * 4);
constexpr size_t OFF_SSQKV = OFF_SSQQ + (size_t)RR * 16;
constexpr size_t OFF_LNS = OFF_SSQKV + (size_t)RR * 16;
constexpr size_t OFF_XN = OFF_LNS + (size_t)RR * 32;
constexpr size_t OFF_W = OFF_XN + (size_t)RR * 1024 * 2;
constexpr size_t W_BYTES = (size_t)2 * 1792 * 1024 * 2 + (size_t)2 * 1024 * 384 * 2 + (size_t)2 * 1024 * 1280 * 2 + (size_t)7168 * 1024 * 2 + (size_t)1024 * 3584 * 2 + (size_t)8 * 7168 * 1024 + (size_t)8 * 1024 * 3584;
constexpr size_t OFF_S = OFF_W + W_BYTES;
constexpr size_t S_CAT = 0;
constexpr size_t S_ABUF = S_CAT + (size_t)RR * 1280 * 2;
constexpr size_t S_QW = S_ABUF + (size_t)RR * 256 * 2;
constexpr size_t S_KW = S_QW + (size_t)RR * 256 * 2;
constexpr size_t S_VW = S_KW + (size_t)4 * NKEY * 128 * 2;
constexpr size_t S_C2 = S_VW + (size_t)4 * NKEY * 128 * 2;
constexpr size_t S_KM = S_C2 + (size_t)RR * 384 * 2;
constexpr size_t S_VM = S_KM + (size_t)16 * NKEY * 96 * 2;
constexpr size_t S_U = S_VM + (size_t)16 * NKEY * 64 * 2;
constexpr size_t S_VG = S_U + (size_t)RR * 256 * 2;
constexpr size_t S_QM = S_VG + (size_t)RR * 256 * 2;
constexpr size_t S_UP = S_QM + (size_t)RR * 384 * 2;
constexpr size_t S_END_MIX = S_UP + (size_t)4 * 128 * 2 * 64 * 256 * 2;
constexpr size_t S_MX = S_ABUF;
constexpr size_t S_H = 0;
constexpr size_t S_YS = S_H + (size_t)RR * 3584 * 2;
constexpr size_t S_END = S_YS + (size_t)NSORT * 1024 * 2;
static_assert(S_END_MIX <= S_END, "S region");
static_assert(S_MX + (size_t)RR * 1024 * 2 <= S_END_MIX, "MX overlay");
static_assert((size_t)NSORT * 3584 <= (size_t)RR * 3584 * 2, "fp8 H fits");
constexpr size_t WS_NEED = OFF_S + S_END;

constexpr int CW_CNT = 4096;
constexpr int CW_CUR = 4112;
constexpr int CW_OFF = 4128;
constexpr int CW_NT = 4144;

struct Params {
    const float *x, *c, *ctx, *c_ctx, *w_mod, *b_mod, *g_pre_mix, *g_post_mix, *g_pre_ffn, *g_post_ffn, *w_in, *w_out, *w_fourier, *win_sink,
        *mla_g_q, *mla_g_kv, *mla_w_uq, *mla_w_ukv, *sgu_w, *sgu_b, *ffn_w_gate, *ffn_w_up, *ffn_w_down, *moe_w_router, *moe_w_gate, *moe_w_up, *moe_w_down;
    float* out; char* ws;
    int wv, pad_;
};
#define WSP(T, off) ((T*)(p.ws + (off)))
#define SP(T, off) ((T*)(p.ws + OFF_S + (off)))

__device__ __forceinline__ float sum4(const float* q) { return (q[0] + q[1]) + (q[2] + q[3]); }
__device__ __forceinline__ int ld_i(const int* q) { return __hip_atomic_load(q, __ATOMIC_RELAXED, __HIP_MEMORY_SCOPE_AGENT); }
__device__ __forceinline__ float ld_f(const float* q) { return __hip_atomic_load(q, __ATOMIC_RELAXED, __HIP_MEMORY_SCOPE_AGENT); }
__device__ __forceinline__ int bid_() { int b = blockIdx.x; asm volatile("" : "+s"(b)); return b; }
__device__ __forceinline__ int lane_() { int l; asm volatile("v_mbcnt_lo_u32_b32 %0, -1, 0\n\tv_mbcnt_hi_u32_b32 %0, -1, %0" : "=v"(l)); return l; }
__device__ __forceinline__ int tid_(int wv) { return (wv << 6) | lane_(); }
namespace pg8 {
#define PG8_LAS __attribute__((address_space(3)))
typedef short bf16x8 __attribute__((ext_vector_type(8)));
typedef float f32x4 __attribute__((ext_vector_type(4)));
typedef unsigned u32x4 __attribute__((ext_vector_type(4)));
typedef unsigned u32x2 __attribute__((ext_vector_type(2)));
typedef int v8i_t __attribute__((ext_vector_type(8)));
typedef int v4i_t __attribute__((ext_vector_type(4)));
constexpr int BM = 256, BK = 64, HALF = 128, HTB = HALF * BK * 2, STAGE_BYTES = 8 * HTB, NXCD = 8, WGM = 8;
__host__ __device__ __forceinline__ int lds_byte(int r, int c) { const int st = (r >> 4) * 2 + (c >> 5), rr = r & 15, cc = c & 31, ob = rr * 64 + cc * 2; return st * 1024 + (ob ^ (((ob >> 9) & 1) << 5)); }
__host__ __device__ __forceinline__ void stage_rc(int b, int& R, int& C) { const int st = b / 1024, sb = b % 1024, swz = sb ^ (((sb >> 9) & 1) << 5); R = (st >> 1) * 16 + swz / 64; C = (st & 1) * 32 + (swz % 64) / 2; }
__host__ __device__ __forceinline__ int perm32(int rho) { const int n = rho >> 4, i = rho & 15; return 8 * (i >> 2) + 4 * n + (i & 3); }
struct Unit { int pm, pn; };
struct Gemm { int lda, ldb, K, wv; };
__device__ __forceinline__ unsigned cvt_pk_bf16(float lo, float hi) { unsigned r; asm volatile("v_cvt_pk_bf16_f32 %0, %1, %2" : "=v"(r) : "v"(lo), "v"(hi)); return r; }

struct OrderBase {
    int nM, nN, nwg, G, c;
    __device__ void init(int nM_, int nN_, int G_, int c_) { nM = nM_; nN = nN_; nwg = nM * nN; G = G_; c = c_; }
    __device__ bool next(int i, Unit& u) const {
        const long L = (long)i * G + c; if (L >= nwg) return false;
        int wgid = (int)L; { const int q = nwg / NXCD, r = nwg % NXCD, xcd = wgid % NXCD, off = wgid / NXCD; wgid = (xcd < r ? xcd * (q + 1) : r * (q + 1) + (xcd - r) * q) + off; }
        const int nig = WGM * nN, gid = wgid / nig, fm = gid * WGM, gsz = (nM - fm) < WGM ? (nM - fm) : WGM;
        u.pm = fm + ((wgid % nig) % gsz); u.pn = (wgid % nig) / gsz; return true;
    }
};

__device__ __forceinline__ void glds16_s(const char* sbase, unsigned voff, unsigned lds_addr) {
    unsigned keep;
    asm volatile("s_mov_b32 %0, m0\n\ts_mov_b32 m0, %3\n\ts_nop 0\n\tglobal_load_lds_dwordx4 %1, %2\n\ts_mov_b32 m0, %0" : "=&s"(keep) : "v"(voff), "s"(sbase), "s"(lds_addr) : "memory");
}
template <class Epi, class Sched, bool GATHER, bool FP8 = false>
__device__ __forceinline__ void gemm_phase(PG8_LAS unsigned char* lds, const Gemm g, const Sched& S, const Epi& E) {
    int wid_ = g.wv; asm volatile("" : "+s"(wid_));
    const int tid = tid_(g.wv), wid = wid_, lane = tid & 63, wr = wid >> 2, wc = wid & 3, fr = lane & 15, fq = lane >> 4;
    const int K = g.K, nt = K / BK;
    int mxs = 0x7f7f7f7f; asm volatile("" : "+v"(mxs));
    unsigned voffA[2], voffB[2]; int RA[2];
#pragma unroll
    for (int i = 0; i < 2; ++i) { int R, C; stage_rc(tid * 16 + i * 8192, R, C); const int Rb = Epi::PERM ? ((R & ~31) + perm32(R & 31)) : R;
        RA[i] = R; voffA[i] = GATHER ? (unsigned)(C * 2) : (unsigned)(R * g.lda + C) * 2u; voffB[i] = (unsigned)(Rb * g.ldb + C) * 2u; }
    const size_t kstep = (size_t)(BK * 2);
    const size_t hstepA = GATHER ? 0 : (size_t)HALF * g.lda * 2, hstepB = (size_t)HALF * g.ldb * 2, rstepA = (size_t)64 * g.lda * 2, rstepB = (size_t)64 * g.ldb * 2;
    const unsigned ldsw = (unsigned)wid * 1024u, ldsbase = (unsigned)(uintptr_t)lds;
    const int aoff = lds_byte(wr * 64 + fr, fq * 8), boff = lds_byte(wc * 32 + fr, fq * 8);
    unsigned gC[2] = {0, 0}, gN[2] = {0, 0};
#define PG8_SA(b, h) (((b) * 2 + (h)) * HTB)
#define PG8_SB(b, h) ((4 + (b) * 2 + (h)) * HTB)
#define PG8_STAGE_B(bufoff, gbase) do { _Pragma("unroll") for (int _i = 0; _i < 2; ++_i) { \
        if constexpr (FP8) glds16_s((const char*)(gbase) + _i * rstepB, voffB[0], ldsbase + (unsigned)(bufoff) + ldsw + _i * 8192u); \
        else __builtin_amdgcn_global_load_lds((const unsigned*)((const char*)(gbase) + _i * rstepB + voffB[0]), (PG8_LAS unsigned*)(lds + (bufoff) + ldsw + _i * 8192), 16, 0, 0); } } while (0)
#define PG8_STAGE_A(bufoff, gbase, h, usenext) do { _Pragma("unroll") for (int _i = 0; _i < 2; ++_i) { \
        const unsigned _o = GATHER ? voffA[0] + ((((usenext) ? gN[h] : gC[h]) >> (16 * _i)) & 0xffffu) * (unsigned)(g.lda * 2) : voffA[0]; \
        if constexpr (FP8) glds16_s((const char*)(gbase) + (h) * hstepA + (GATHER ? 0 : _i) * rstepA, _o, ldsbase + (unsigned)(bufoff) + ldsw + _i * 8192u); \
        else __builtin_amdgcn_global_load_lds((const unsigned*)((const char*)(gbase) + (h) * hstepA + (GATHER ? 0 : _i) * rstepA + _o), (PG8_LAS unsigned*)(lds + (bufoff) + ldsw + _i * 8192), 16, 0, 0); } } while (0)
#define PG8_LDA(dst, b, h) do { _Pragma("unroll") for (int m = 0; m < 4; ++m) { if constexpr (FP8) { const v4i_t lo_ = *(const PG8_LAS v4i_t*)(lds + PG8_SA(b, h) + aoff + m * 2048), hi_ = *(const PG8_LAS v4i_t*)(lds + PG8_SA(b, h) + aoff + m * 2048 + 1024); \
        dst##8[m] = __builtin_shufflevector(lo_, hi_, 0, 1, 2, 3, 4, 5, 6, 7); } else { _Pragma("unroll") for (int k = 0; k < 2; ++k) dst[m][k] = *(const PG8_LAS bf16x8*)(lds + PG8_SA(b, h) + aoff + m * 2048 + k * 1024); } } } while (0)
#define PG8_LDB(dst, b, h) do { _Pragma("unroll") for (int n = 0; n < 2; ++n) { if constexpr (FP8) { const v4i_t lo_ = *(const PG8_LAS v4i_t*)(lds + PG8_SB(b, h) + boff + n * 2048), hi_ = *(const PG8_LAS v4i_t*)(lds + PG8_SB(b, h) + boff + n * 2048 + 1024); \
        dst##8[n] = __builtin_shufflevector(lo_, hi_, 0, 1, 2, 3, 4, 5, 6, 7); } else { _Pragma("unroll") for (int k = 0; k < 2; ++k) dst[n][k] = *(const PG8_LAS bf16x8*)(lds + PG8_SB(b, h) + boff + n * 2048 + k * 1024); } } } while (0)
#define PG8_MMA(ai, bj, At, Bt) do { __builtin_amdgcn_s_setprio(1); _Pragma("unroll") for (int m = 0; m < 4; ++m) _Pragma("unroll") for (int n = 0; n < 2; ++n) { \
        if constexpr (FP8) acc[ai][bj][m][n] = __builtin_amdgcn_mfma_scale_f32_16x16x128_f8f6f4(Bt##8[n], At##8[m], acc[ai][bj][m][n], 0, 0, 0, mxs, 0, mxs); \
        else { _Pragma("unroll") for (int k = 0; k < 2; ++k) acc[ai][bj][m][n] = __builtin_amdgcn_mfma_f32_16x16x32_bf16(Bt[n][k], At[m][k], acc[ai][bj][m][n], 0, 0, 0); } } \
        __builtin_amdgcn_s_setprio(0); } while (0)
#define PG8_WAIT_V(n) asm volatile("s_waitcnt vmcnt(" #n ")" ::: "memory")
#define PG8_WAIT_L(n) asm volatile("s_waitcnt lgkmcnt(" #n ")" ::: "memory")
#define PG8_BAR __builtin_amdgcn_s_barrier()
#define PG8_SCHED __builtin_amdgcn_sched_barrier(0)
    Unit cur, nxt; int ui = 0;
    if (!S.next(0, cur)) return;
    f32x4 acc[2][2][4][2];
#pragma unroll
    for (int a = 0; a < 2; ++a)
#pragma unroll
        for (int b = 0; b < 2; ++b)
#pragma unroll
            for (int m = 0; m < 4; ++m)
#pragma unroll
                for (int n = 0; n < 2; ++n) acc[a][b][m][n] = (f32x4){0.f, 0.f, 0.f, 0.f};
    bf16x8 At[4][2], B0[2][2], B1[2][2]; v8i_t At8[4], B08[2], B18[2];
    const char* cA = S.a_base(cur); const char* cB = S.b_base(cur);
    if constexpr (GATHER) {
#pragma unroll
        for (int h = 0; h < 2; ++h) gC[h] = (unsigned)S.row(cur, h * HALF + RA[0]) | ((unsigned)S.row(cur, h * HALF + RA[1]) << 16);
    }
    PG8_STAGE_B(PG8_SB(0, 0), cB); PG8_STAGE_B(PG8_SB(0, 1), cB + hstepB); PG8_STAGE_A(PG8_SA(0, 0), cA, 0, false); PG8_STAGE_A(PG8_SA(0, 1), cA, 1, false);
    if (wr == 1) PG8_BAR;
    PG8_WAIT_V(2); PG8_BAR;
    PG8_STAGE_B(PG8_SB(1, 0), cB + kstep); PG8_STAGE_A(PG8_SA(1, 0), cA + kstep, 0, false); PG8_STAGE_B(PG8_SB(1, 1), cB + hstepB + kstep);
    PG8_WAIT_V(6); PG8_BAR;
    for (;;) {
        const bool has_next = S.next(ui + 1, nxt);
        if (!has_next) nxt = cur;
        const char* nA = S.a_base(nxt); const char* nB = S.b_base(nxt);
        if constexpr (GATHER) { int R0_, R1_, C_; const int t3_ = tid_(g.wv); stage_rc(t3_ * 16, R0_, C_); stage_rc(t3_ * 16 + 8192, R1_, C_);
#pragma unroll
            for (int h = 0; h < 2; ++h) gN[h] = (unsigned)S.row(nxt, h * HALF + R0_) | ((unsigned)S.row(nxt, h * HALF + R1_) << 16);
        }
        asm volatile(".p2align 8");
#pragma unroll 1
        for (int t = 0; t < nt; t += 2) {
            const bool last = (t == nt - 2);
            const char* a1 = cA + (size_t)(t + 1) * kstep;
            const char* a2 = last ? nA : cA + (size_t)(t + 2) * kstep; const char* b2 = last ? nB : cB + (size_t)(t + 2) * kstep;
            const char* a3 = a2 + kstep; const char* b3 = b2 + kstep;
            PG8_LDB(B0, 0, 0); PG8_LDB(B1, 0, 1); PG8_SCHED; PG8_LDA(At, 0, 0); PG8_STAGE_A(PG8_SA(1, 1), a1, 1, false);
            PG8_WAIT_V(8); PG8_WAIT_L(0); PG8_BAR; PG8_MMA(0, 0, At, B0); PG8_MMA(0, 1, At, B1); PG8_BAR; PG8_SCHED;
            PG8_LDA(At, 0, 1); PG8_STAGE_B(PG8_SB(0, 0), b2); PG8_STAGE_B(PG8_SB(0, 1), b2 + hstepB); PG8_STAGE_A(PG8_SA(0, 0), a2, 0, last);
            PG8_WAIT_V(8); PG8_WAIT_L(0); PG8_BAR; PG8_MMA(1, 0, At, B0); PG8_MMA(1, 1, At, B1); PG8_BAR; PG8_SCHED;
            PG8_LDB(B0, 1, 0); PG8_LDB(B1, 1, 1); PG8_SCHED; PG8_LDA(At, 1, 0); PG8_STAGE_A(PG8_SA(0, 1), a2, 1, last);
            PG8_WAIT_V(8); PG8_WAIT_L(0); PG8_BAR; PG8_MMA(0, 0, At, B0); PG8_MMA(0, 1, At, B1); PG8_BAR; PG8_SCHED;
            PG8_LDA(At, 1, 1); PG8_STAGE_B(PG8_SB(1, 0), b3); PG8_STAGE_B(PG8_SB(1, 1), b3 + hstepB); PG8_STAGE_A(PG8_SA(1, 0), a3, 0, last);
            PG8_WAIT_V(8); PG8_WAIT_L(0); PG8_BAR; PG8_MMA(1, 0, At, B0); PG8_MMA(1, 1, At, B1); PG8_BAR; PG8_SCHED;
        }
        if (wr == 0) PG8_BAR;
        { const int t2_ = tid_(g.wv), fr_ = t2_ & 15, fq_ = (t2_ >> 4) & 3;
          E(acc, cur, wr, wc, fr_, fq_); }
        if (!has_next) break;
#pragma unroll
        for (int a = 0; a < 2; ++a)
#pragma unroll
            for (int b = 0; b < 2; ++b)
#pragma unroll
                for (int m = 0; m < 4; ++m)
#pragma unroll
                    for (int n = 0; n < 2; ++n) acc[a][b][m][n] = (f32x4){0.f, 0.f, 0.f, 0.f};
        cur = nxt; cA = nA; cB = nB; ++ui;
        if constexpr (GATHER) { gC[0] = gN[0]; gC[1] = gN[1]; }
        if (wr == 1) PG8_BAR;
    }
    PG8_WAIT_V(0);
    PG8_BAR;
#undef PG8_SA
#undef PG8_SB
#undef PG8_STAGE_A
#undef PG8_STAGE_B
#undef PG8_LDA
#undef PG8_LDB
#undef PG8_MMA
#undef PG8_WAIT_V
#undef PG8_WAIT_L
#undef PG8_BAR
#undef PG8_SCHED
}
}

constexpr int OPT_THREADS = 512, OPT_LDS = 147456;
__device__ __forceinline__ bf16_t* ys_row(const Params& p, int srow) { return SP(bf16_t, S_YS) + (size_t)srow * 1024; }
__device__ __forceinline__ unsigned fp8x4(float a, float b, float c, float d) { int r = __builtin_amdgcn_cvt_pk_fp8_f32(a, b, 0, false); return (unsigned)__builtin_amdgcn_cvt_pk_fp8_f32(c, d, r, true); }
__device__ __forceinline__ float clamp448(float v) { return __builtin_amdgcn_fmed3f(v, -448.f, 448.f); }
constexpr size_t W_IN = 0;
constexpr size_t W_UP = W_IN + (size_t)2 * 1792 * 1024 * 2;
constexpr size_t W_O = W_UP + (size_t)2 * 1024 * 384 * 2;
constexpr size_t W_GU = W_O + (size_t)2 * 1024 * 1280 * 2;
constexpr size_t W_D = W_GU + (size_t)7168 * 1024 * 2;
constexpr size_t W_MGU = W_D + (size_t)1024 * 3584 * 2;
constexpr size_t W_MD = W_MGU + (size_t)8 * 7168 * 1024;
constexpr size_t W_END = W_MD + (size_t)8 * 1024 * 3584;
static_assert(W_END == W_BYTES, "weights region");
#ifndef MK_TEST
#define MK_TEST 0
#endif
#ifndef DENSE_FP8
#define DENSE_FP8 2
#endif
constexpr float WSCALE = 64.f, HSCALE = 8.f;
#define WP(off) ((bf16_t*)(p.ws + OFF_W + (off)))

struct CvtJob { bf16_t* dst; int ldd; const float* s0; const float* s1; int lds_, kind; const float* scale; const float* scale2; bool f8; };
__device__ __forceinline__ const float* cvt_src(const CvtJob& j, int k, int n, float& sc) {
    sc = 1.f;
    if (j.kind == 0) return j.s0 + (size_t)k * j.lds_ + n;
    if (j.kind == 1) { if (n < 1184) return j.s0 + (size_t)k * j.lds_ + n; if (n >= 1280) return j.s0 + (size_t)k * j.lds_ + n - 96; return nullptr; }
    if (j.kind == 2) { const int tl = n >> 8, jj = n & 255; return (jj < 128 ? j.s0 : j.s1) + (size_t)k * j.lds_ + tl * 128 + (jj & 127); }
    if (n < 384 && k < 256) { sc = j.scale[k]; return j.s0 + (size_t)k * 384 + n; }
    if (n >= 512 && k >= 256) { sc = j.scale2[k - 256]; return j.s1 + (size_t)(k - 256) * 512 + (n - 512); }
    return nullptr;
}
__device__ __forceinline__ void cvt_wave_store(const float4 (&v)[16], bool f8, void* dst, int ldd, int n0, int k0, unsigned char* T, int lane) {
    const int kq = lane >> 4, nc = (lane & 15) * 4;
    if (f8) {
#pragma unroll
        for (int i = 0; i < 4; ++i) { const int kb = 16 * i + 4 * kq;
            *(unsigned*)(T + (nc + 0) * 68 + kb) = fp8x4(v[4 * i].x, v[4 * i + 1].x, v[4 * i + 2].x, v[4 * i + 3].x);
            *(unsigned*)(T + (nc + 1) * 68 + kb) = fp8x4(v[4 * i].y, v[4 * i + 1].y, v[4 * i + 2].y, v[4 * i + 3].y);
            *(unsigned*)(T + (nc + 2) * 68 + kb) = fp8x4(v[4 * i].z, v[4 * i + 1].z, v[4 * i + 2].z, v[4 * i + 3].z);
            *(unsigned*)(T + (nc + 3) * 68 + kb) = fp8x4(v[4 * i].w, v[4 * i + 1].w, v[4 * i + 2].w, v[4 * i + 3].w); }
        asm volatile("s_waitcnt lgkmcnt(0)" ::: "memory");
#pragma unroll
        for (int r = 0; r < 8; ++r) { const int n = r * 8 + (lane >> 3), kc = (lane & 7) * 8; uint2 w; w.x = *(const unsigned*)(T + n * 68 + kc); w.y = *(const unsigned*)(T + n * 68 + kc + 4);
            *(uint2*)((unsigned char*)dst + (size_t)(n0 + n) * ldd + k0 + kc) = w; }
    } else {
#pragma unroll
        for (int i = 0; i < 4; ++i) { const int kb = (16 * i + 4 * kq) * 2;
            *(unsigned*)(T + (nc + 0) * 132 + kb) = pg8::cvt_pk_bf16(v[4 * i].x, v[4 * i + 1].x); *(unsigned*)(T + (nc + 0) * 132 + kb + 4) = pg8::cvt_pk_bf16(v[4 * i + 2].x, v[4 * i + 3].x);
            *(unsigned*)(T + (nc + 1) * 132 + kb) = pg8::cvt_pk_bf16(v[4 * i].y, v[4 * i + 1].y); *(unsigned*)(T + (nc + 1) * 132 + kb + 4) = pg8::cvt_pk_bf16(v[4 * i + 2].y, v[4 * i + 3].y);
            *(unsigned*)(T + (nc + 2) * 132 + kb) = pg8::cvt_pk_bf16(v[4 * i].z, v[4 * i + 1].z); *(unsigned*)(T + (nc + 2) * 132 + kb + 4) = pg8::cvt_pk_bf16(v[4 * i + 2].z, v[4 * i + 3].z);
            *(unsigned*)(T + (nc + 3) * 132 + kb) = pg8::cvt_pk_bf16(v[4 * i].w, v[4 * i + 1].w); *(unsigned*)(T + (nc + 3) * 132 + kb + 4) = pg8::cvt_pk_bf16(v[4 * i + 2].w, v[4 * i + 3].w); }
        asm volatile("s_waitcnt lgkmcnt(0)" ::: "memory");
#pragma unroll
        for (int r = 0; r < 8; ++r) { const int n = r * 8 + (lane >> 3), kc = (lane & 7) * 16; uint4 w;
            w.x = *(const unsigned*)(T + n * 132 + kc); w.y = *(const unsigned*)(T + n * 132 + kc + 4); w.z = *(const unsigned*)(T + n * 132 + kc + 8); w.w = *(const unsigned*)(T + n * 132 + kc + 12);
            *(uint4*)((bf16_t*)dst + (size_t)(n0 + n) * ldd + k0 + (lane & 7) * 8) = w; }
    }
    asm volatile("s_waitcnt lgkmcnt(0)" ::: "memory");
}
__device__ __forceinline__ void cvt_wave_tile(const CvtJob& j, int n0, int k0, unsigned char* T  , int lane) {
    const int kq = lane >> 4, nc = (lane & 15) * 4;
    float4 v[16]; float sc[16];
#pragma unroll
    for (int q = 0; q < 16; ++q) { const float* src = cvt_src(j, k0 + 16 * (q >> 2) + 4 * kq + (q & 3), n0 + nc, sc[q]); v[q] = src ? *(const float4*)src : make_float4(0.f, 0.f, 0.f, 0.f); }
#pragma unroll
    for (int q = 0; q < 16; ++q) { const float s_ = j.f8 ? WSCALE : sc[q]; v[q].x *= s_; v[q].y *= s_; v[q].z *= s_; v[q].w *= s_; }
    cvt_wave_store(v, j.f8, j.dst, j.ldd, n0, k0, T, lane);
}
typedef __attribute__((address_space(3))) unsigned char lds_t;
__device__ __forceinline__ float silu_fast(float x) { return x * __builtin_amdgcn_rcpf(1.f + __expf(-x)); }

__device__ __forceinline__ void cvt_decode(const Params& p, int ti, CvtJob& j, int& n0, int& k0) {
    constexpr int T_IN = 448, T_UP = 96, T_GU = 1792, T_D = 896;
    int idx = ti, kt; j = CvtJob{};
    if (idx < 2 * T_IN) { const int l = idx / T_IN; idx %= T_IN; j.dst = WP(W_IN) + (size_t)l * 1792 * 1024; j.ldd = 1024; j.s0 = p.w_in + (size_t)l * 1024 * DIN; j.lds_ = DIN; j.kind = 1; kt = 16; }
    else if ((idx -= 2 * T_IN) < 2 * T_UP) { const int l = idx / T_UP; idx %= T_UP; j.dst = WP(W_UP) + (size_t)l * 1024 * 384; j.ldd = 384; j.s0 = p.mla_w_uq + (size_t)l * 256 * 384; j.s1 = p.mla_w_ukv + (size_t)l * 128 * 512;
        j.scale = p.mla_g_q + l * 256; j.scale2 = p.mla_g_kv + l * 128; j.kind = 3; kt = 6; }
    else if ((idx -= 2 * T_UP) < T_GU) { j.dst = WP(W_GU); j.ldd = 1024; j.s0 = p.ffn_w_gate; j.s1 = p.ffn_w_up; j.lds_ = DFF; j.kind = 2; j.f8 = (DENSE_FP8 == 1); kt = 16; }
    else if ((idx -= T_GU) < T_D) { j.dst = WP(W_D); j.ldd = DFF; j.s0 = p.ffn_w_down; j.lds_ = 1024; j.kind = 0; j.f8 = (DENSE_FP8 != 0); kt = 56; }
    else if ((idx -= T_D) < 8 * T_GU) { const int e = idx / T_GU; idx %= T_GU; j.dst = (bf16_t*)(p.ws + OFF_W + W_MGU + (size_t)e * 7168 * 1024); j.ldd = 1024; j.s0 = p.moe_w_gate + (size_t)e * 1024 * DFF; j.s1 = p.moe_w_up + (size_t)e * 1024 * DFF; j.lds_ = DFF; j.kind = 2; j.f8 = true; kt = 16; }
    else { idx -= 8 * T_GU; const int e = idx / T_D; idx %= T_D; j.dst = (bf16_t*)(p.ws + OFF_W + W_MD + (size_t)e * 1024 * DFF); j.ldd = DFF; j.s0 = p.moe_w_down + (size_t)e * DFF * 1024; j.lds_ = 1024; j.kind = 0; j.f8 = true; kt = 56; }
    const int ntn = j.kind == 1 ? 28 : (j.kind == 3 ? 16 : (j.kind == 2 ? 112 : 16)); (void)kt;
    n0 = (idx % ntn) * 64; k0 = (idx / ntn) * 64;
}
constexpr int CVT_TOT = 2 * 448 + 2 * 96 + 1792 + 896 + 8 * (1792 + 896), CVT_MOE0 = 2 * 448 + 2 * 96 + 1792 + 896;
__device__ __forceinline__ void phase_cvt(const Params& p, lds_t* lds, int begin, int end, int wb, int nwb) {
    const int t = tid_(p.wv), lane = t & 63;
    unsigned char* T = (unsigned char*)lds + p.wv * 9216;
    for (int ti = begin + wb * 8 + p.wv; ti < end; ti += nwb * 8) { CvtJob j; int n0, k0; cvt_decode(p, ti, j, n0, k0); cvt_wave_tile(j, n0, k0, T, lane); }
    __syncthreads();
}
__device__ __forceinline__ void cvt_in_tail(const Params& p, lds_t* lds, int nunits, int begin, int end) {
    const int G = gridDim.x, c = bid_(), heavy = nunits % G;
    if (G != 256 || heavy == 0 || c < heavy) return;
    phase_cvt(p, lds, CVT_MOE0 + begin, CVT_MOE0 + end, c - heavy, G - heavy);
}

struct SchedDense : pg8::OrderBase {
    const char *A, *B; size_t ta, tb;
    __device__ const char* a_base(const pg8::Unit& u) const { return A + (size_t)u.pm * ta; }
    __device__ const char* b_base(const pg8::Unit& u) const { return B + (size_t)u.pn * tb; }
    __device__ int row(const pg8::Unit&, int) const { return 0; }
};
struct SchedMoE : pg8::OrderBase {
    const char *A, *B; size_t ta, tb, te; int t0; const int* tile_e; const int* rowidx;
    __device__ const char* a_base(const pg8::Unit& u) const { return A + (size_t)u.pm * ta; }
    __device__ const char* b_base(const pg8::Unit& u) const { return B + (size_t)__builtin_amdgcn_readfirstlane(ld_i(tile_e + t0 + u.pm)) * te + (size_t)u.pn * tb; }
    __device__ int row(const pg8::Unit& u, int r) const { return rowidx[(t0 + u.pm) * 256 + r]; }
};
struct EpiSwiGLU {
    static constexpr bool PERM = true;
    bf16_t* H;
    __device__ __forceinline__ void operator()(const pg8::f32x4 (&acc)[2][2][4][2], const pg8::Unit& u, int wr, int wc, int fr, int fq) const {
#pragma unroll
        for (int ai = 0; ai < 2; ++ai)
#pragma unroll
            for (int m = 0; m < 4; ++m) {
                const int row = u.pm * 256 + ai * 128 + wr * 64 + m * 16 + fr;
                const pg8::f32x4 g0 = acc[ai][0][m][0], g1 = acc[ai][0][m][1], u0 = acc[ai][1][m][0], u1 = acc[ai][1][m][1];
                pg8::u32x4 w;
                w.x = pg8::cvt_pk_bf16(silu_fast(g0[0]) * u0[0], silu_fast(g0[1]) * u0[1]); w.y = pg8::cvt_pk_bf16(silu_fast(g0[2]) * u0[2], silu_fast(g0[3]) * u0[3]);
                w.z = pg8::cvt_pk_bf16(silu_fast(g1[0]) * u1[0], silu_fast(g1[1]) * u1[1]); w.w = pg8::cvt_pk_bf16(silu_fast(g1[2]) * u1[2], silu_fast(g1[3]) * u1[3]);
                *(pg8::u32x4*)(H + (size_t)row * DFF + u.pn * 128 + wc * 32 + 8 * fq) = w;
            }
    }
};
template <bool WS = true> struct EpiSwiGLU8T {
    static constexpr bool PERM = true;
    unsigned char* H;
    __device__ __forceinline__ void operator()(const pg8::f32x4 (&acc)[2][2][4][2], const pg8::Unit& u, int wr, int wc, int fr, int fq) const {
        constexpr float IS = WS ? 1.f / WSCALE : 1.f;
#pragma unroll
        for (int ai = 0; ai < 2; ++ai)
#pragma unroll
            for (int m = 0; m < 4; ++m) {
                const int row = u.pm * 256 + ai * 128 + wr * 64 + m * 16 + fr;
                const pg8::f32x4 g0 = acc[ai][0][m][0] * IS, g1 = acc[ai][0][m][1] * IS, u0 = acc[ai][1][m][0] * (IS * HSCALE), u1 = acc[ai][1][m][1] * (IS * HSCALE);
                pg8::u32x2 w;
                w.x = fp8x4(clamp448(silu_fast(g0[0]) * u0[0]), clamp448(silu_fast(g0[1]) * u0[1]), clamp448(silu_fast(g0[2]) * u0[2]), clamp448(silu_fast(g0[3]) * u0[3]));
                w.y = fp8x4(clamp448(silu_fast(g1[0]) * u1[0]), clamp448(silu_fast(g1[1]) * u1[1]), clamp448(silu_fast(g1[2]) * u1[2]), clamp448(silu_fast(g1[3]) * u1[3]));
                *(pg8::u32x2*)(H + (size_t)row * DFF + u.pn * 128 + wc * 32 + 8 * fq) = w;
            }
    }
};
typedef EpiSwiGLU8T<true> EpiSwiGLU8;
template <bool MOE, bool SCALED = MOE> struct EpiRowsBf16 {
    static constexpr bool PERM = true;
    Params p; bf16_t* O; int t0;
    __device__ __forceinline__ void operator()(const pg8::f32x4 (&acc)[2][2][4][2], const pg8::Unit& u, int wr, int wc, int fr, int fq) const {
#pragma unroll
        for (int ai = 0; ai < 2; ++ai)
#pragma unroll
            for (int m = 0; m < 4; ++m) {
                const int row = u.pm * 256 + ai * 128 + wr * 64 + m * 16 + fr;
                bf16_t* rp = MOE ? ys_row(p, t0 * 256 + row) : O + (size_t)row * 1024;
#pragma unroll
                for (int bj = 0; bj < 2; ++bj) { constexpr float SC = SCALED ? 1.f / (WSCALE * HSCALE) : 1.f; const pg8::f32x4 v0 = acc[ai][bj][m][0] * SC, v1 = acc[ai][bj][m][1] * SC; pg8::u32x4 w;
                    w.x = pg8::cvt_pk_bf16(v0[0], v0[1]); w.y = pg8::cvt_pk_bf16(v0[2], v0[3]); w.z = pg8::cvt_pk_bf16(v1[0], v1[1]); w.w = pg8::cvt_pk_bf16(v1[2], v1[3]);
                    *(pg8::u32x4*)(rp + u.pn * 256 + bj * 128 + wc * 32 + 8 * fq) = w; }
            }
    }
};
__device__ __forceinline__ void phase_ffn_gu_dense(const Params& p, lds_t* lds) {
#if DENSE_FP8 == 1
    SchedDense S; S.init(RR / 256, 28, gridDim.x, bid_()); S.A = (const char*)WSP(bf16_t, OFF_XN); S.B = (const char*)WP(W_GU); S.ta = (size_t)256 * 1024; S.tb = (size_t)256 * 1024;
    EpiSwiGLU8 E{(unsigned char*)SP(bf16_t, S_H)};
    pg8::gemm_phase<EpiSwiGLU8, SchedDense, false, true>(lds, pg8::Gemm{512, 512, 512, p.wv}, S, E);
#elif DENSE_FP8 == 2
    SchedDense S; S.init(RR / 256, 28, gridDim.x, bid_()); S.A = (const char*)WSP(bf16_t, OFF_XN); S.B = (const char*)WP(W_GU); S.ta = (size_t)256 * 1024 * 2; S.tb = (size_t)256 * 1024 * 2;
    EpiSwiGLU8T<false> E{(unsigned char*)SP(bf16_t, S_H)};
    pg8::gemm_phase<EpiSwiGLU8T<false>, SchedDense, false>(lds, pg8::Gemm{1024, 1024, 1024, p.wv}, S, E);
#else
    SchedDense S; S.init(RR / 256, 28, gridDim.x, bid_()); S.A = (const char*)WSP(bf16_t, OFF_XN); S.B = (const char*)WP(W_GU); S.ta = (size_t)256 * 1024 * 2; S.tb = (size_t)256 * 1024 * 2;
    EpiSwiGLU E{SP(bf16_t, S_H)};
    pg8::gemm_phase<EpiSwiGLU, SchedDense, false>(lds, pg8::Gemm{1024, 1024, 1024, p.wv}, S, E);
#endif
}
__device__ __forceinline__ void phase_ffn_dn_dense(const Params& p, lds_t* lds) {
#if DENSE_FP8
    SchedDense S; S.init(RR / 256, 4, gridDim.x, bid_()); S.A = (const char*)SP(bf16_t, S_H); S.B = (const char*)WP(W_D); S.ta = (size_t)256 * DFF; S.tb = (size_t)256 * DFF;
    EpiRowsBf16<false, true> E{p, WSP(bf16_t, OFF_XN), 0};
    pg8::gemm_phase<EpiRowsBf16<false, true>, SchedDense, false, true>(lds, pg8::Gemm{DFF / 2, DFF / 2, DFF / 2, p.wv}, S, E);
#else
    SchedDense S; S.init(RR / 256, 4, gridDim.x, bid_()); S.A = (const char*)SP(bf16_t, S_H); S.B = (const char*)WP(W_D); S.ta = (size_t)256 * DFF * 2; S.tb = (size_t)256 * DFF * 2;
    EpiRowsBf16<false> E{p, WSP(bf16_t, OFF_XN), 0};
    pg8::gemm_phase<EpiRowsBf16<false>, SchedDense, false>(lds, pg8::Gemm{DFF, DFF, DFF, p.wv}, S, E);
#endif
}
__device__ __forceinline__ void phase_moe_gu(const Params& p, lds_t* lds) {
    const int NT = ld_i((const int*)p.ws + CW_NT);
    SchedMoE S; S.init(NT, 28, gridDim.x, bid_()); S.A = (const char*)SP(bf16_t, S_YS); S.B = (const char*)(p.ws + OFF_W + W_MGU); S.ta = (size_t)256 * 1024; S.tb = (size_t)256 * 1024; S.te = (size_t)7168 * 1024;
    S.t0 = 0; S.tile_e = WSP(int, OFF_TILEE); S.rowidx = WSP(int, OFF_ROWIDX);
    EpiSwiGLU8 E{(unsigned char*)SP(bf16_t, S_H)};
    pg8::gemm_phase<EpiSwiGLU8, SchedMoE, false, true>(lds, pg8::Gemm{512, 512, 512, p.wv}, S, E);
}
__device__ __forceinline__ void phase_moe_dn(const Params& p, lds_t* lds) {
    const int NT = ld_i((const int*)p.ws + CW_NT);
    SchedMoE S; S.init(NT, 4, gridDim.x, bid_()); S.A = (const char*)SP(bf16_t, S_H); S.B = (const char*)(p.ws + OFF_W + W_MD); S.ta = (size_t)256 * DFF; S.tb = (size_t)256 * DFF; S.te = (size_t)1024 * DFF;
    S.t0 = 0; S.tile_e = WSP(int, OFF_TILEE); S.rowidx = WSP(int, OFF_ROWIDX);
    EpiRowsBf16<true> E{p, nullptr, 0};
    pg8::gemm_phase<EpiRowsBf16<true>, SchedMoE, false, true>(lds, pg8::Gemm{DFF / 2, DFF / 2, DFF / 2, p.wv}, S, E);
}

typedef float f32x2 __attribute__((ext_vector_type(2)));
__device__ __forceinline__ f32x2 gelu_pk(f32x2 v) {
    const f32x2 av = __builtin_elementwise_abs(v), d = av * 0.2316418882f + 1.0f;
    f32x2 t; t.x = __builtin_amdgcn_rcpf(d.x); t.y = __builtin_amdgcn_rcpf(d.y);
    f32x2 q = t * 0.5307027145f + (-0.7265760135f); q = q * t + 0.7107068705f; q = q * t + (-0.142248368f); q = q * t + 0.127414796f; q = q * t;
    const f32x2 s = (v * v) * (-0.72134752044f);
    f32x2 e; e.x = __builtin_amdgcn_exp2f(s.x); e.y = __builtin_amdgcn_exp2f(s.y);
    const f32x2 m = v * (q * e), r = v - m;
    f32x2 o; o.x = v.x < 0.f ? m.x : r.x; o.y = v.y < 0.f ? m.y : r.y; return o;
}
__device__ __forceinline__ pg8::u32x4 pack8(const float* v) { pg8::u32x4 w; w.x = pg8::cvt_pk_bf16(v[0], v[1]); w.y = pg8::cvt_pk_bf16(v[2], v[3]); w.z = pg8::cvt_pk_bf16(v[4], v[5]); w.w = pg8::cvt_pk_bf16(v[6], v[7]); return w; }
__device__ __forceinline__ void rope8(float* v, const float2* cs) {
    const float4 a = *(const float4*)cs, b = *(const float4*)(cs + 2);
    const float c[4] = {a.x, a.z, b.x, b.z}, sn[4] = {a.y, a.w, b.y, b.w};
#pragma unroll
    for (int q = 0; q < 4; ++q) { const float x1 = v[2 * q], x2 = v[2 * q + 1]; v[2 * q] = x1 * c[q] - x2 * sn[q]; v[2 * q + 1] = x1 * sn[q] + x2 * c[q]; }
}
__device__ __forceinline__ const float2* rope_ptr(const float2* tab, int nf, int pos, int pi0) { const int co = pi0 < nf ? (pos >> 6) : (pos & 63); return tab + co * nf + (pi0 < nf ? pi0 : pi0 - nf); }

__device__ __forceinline__ void rope8r(float* v, const float4 a, const float4 b) {
    const float c[4] = {a.x, a.z, b.x, b.z}, sn[4] = {a.y, a.w, b.y, b.w};
#pragma unroll
    for (int q = 0; q < 4; ++q) { const float x1 = v[2 * q], x2 = v[2 * q + 1]; v[2 * q] = x1 * c[q] - x2 * sn[q]; v[2 * q + 1] = x1 * sn[q] + x2 * c[q]; }
}
struct EpiInProj {
    static constexpr bool PERM = true;
    Params p;
    __device__ __forceinline__ void operator()(const pg8::f32x4 (&acc)[2][2][4][2], const pg8::Unit& u, int wr, int wc, int fr, int fq) const {
        const int pn = u.pn;
        const bool lat_t = u.pm < TL / 256, roped = lat_t && (pn == 1 || pn == 2 || (pn == 4 && wc == 0));
        const int nf = pn == 4 ? 8 : 16, pb = pn == 4 ? 4 * fq : (wc & 1) * 16 + 4 * fq; const bool rowt = pb < nf;
        float4 ra[4], rb[4];
#pragma unroll
        for (int q = 0; q < 4; ++q) { ra[q] = make_float4(1.f, 0.f, 1.f, 0.f); rb[q] = ra[q]; }
        if (roped) { const float2* tab = pn == 4 ? WSP(float2, OFF_ROPEM) : WSP(float2, OFF_ROPEW);
#pragma unroll
            for (int q = 0; q < 4; ++q) { const int coord = rowt ? ((u.pm * 4 + (q & 1) * 2 + wr) & 127) : (q * 16 + fr); const float2* t = tab + coord * nf + (rowt ? pb : pb - nf);
                ra[q] = *(const float4*)t; rb[q] = *(const float4*)(t + 2); } }
#pragma unroll
        for (int ai = 0; ai < 2; ++ai)
#pragma unroll
            for (int m = 0; m < 4; ++m) {
                const int r = u.pm * 256 + ai * 128 + wr * 64 + m * 16 + fr;
                const int bb = row_batch(r), key = row_key(r);
                const float4 ca = rowt ? ra[ai] : ra[m], cb = rowt ? rb[ai] : rb[m];
                float s1 = 0.f, s2 = 0.f;
#pragma unroll
                for (int bj = 0; bj < 2; ++bj) {
                    const int c0 = bj * 128 + wc * 32 + 8 * fq;
                    float v[8];
#pragma unroll
                    for (int e = 0; e < 4; ++e) { v[e] = acc[ai][bj][m][0][e]; v[4 + e] = acc[ai][bj][m][1][e]; }
                    if (pn == 0) { *(pg8::u32x4*)(SP(bf16_t, S_ABUF) + (size_t)r * 256 + c0) = pack8(v); }
                    else if (pn == 1) { rope8r(v, ca, cb);
#pragma unroll
                        for (int e = 0; e < 8; ++e) v[e] *= 0.125f;
                        *(pg8::u32x4*)(SP(bf16_t, S_QW) + (size_t)r * 256 + c0) = pack8(v); }
                    else if (pn == 2) {
                        if (bj == 0) { rope8r(v, ca, cb); *(pg8::u32x4*)(SP(bf16_t, S_KW) + ((size_t)bb * NKEY + key) * 128 + c0) = pack8(v); }
                        else *(pg8::u32x4*)(SP(bf16_t, S_VW) + ((size_t)bb * NKEY + key) * 128 + (c0 - 128)) = pack8(v); }
                    else if (pn == 3) {
#pragma unroll
                        for (int e = 0; e < 8; ++e) s2 += v[e] * v[e];
                        *(pg8::u32x4*)(SP(bf16_t, S_C2) + (size_t)r * 384 + c0) = pack8(v); }
                    else if (pn == 4) {
                        if (bj == 0) {
#pragma unroll
                            for (int e = 0; e < 8; ++e) s2 += v[e] * v[e];
                            *(pg8::u32x4*)(SP(bf16_t, S_C2) + (size_t)r * 384 + 256 + c0) = pack8(v); }
                        else if (wc == 0) { rope8r(v, ca, cb); const pg8::u32x4 w = pack8(v);
#pragma unroll
                            for (int h = 0; h < 4; ++h) *(pg8::u32x4*)(SP(bf16_t, S_KM) + (((size_t)bb * 4 + h) * NKEY + key) * 96 + 64 + 8 * fq) = w; } }
                    else {
#pragma unroll
                        for (int e = 0; e < 8; e += 2) { const f32x2 gq = gelu_pk((f32x2){v[e], v[e + 1]}); v[e] = gq.x; v[e + 1] = gq.y; }
                        if (pn == 6) {
#pragma unroll
                            for (int e = 0; e < 8; ++e) { s1 += v[e]; s2 += v[e] * v[e]; } }
                        *(pg8::u32x4*)(SP(bf16_t, pn == 5 ? S_U : S_VG) + (size_t)r * 256 + c0) = pack8(v); }
                }
                if (pn == 3 || pn == 4 || pn == 6) {
                    { const int l4_ = lane_() << 2; s1 += __int_as_float(__builtin_amdgcn_ds_bpermute(l4_ ^ 64, __float_as_int(s1))); s1 += __int_as_float(__builtin_amdgcn_ds_bpermute(l4_ ^ 128, __float_as_int(s1))); s2 += __int_as_float(__builtin_amdgcn_ds_bpermute(l4_ ^ 64, __float_as_int(s2))); s2 += __int_as_float(__builtin_amdgcn_ds_bpermute(l4_ ^ 128, __float_as_int(s2))); }
                    if (fq == 0) { if (pn == 3) WSP(float, OFF_SSQQ)[(size_t)r * 4 + wc] = s2; else if (pn == 4) WSP(float, OFF_SSQKV)[(size_t)r * 4 + wc] = s2;
                        else { WSP(float, OFF_LNS)[(size_t)r * 8 + wc * 2] = s1; WSP(float, OFF_LNS)[(size_t)r * 8 + wc * 2 + 1] = s2; } }
                }
            }
    }
};
template <int KV> struct EpiUp {
    static constexpr bool PERM = true;
    Params p;
    __device__ __forceinline__ void operator()(const pg8::f32x4 (&acc)[2][2][4][2], const pg8::Unit& u, int wr, int wc, int fr, int fq) const {
        const int pn = u.pn;
        float rs8[8];
#pragma unroll
        for (int q = 0; q < 8; ++q) { const int r = u.pm * 256 + (q >> 2) * 128 + wr * 64 + (q & 3) * 16 + fr; const float4 sq4 = *(const float4*)(WSP(float, KV ? OFF_SSQKV : OFF_SSQQ) + (size_t)r * 4);
            rs8[q] = rsqrtf(((sq4.x + sq4.y) + (sq4.z + sq4.w)) * (KV ? 1.f / 128.f : 1.f / 256.f) + EPS) * (KV ? 1.f : 0.10206207261596575f); }
#pragma unroll
        for (int ai = 0; ai < 2; ++ai)
#pragma unroll
            for (int m = 0; m < 4; ++m) {
                const int r = u.pm * 256 + ai * 128 + wr * 64 + m * 16 + fr;
                const bool lat = r < TL; const int pos = r & 8191, bb = row_batch(r), key = row_key(r);
                const float rs = rs8[ai * 4 + m];
#pragma unroll
                for (int bj = 0; bj < 2; ++bj) {
                    const int c0 = bj * 128 + wc * 32 + 8 * fq, n = pn * 256 + c0;
                    float v[8];
#pragma unroll
                    for (int e = 0; e < 4; ++e) { v[e] = acc[ai][bj][m][0][e] * rs; v[4 + e] = acc[ai][bj][m][1][e] * rs; }
                    if (!KV) { if (n < 384) { const int i = n % 96;
                            if (i >= 64 && lat) rope8(v, rope_ptr(WSP(float2, OFF_ROPEM), 8, pos, (i - 64) >> 1));
                            *(pg8::u32x4*)(SP(bf16_t, S_QM) + (size_t)r * 384 + n) = pack8(v); } }
                    else { const int h = n >> 7, j0 = n & 127;
                        if (j0 < 64) *(pg8::u32x4*)(SP(bf16_t, S_KM) + (((size_t)bb * 4 + h) * NKEY + key) * 96 + j0) = pack8(v);
                        else *(pg8::u32x4*)(SP(bf16_t, S_VM) + (((size_t)bb * 4 + h) * NKEY + key) * 64 + (j0 - 64)) = pack8(v); }
                }
            }
    }
};
__device__ __forceinline__ void phase_inproj(const Params& p, lds_t* lds, int l) {
    SchedDense S; S.init(RR / 256, 7, gridDim.x, bid_()); S.A = (const char*)WSP(bf16_t, OFF_XN); S.B = (const char*)(WP(W_IN) + (size_t)l * 1792 * 1024); S.ta = (size_t)256 * 1024 * 2; S.tb = (size_t)256 * 1024 * 2;
    EpiInProj E{p};
    pg8::gemm_phase<EpiInProj, SchedDense, false>(lds, pg8::Gemm{1024, 1024, 1024, p.wv}, S, E);
}
__device__ __forceinline__ void phase_up(const Params& p, lds_t* lds, int l) {
    { SchedDense S; S.init(RR / 256, 2, gridDim.x, bid_()); S.A = (const char*)SP(bf16_t, S_C2); S.B = (const char*)(WP(W_UP) + (size_t)l * 1024 * 384); S.ta = (size_t)256 * 384 * 2; S.tb = (size_t)256 * 384 * 2;
      EpiUp<0> E{p}; pg8::gemm_phase<EpiUp<0>, SchedDense, false>(lds, pg8::Gemm{384, 384, 256, p.wv}, S, E); }
    { SchedDense S; S.init(RR / 256, 2, gridDim.x, (int)gridDim.x - 1 - bid_()); S.A = (const char*)(SP(bf16_t, S_C2) + 256); S.B = (const char*)(WP(W_UP) + (size_t)l * 1024 * 384 + (size_t)512 * 384 + 256); S.ta = (size_t)256 * 384 * 2; S.tb = (size_t)256 * 384 * 2;
      EpiUp<1> E{p}; pg8::gemm_phase<EpiUp<1>, SchedDense, false>(lds, pg8::Gemm{384, 384, 128, p.wv}, S, E); }
}
__device__ __forceinline__ void phase_outproj(const Params& p, lds_t* lds, int l) {
    SchedDense S; S.init(l == 0 ? RR / 256 : TL / 256, 4, gridDim.x, bid_()); S.A = (const char*)SP(bf16_t, S_CAT); S.B = (const char*)(WP(W_O) + (size_t)l * 1024 * 1280); S.ta = (size_t)256 * 1280 * 2; S.tb = (size_t)256 * 1280 * 2;
    EpiRowsBf16<false> E{p, SP(bf16_t, S_MX), 0};
    pg8::gemm_phase<EpiRowsBf16<false>, SchedDense, false>(lds, pg8::Gemm{1280, 1280, 1280, p.wv}, S, E);
}


namespace att {
using bf16x8 = __attribute__((ext_vector_type(8))) short;
using s16x4 = __attribute__((ext_vector_type(4))) short;
using f32x16 = __attribute__((ext_vector_type(16))) float;
using u32x4 = __attribute__((ext_vector_type(4))) unsigned;
#define KSWZ(row, colB) ((row) * 256 + ((colB) ^ (((row) & 15) << 4)))
#define SBAR() __builtin_amdgcn_sched_barrier(0)
constexpr float THR = 8.f, LOG2E = 1.4426950408889634f;
constexpr int SHM_K = 64 * 256, SHM_V = 64 * 64 * 2;
constexpr int NBUF = 3;
constexpr int ATT_LDS = NBUF * SHM_K + NBUF * SHM_V + 8 * 64 * 4;
__device__ __forceinline__ int crow(int r, int hi) { return (r & 3) + 8 * (r >> 2) + 4 * hi; }
__device__ __forceinline__ unsigned cvtpk(float lo, float hi) { unsigned r; asm volatile("v_cvt_pk_bf16_f32 %0, %1, %2" : "=v"(r) : "v"(lo), "v"(hi)); return r; }
__device__ __forceinline__ void partialSM(f32x16& p0, f32x16& p1, float& m_reg, float& mn, float& alpha) {
    float pmax = p0[0];
#pragma unroll
    for (int r = 1; r < 16; ++r) pmax = fmaxf(pmax, p0[r]);
#pragma unroll
    for (int r = 0; r < 16; ++r) pmax = fmaxf(pmax, p1[r]);
    { auto rr = __builtin_amdgcn_permlane32_swap(__float_as_uint(pmax), __float_as_uint(pmax), false, false); pmax = fmaxf(__uint_as_float(rr[0]), __uint_as_float(rr[1])); }
    if (__builtin_expect(__all(pmax - m_reg <= THR), 1)) { mn = m_reg; alpha = 1.f; }
    else { mn = fmaxf(m_reg, pmax); alpha = __builtin_amdgcn_exp2f((m_reg - mn) * LOG2E); m_reg = mn; }
    const float mnC = -mn * LOG2E;
#pragma unroll
    for (int r = 0; r < 16; ++r) p0[r] = fmaf(p0[r], LOG2E, mnC);
#pragma unroll
    for (int r = 0; r < 16; ++r) p1[r] = fmaf(p1[r], LOG2E, mnC);
#pragma unroll
    for (int r = 0; r < 16; ++r) p0[r] = __builtin_amdgcn_exp2f(p0[r]);
}
__device__ __forceinline__ void finishSM(f32x16& p0, f32x16& p1, bf16x8& pa0, bf16x8& pa1, bf16x8& pa2, bf16x8& pa3) {
#pragma unroll
    for (int r = 0; r < 16; ++r) p1[r] = __builtin_amdgcn_exp2f(p1[r]);
#define PK4(P, BASE, OUT) do { u32x4 w = {cvtpk(P[BASE + 0], P[BASE + 1]), cvtpk(P[BASE + 2], P[BASE + 3]), cvtpk(P[BASE + 4], P[BASE + 5]), cvtpk(P[BASE + 6], P[BASE + 7])}; OUT = *reinterpret_cast<bf16x8*>(&w); } while (0)
    PK4(p0, 0, pa0); PK4(p0, 8, pa1); PK4(p1, 0, pa2); PK4(p1, 8, pa3);
#undef PK4
}
template <int DQK>
__device__ __forceinline__ void qkt(f32x16& p0, f32x16& p1, const char* Ks, const bf16x8* qr, int r32, int hi) {
    p0 = f32x16{}; p1 = f32x16{};
#pragma unroll
    for (int d0 = 0; d0 < DQK / 16; ++d0) { const int cb = (d0 * 16 + hi * 8) * 2;
        const bf16x8 b0 = *reinterpret_cast<const bf16x8*>(Ks + KSWZ(r32, cb));
        const bf16x8 b1 = *reinterpret_cast<const bf16x8*>(Ks + KSWZ(32 + r32, cb));
        p0 = __builtin_amdgcn_mfma_f32_32x32x16_bf16(b0, qr[d0], p0, 0, 0, 0);
        p1 = __builtin_amdgcn_mfma_f32_32x32x16_bf16(b1, qr[d0], p1, 0, 0, 0); }
}
__device__ __forceinline__ void maskband(f32x16& p0, f32x16& p1, int kp0, int qp, int hi) {
#pragma unroll
    for (int r = 0; r < 16; ++r) { const int d0 = kp0 + crow(r, hi) - qp; if (d0 > 128 || d0 < -128) p0[r] = -1e30f; const int d1 = d0 + 32; if (d1 > 128 || d1 < -128) p1[r] = -1e30f; }
}
__device__ __forceinline__ int v_st(int k, int c) { const int kk = k; return ((kk >> 3) * 2 + (c >> 5)) * 512 + ((kk & 7) * 32 + (c & 31)) * 2; }
__device__ __forceinline__ int v_rd_base(int lane) { return ((lane & 3) << 3) | (((lane >> 2) & 3) << 6) | (((lane >> 4) & 1) << 5) | (((lane >> 5) & 1) << 8); }
constexpr int v_rd_off(int d0, int ks, int half) { return d0 * 512 + ks * 2048 + half * 1024; }
template <int OFF> __device__ __forceinline__ s16x4 tr_read(int vb) { s16x4 r; asm volatile("ds_read_b64_tr_b16 %0, %1 offset:%2" : "=&v"(r) : "v"(vb), "i"(OFF) : "memory"); return r; }
template <int D0> __device__ __forceinline__ void pv_one(f32x16& od, int vb, bf16x8 pa0, bf16x8 pa1, bf16x8 pa2, bf16x8 pa3) {
    const s16x4 l0 = tr_read<v_rd_off(D0, 0, 0)>(vb), h0 = tr_read<v_rd_off(D0, 0, 1)>(vb), l1 = tr_read<v_rd_off(D0, 1, 0)>(vb), h1 = tr_read<v_rd_off(D0, 1, 1)>(vb);
    const s16x4 l2 = tr_read<v_rd_off(D0, 2, 0)>(vb), h2 = tr_read<v_rd_off(D0, 2, 1)>(vb), l3 = tr_read<v_rd_off(D0, 3, 0)>(vb), h3 = tr_read<v_rd_off(D0, 3, 1)>(vb);
    asm volatile("s_waitcnt lgkmcnt(0)" ::: "memory"); SBAR();
#define PK(L, H) (bf16x8){L[0], L[1], L[2], L[3], H[0], H[1], H[2], H[3]}
    od = __builtin_amdgcn_mfma_f32_32x32x16_bf16(pa0, PK(l0, h0), od, 0, 0, 0);
    od = __builtin_amdgcn_mfma_f32_32x32x16_bf16(pa1, PK(l1, h1), od, 0, 0, 0);
    od = __builtin_amdgcn_mfma_f32_32x32x16_bf16(pa2, PK(l2, h2), od, 0, 0, 0);
    od = __builtin_amdgcn_mfma_f32_32x32x16_bf16(pa3, PK(l3, h3), od, 0, 0, 0);
#undef PK
}
__device__ __forceinline__ void pv_pair(f32x16& o0, f32x16& o1, int vb, bf16x8 pa0, bf16x8 pa1, bf16x8 pa2, bf16x8 pa3) {
    const s16x4 l0 = tr_read<v_rd_off(0, 0, 0)>(vb), h0 = tr_read<v_rd_off(0, 0, 1)>(vb), l1 = tr_read<v_rd_off(0, 1, 0)>(vb), h1 = tr_read<v_rd_off(0, 1, 1)>(vb);
    const s16x4 l2 = tr_read<v_rd_off(0, 2, 0)>(vb), h2 = tr_read<v_rd_off(0, 2, 1)>(vb), l3 = tr_read<v_rd_off(0, 3, 0)>(vb), h3 = tr_read<v_rd_off(0, 3, 1)>(vb);
    const s16x4 m0 = tr_read<v_rd_off(1, 0, 0)>(vb), n0 = tr_read<v_rd_off(1, 0, 1)>(vb), m1 = tr_read<v_rd_off(1, 1, 0)>(vb), n1 = tr_read<v_rd_off(1, 1, 1)>(vb);
    const s16x4 m2 = tr_read<v_rd_off(1, 2, 0)>(vb), n2 = tr_read<v_rd_off(1, 2, 1)>(vb), m3 = tr_read<v_rd_off(1, 3, 0)>(vb), n3 = tr_read<v_rd_off(1, 3, 1)>(vb);
#define PK(L, H) (bf16x8){L[0], L[1], L[2], L[3], H[0], H[1], H[2], H[3]}
    asm volatile("s_waitcnt lgkmcnt(8)" ::: "memory"); SBAR();
    o0 = __builtin_amdgcn_mfma_f32_32x32x16_bf16(pa0, PK(l0, h0), o0, 0, 0, 0); o0 = __builtin_amdgcn_mfma_f32_32x32x16_bf16(pa1, PK(l1, h1), o0, 0, 0, 0);
    o0 = __builtin_amdgcn_mfma_f32_32x32x16_bf16(pa2, PK(l2, h2), o0, 0, 0, 0); o0 = __builtin_amdgcn_mfma_f32_32x32x16_bf16(pa3, PK(l3, h3), o0, 0, 0, 0);
    asm volatile("s_waitcnt lgkmcnt(0)" ::: "memory"); SBAR();
    o1 = __builtin_amdgcn_mfma_f32_32x32x16_bf16(pa0, PK(m0, n0), o1, 0, 0, 0); o1 = __builtin_amdgcn_mfma_f32_32x32x16_bf16(pa1, PK(m1, n1), o1, 0, 0, 0);
    o1 = __builtin_amdgcn_mfma_f32_32x32x16_bf16(pa2, PK(m2, n2), o1, 0, 0, 0); o1 = __builtin_amdgcn_mfma_f32_32x32x16_bf16(pa3, PK(m3, n3), o1, 0, 0, 0);
#undef PK
}
struct Unit {
    const bf16_t* Q; int ldq;
    const bf16_t* K; int ldk;
    const bf16_t* V; int ldv;
    bf16_t* O; int ldo;
    int NT, n1, k1, k2;
    int qpos0;
    float sink; int has_sink, wv;
};
template <int DQK, bool WIN>
__device__ __forceinline__ void attn_unit(const Unit& U, char* lds) {
    constexpr int NCH = DQK / 8;
    const int tid = tid_(U.wv), wid = U.wv, lane = tid & 63, r32 = lane & 31, hi = lane >> 5;
    char* V_lds = lds; char* K_lds = lds + NBUF * SHM_V;
    float* ws = (float*)(lds + NBUF * SHM_V + NBUF * SHM_K) + wid * 64; float* li_l = ws; float* al_l = ws + 32;
    float m_reg = -1e30f; f32x16 o[2] = {}, lacc = {}; bf16x8 qr[DQK / 16];
    const bf16x8 ones = {0x3F80, 0x3F80, 0x3F80, 0x3F80, 0x3F80, 0x3F80, 0x3F80, 0x3F80};
    const bf16_t* Qw = U.Q + (size_t)(wid * 32 + r32) * U.ldq + hi * 8;
#pragma unroll
    for (int d0 = 0; d0 < DQK / 16; ++d0) qr[d0] = *reinterpret_cast<const bf16x8*>(Qw + d0 * 16);
    const int kc0 = tid, kr0 = kc0 / NCH, kcol0 = (kc0 % NCH) * 8;
    const int kc1 = tid + 512, kr1 = kc1 / NCH, kcol1 = (kc1 % NCH) * 8; const bool has1 = kc1 < 64 * NCH;
    const int vr = tid >> 3, vc = (tid & 7) * 8, vst = v_st(vr, vc);
    const int kst0 = KSWZ(kr0, kcol0 * 2), kst1 = KSWZ(kr1, kcol1 * 2);
    const int vb0 = (int)(uintptr_t)V_lds + v_rd_base(lane);
    const int qp = U.qpos0 + wid * 32 + r32;
    struct { bf16x8 k0, k1, v; } sr_[2];
#define TKEY(j) ((j) < U.n1 ? U.k1 + 64 * (j) : U.k2 + 64 * ((j) - U.n1))
#define SLOAD(i, j) do { const int _k0 = TKEY(j); sr_[i].k0 = *reinterpret_cast<const bf16x8*>(U.K + (size_t)(_k0 + kr0) * U.ldk + kcol0); \
    if (has1) sr_[i].k1 = *reinterpret_cast<const bf16x8*>(U.K + (size_t)(_k0 + kr1) * U.ldk + kcol1); \
    sr_[i].v = *reinterpret_cast<const bf16x8*>(U.V + (size_t)(_k0 + vr) * U.ldv + vc); } while (0)
#define SWRITE(b, i) do { *(bf16x8*)(V_lds + (b) * SHM_V + vst) = sr_[i].v; *(bf16x8*)(K_lds + (b) * SHM_K + kst0) = sr_[i].k0; \
    if (has1) *(bf16x8*)(K_lds + (b) * SHM_K + kst1) = sr_[i].k1; } while (0)
#define RESC(a) do { if (__any((a) < 1.f)) { if (hi == 0) al_l[r32] = (a); asm volatile("s_waitcnt lgkmcnt(0)" ::: "memory"); \
    _Pragma("unroll") for (int r = 0; r < 16; ++r) { const float a_ = al_l[crow(r, hi)]; o[0][r] *= a_; o[1][r] *= a_; lacc[r] *= a_; } } } while (0)
#define MASK(P0, P1, j) do { if (WIN && (j) >= U.n1) maskband(P0, P1, TKEY(j), qp, hi); } while (0)
#define PVD(vbase) do { pv_one<0>(o[0], vbase, pa0, pa1, pa2, pa3); pv_one<1>(o[1], vbase, pa0, pa1, pa2, pa3); \
    lacc = __builtin_amdgcn_mfma_f32_32x32x16_bf16(pa0, ones, lacc, 0, 0, 0); lacc = __builtin_amdgcn_mfma_f32_32x32x16_bf16(pa1, ones, lacc, 0, 0, 0); \
    lacc = __builtin_amdgcn_mfma_f32_32x32x16_bf16(pa2, ones, lacc, 0, 0, 0); lacc = __builtin_amdgcn_mfma_f32_32x32x16_bf16(pa3, ones, lacc, 0, 0, 0); } while (0)
    f32x16 pA0, pA1, pB0, pB1; float mnA, mnB, alA, alB; bf16x8 pa0, pa1, pa2, pa3; const int NT = U.NT;
    SLOAD(0, 0); asm volatile("s_waitcnt vmcnt(0)" ::: "memory"); SWRITE(0, 0); __syncthreads();
    qkt<DQK>(pA0, pA1, K_lds, qr, r32, hi); MASK(pA0, pA1, 0); partialSM(pA0, pA1, m_reg, mnA, alA);
    SLOAD(1, 1); if (2 < NT) SLOAD(0, 2);
    SWRITE(1, 1); __syncthreads();
    int bc = 1, bp = 0, bn = 2;
    for (int j = 1; j + 1 < NT; j += 2) {
        SLOAD(1, j + 2);
        SBAR(); qkt<DQK>(pB0, pB1, K_lds + bc * SHM_K, qr, r32, hi); MASK(pB0, pB1, j);
        finishSM(pA0, pA1, pa0, pa1, pa2, pa3); SBAR();
        PVD(vb0 + bp * SHM_V); partialSM(pB0, pB1, m_reg, mnB, alB);
        SWRITE(bn, 0);
        RESC(alB); __syncthreads();
        { const int t_ = bp; bp = bc; bc = bn; bn = t_; }
        if (j + 3 < NT) SLOAD(0, j + 3);
        SBAR(); qkt<DQK>(pA0, pA1, K_lds + bc * SHM_K, qr, r32, hi); MASK(pA0, pA1, j + 1);
        finishSM(pB0, pB1, pa0, pa1, pa2, pa3); SBAR();
        PVD(vb0 + bp * SHM_V); partialSM(pA0, pA1, m_reg, mnA, alA);
        SWRITE(bn, 1);
        RESC(alA); __syncthreads();
        { const int t_ = bp; bp = bc; bc = bn; bn = t_; }
    }
    SBAR(); qkt<DQK>(pB0, pB1, K_lds + bc * SHM_K, qr, r32, hi); MASK(pB0, pB1, NT - 1);
    finishSM(pA0, pA1, pa0, pa1, pa2, pa3); SBAR();
    PVD(vb0 + bp * SHM_V); partialSM(pB0, pB1, m_reg, mnB, alB);
    RESC(alB);
    finishSM(pB0, pB1, pa0, pa1, pa2, pa3); SBAR();
    PVD(vb0 + bc * SHM_V);
    if (WIN && U.has_sink) {
        if (hi == 0) li_l[r32] = __builtin_amdgcn_exp2f((U.sink - m_reg) * LOG2E); asm volatile("s_waitcnt lgkmcnt(0)" ::: "memory");
#pragma unroll
        for (int r = 0; r < 16; ++r) lacc[r] += li_l[crow(r, hi)]; }
    float rli[16];
#pragma unroll
    for (int r = 0; r < 16; ++r) rli[r] = __builtin_amdgcn_rcpf(lacc[r]);
    bf16_t* Ow = U.O + (size_t)(wid * 32) * U.ldo;
#pragma unroll
    for (int r = 0; r < 16; ++r) { const int orow = crow(r, hi);
#pragma unroll
        for (int d0 = 0; d0 < 2; ++d0) Ow[(size_t)orow * U.ldo + d0 * 32 + r32] = f2bf(o[d0][r] * rli[r]); }
    __syncthreads();
#undef TKEY
#undef SLOAD
#undef SWRITE
#undef RESC
#undef MASK
#undef PVD
}

typedef __bf16 bf16x2_t __attribute__((ext_vector_type(2)));
typedef float f32x2_t __attribute__((ext_vector_type(2)));
__device__ __forceinline__ unsigned cvtpk2(float lo, float hi) { f32x2_t f = {lo, hi}; bf16x2_t b = __builtin_convertvector(f, bf16x2_t); return *reinterpret_cast<unsigned*>(&b); }
__device__ __forceinline__ void sl_pk(const f32x16& p, bf16x8& lo, bf16x8& hi) {
#define PK4(BASE, OUT) do { u32x4 w = {cvtpk2(p[BASE + 0], p[BASE + 1]), cvtpk2(p[BASE + 2], p[BASE + 3]), cvtpk2(p[BASE + 4], p[BASE + 5]), cvtpk2(p[BASE + 6], p[BASE + 7])}; OUT = *reinterpret_cast<bf16x8*>(&w); } while (0)
    PK4(0, lo); PK4(8, hi);
#undef PK4
}
template <int DQK>
__device__ __forceinline__ void attn_mla2(const Unit& U, char* lds) {
    constexpr int NCH = DQK / 8; constexpr float PLIM = 1073741824.f;
    const int tid = tid_(U.wv), wid = U.wv, lane = tid & 63, r32 = lane & 31, hi = lane >> 5;
    constexpr int KRS = 208, SK2 = 64 * KRS;
    char* V_lds = lds; char* K_lds = lds + 6 * SHM_V;
    float* ws = (float*)(lds + 6 * SHM_V + 6 * SK2) + wid * 64; float* li_l = ws; float* al_l = ws + 32;
    float mA, mB, lA, lB; f32x16 oA[2], oB[2]; bf16x8 qA[DQK / 16], qB[DQK / 16]; bool refA, refB, force = false;
    { const bf16_t* Qw = U.Q + (size_t)(wid * 64 + r32) * U.ldq + hi * 8;
#pragma unroll
      for (int d0 = 0; d0 < DQK / 16; ++d0) { qA[d0] = *reinterpret_cast<const bf16x8*>(Qw + d0 * 16); qB[d0] = *reinterpret_cast<const bf16x8*>(Qw + (size_t)32 * U.ldq + d0 * 16);
#pragma unroll
        for (int e = 0; e < 8; ++e) { qA[d0][e] = (short)f2bf(bf2f((bf16_t)qA[d0][e]) * LOG2E); qB[d0][e] = (short)f2bf(bf2f((bf16_t)qB[d0][e]) * LOG2E); } } }
    const int kc0 = tid, kr0 = kc0 / NCH, kcol0 = (kc0 % NCH) * 8;
    const int kc1 = tid + 512, kr1 = kc1 / NCH, kcol1 = (kc1 % NCH) * 8; const bool has1 = kc1 < 64 * NCH;
    const int vr = tid >> 3, vc = (tid & 7) * 8, vst = v_st(vr, vc);
    const int kst0 = kr0 * KRS + kcol0 * 2, kst1 = kr1 * KRS + kcol1 * 2;
    const int kb_ = r32 * KRS + hi * 16;
    const int vb0 = (int)(uintptr_t)V_lds + v_rd_base(lane);
    bf16x8 sk0, sk1, sv;
    typedef __attribute__((address_space(1))) const char* g_c_p; typedef __attribute__((address_space(1))) const bf16x8* g_b8_p;
    const unsigned ko0 = (unsigned)(kr0 * U.ldk + kcol0) * 2u, ko1 = (unsigned)(kr1 * U.ldk + kcol1) * 2u, vo = (unsigned)(vr * U.ldv + vc) * 2u;
#define SLOAD4(j) do { unsigned long long kj_ = (unsigned long long)((const char*)U.K + (size_t)(64 * (j)) * U.ldk * 2), vj_ = (unsigned long long)((const char*)U.V + (size_t)(64 * (j)) * U.ldv * 2); \
    asm volatile("" : "+s"(kj_), "+s"(vj_)); g_c_p Kj_ = (g_c_p)kj_; g_c_p Vj_ = (g_c_p)vj_; \
    sk0 = *(g_b8_p)(Kj_ + ko0); if (has1) sk1 = *(g_b8_p)(Kj_ + ko1); sv = *(g_b8_p)(Vj_ + vo); } while (0)
#define SWRITE4(b) do { *(bf16x8*)(V_lds + (b) * SHM_V + vst) = sv; *(bf16x8*)(K_lds + (b) * SK2 + kst0) = sk0; if (has1) *(bf16x8*)(K_lds + (b) * SK2 + kst1) = sk1; } while (0)
#define SOFTMAX4(S0, S1, q, m, refnz, l, o, f0, f1, f2, f3, Ks) do { \
    float ps_ = 0.f; \
    if (refnz) { _Pragma("unroll") for (int r = 0; r < 16; ++r) { S0[r] -= (m); S1[r] -= (m); } } \
    _Pragma("unroll") for (int r = 0; r < 16; ++r) S0[r] = __builtin_amdgcn_exp2f(S0[r]); \
    _Pragma("unroll") for (int r = 0; r < 16; ++r) S1[r] = __builtin_amdgcn_exp2f(S1[r]); \
    _Pragma("unroll") for (int r = 0; r < 16; ++r) ps_ += S0[r]; \
    _Pragma("unroll") for (int r = 0; r < 16; ++r) ps_ += S1[r]; \
    { auto rr_ = __builtin_amdgcn_permlane32_swap(__float_as_uint(ps_), __float_as_uint(ps_), false, false); ps_ = __uint_as_float(rr_[0]) + __uint_as_float(rr_[1]); } \
    if (__builtin_expect(force || (MK_TEST == 1 && first_) || __any(!(ps_ <= PLIM)), 0)) { \
        S0 = f32x16{}; S1 = f32x16{}; \
        _Pragma("unroll") for (int d0 = 0; d0 < DQK / 16; ++d0) { \
            const bf16x8 k0_ = *reinterpret_cast<const bf16x8*>(Ks + d0 * 32), k1_ = *reinterpret_cast<const bf16x8*>(Ks + d0 * 32 + 32 * KRS); \
            S0 = __builtin_amdgcn_mfma_f32_32x32x16_bf16(k0_, q[d0], S0, 0, 0, 0); S1 = __builtin_amdgcn_mfma_f32_32x32x16_bf16(k1_, q[d0], S1, 0, 0, 0); } \
        float pm_ = S0[0]; \
        _Pragma("unroll") for (int r = 1; r < 16; ++r) pm_ = fmaxf(pm_, S0[r]); \
        _Pragma("unroll") for (int r = 0; r < 16; ++r) pm_ = fmaxf(pm_, S1[r]); \
        { auto rr_ = __builtin_amdgcn_permlane32_swap(__float_as_uint(pm_), __float_as_uint(pm_), false, false); pm_ = fmaxf(__uint_as_float(rr_[0]), __uint_as_float(rr_[1])); } \
        const float mn_ = fmaxf(m, pm_), al_ = __builtin_amdgcn_exp2f((m) - mn_); m = mn_; l *= al_; refnz = true; \
        if (hi == 0) al_l[r32] = al_; asm volatile("s_waitcnt lgkmcnt(0)" ::: "memory"); \
        _Pragma("unroll") for (int r = 0; r < 16; ++r) { const float a_ = al_l[crow(r, hi)]; o[0][r] *= a_; o[1][r] *= a_; } \
        ps_ = 0.f; \
        _Pragma("unroll") for (int r = 0; r < 16; ++r) { S0[r] = __builtin_amdgcn_exp2f(S0[r] - mn_); ps_ += S0[r]; } \
        _Pragma("unroll") for (int r = 0; r < 16; ++r) { S1[r] = __builtin_amdgcn_exp2f(S1[r] - mn_); ps_ += S1[r]; } \
        { auto rr_ = __builtin_amdgcn_permlane32_swap(__float_as_uint(ps_), __float_as_uint(ps_), false, false); ps_ = __uint_as_float(rr_[0]) + __uint_as_float(rr_[1]); } \
    } \
    l += ps_; \
    { bf16x8 t0_, t1_; sl_pk(S0, t0_, t1_); f0 = t0_; f1 = t1_; sl_pk(S1, t0_, t1_); f2 = t0_; f3 = t1_; } \
} while (0)
    const int NT = U.NT;
#define TILE4(b) do { \
        f32x16 pA0 = {}, pA1 = {}, pB0 = {}, pB1 = {}; \
        const char* Ks = K_lds + (b) * SK2 + kb_; \
        _Pragma("unroll") for (int d0 = 0; d0 < DQK / 16; ++d0) { \
            const bf16x8 k0 = *reinterpret_cast<const bf16x8*>(Ks + d0 * 32), k1 = *reinterpret_cast<const bf16x8*>(Ks + d0 * 32 + 32 * KRS); \
            pA0 = __builtin_amdgcn_mfma_f32_32x32x16_bf16(k0, qA[d0], pA0, 0, 0, 0); pA1 = __builtin_amdgcn_mfma_f32_32x32x16_bf16(k1, qA[d0], pA1, 0, 0, 0); \
            pB0 = __builtin_amdgcn_mfma_f32_32x32x16_bf16(k0, qB[d0], pB0, 0, 0, 0); pB1 = __builtin_amdgcn_mfma_f32_32x32x16_bf16(k1, qB[d0], pB1, 0, 0, 0); SBAR(); }     \
        bf16x8 pa0, pa1, pa2, pa3, pb0, pb1, pb2, pb3; \
        SOFTMAX4(pA0, pA1, qA, mA, refA, lA, oA, pa0, pa1, pa2, pa3, Ks); \
        pv_one<0>(oA[0], vb0 + (b) * SHM_V, pa0, pa1, pa2, pa3); pv_one<1>(oA[1], vb0 + (b) * SHM_V, pa0, pa1, pa2, pa3); \
        SOFTMAX4(pB0, pB1, qB, mB, refB, lB, oB, pb0, pb1, pb2, pb3, Ks); \
        pv_one<0>(oB[0], vb0 + (b) * SHM_V, pb0, pb1, pb2, pb3); pv_one<1>(oB[1], vb0 + (b) * SHM_V, pb0, pb1, pb2, pb3); \
    } while (0)
    int* fl = (int*)lds;
#pragma unroll 1
    for (int pass = 0; pass < 2; ++pass) {
    mA = mB = force ? -1e30f : 0.f; lA = lB = 0.f; refA = refB = false; oA[0] = oA[1] = oB[0] = oB[1] = f32x16{};
    SLOAD4(0); asm volatile("s_waitcnt vmcnt(0)" ::: "memory"); SWRITE4(0); SLOAD4(1); asm volatile("s_waitcnt vmcnt(0)" ::: "memory"); SWRITE4(1); SLOAD4(2); asm volatile("s_waitcnt vmcnt(0)" ::: "memory"); SWRITE4(2); __syncthreads();
    asm volatile(".p2align 8");
#pragma unroll 1
    for (int j = 0; j < NT; j += 3) {
        const bool first_ = j == 0;
        const int s0 = (j % 6), w0 = 3 - s0; const bool more = j + 3 < NT;
        if (more) SLOAD4(j + 3);
        TILE4(s0);
        if (more) { SWRITE4(w0); SLOAD4(j + 4); }
        SBAR();
        TILE4(s0 + 1);
        if (more) { SWRITE4(w0 + 1); SLOAD4(j + 5); }
        SBAR();
        TILE4(s0 + 2);
        if (more) SWRITE4(w0 + 2);
        __syncthreads();
    }
    if (pass) break;
    { const bool bad = (MK_TEST == 2) || __any(!(lA > 1e-30f) || !(lB > 1e-30f));
      if (lane == 0) fl[wid] = bad ? 1 : 0; __syncthreads();
      const bool redo = __any(fl[lane & 7] != 0); __syncthreads();
      if (!redo) break; force = true; }
    }
    const int lane_e = tid_(U.wv) & 63, r32_e = lane_e & 31, hi_e = lane_e >> 5;
#pragma unroll
    for (int t = 0; t < 2; ++t) {
        if (hi_e == 0) li_l[r32_e] = t ? lB : lA; asm volatile("s_waitcnt lgkmcnt(0)" ::: "memory");
        bf16_t* Ow = U.O + (size_t)(wid * 64 + t * 32) * U.ldo;
#pragma unroll
        for (int r = 0; r < 16; ++r) { const int orow = crow(r, hi_e); const float rl = __builtin_amdgcn_rcpf(li_l[orow]);
#pragma unroll
            for (int d0 = 0; d0 < 2; ++d0) Ow[(size_t)orow * U.ldo + d0 * 32 + r32_e] = f2bf((t ? oB[d0][r] : oA[d0][r]) * rl); }
        asm volatile("s_waitcnt lgkmcnt(0)" ::: "memory");
    }
    __syncthreads();
#undef SLOAD4
#undef SWRITE4
#undef SOFTMAX4
#undef TILE4
}
}

__device__ __forceinline__ void phase_mla(const Params& p, lds_t* lds, int l) {
    for (int L = bid_(); L < 256; L += gridDim.x) {
        const int u = gridDim.x == 256 ? ((((L & 7) + 8 * ((L >> 3) & 1)) << 4) | (L >> 4)) : L;
        const int qb = u & 15, h = (u >> 4) & 3, b = u >> 6; const int r0 = b * 8192 + qb * 512;
        att::Unit U{}; U.Q = SP(bf16_t, S_QM) + (size_t)r0 * 384 + h * 96; U.NT = 132; U.O = SP(bf16_t, S_CAT) + (size_t)r0 * 1280 + 768 + h * 64;
        U.K = SP(bf16_t, S_KM) + ((size_t)b * 4 + h) * NKEY * 96; U.V = SP(bf16_t, S_VM) + ((size_t)b * 4 + h) * NKEY * 64;
        U.ldq = 384; U.ldk = 96; U.ldv = 64; U.ldo = 1280; U.wv = p.wv;
        att::attn_mla2<96>(U, (char*)lds);
    }
    if (l == 0) for (int c = bid_(); c < 16; c += gridDim.x) {
        const int h = c & 3, b = c >> 2; const int r0 = TL + b * 256;
        att::Unit U{}; U.Q = SP(bf16_t, S_QM) + (size_t)r0 * 384 + h * 96; U.NT = 4; U.n1 = 4; U.k1 = 8192; U.O = SP(bf16_t, S_CAT) + (size_t)r0 * 1280 + 768 + h * 64;
        U.K = SP(bf16_t, S_KM) + ((size_t)b * 4 + h) * NKEY * 96; U.V = SP(bf16_t, S_VM) + ((size_t)b * 4 + h) * NKEY * 64;
        U.ldq = 384; U.ldk = 96; U.ldv = 64; U.ldo = 1280; U.wv = p.wv;
        att::attn_unit<96, false>(U, (char*)lds);
    }
}
__device__ __forceinline__ void phase_win(const Params& p, lds_t* lds, int l) {
    const int nun = 512 + (l == 0 ? 16 : 0);
    for (int u = bid_(); u < nun; u += gridDim.x) {
        att::Unit U{}; int b, h, r0;
        if (u < 512) { const int qb = u & 31; h = (u >> 5) & 3; b = u >> 7; r0 = b * 8192 + qb * 256; const int q0 = qb * 256;
            const int klo = q0 - 128 < 0 ? 0 : q0 - 128, khi = q0 + 384 > 8192 ? 8192 : q0 + 384;
            U.n1 = 4; U.k1 = 8192; U.k2 = klo; U.NT = 4 + (khi - klo) / 64; U.qpos0 = q0; }
        else { h = (u - 512) & 3; b = (u - 512) >> 2; r0 = TL + b * 256; U.n1 = 4; U.k1 = 8192; U.k2 = 0; U.NT = 4; U.qpos0 = 0; }
        U.Q = SP(bf16_t, S_QW) + (size_t)r0 * 256 + h * 64; U.ldq = 256;
        U.K = SP(bf16_t, S_KW) + (size_t)b * NKEY * 128 + (h >> 1) * 64; U.ldk = 128; U.V = SP(bf16_t, S_VW) + (size_t)b * NKEY * 128 + (h >> 1) * 64; U.ldv = 128;
        U.O = SP(bf16_t, S_CAT) + (size_t)r0 * 1280 + 512 + h * 64; U.ldo = 1280; U.sink = p.win_sink[l * 4 + h]; U.has_sink = 1; U.wv = p.wv;
        att::attn_unit<64, true>(U, (char*)lds);
    }
}


namespace sg {
using bf16x8 = __attribute__((ext_vector_type(8))) short;
using s16x4 = __attribute__((ext_vector_type(4))) short;
using f32x16 = __attribute__((ext_vector_type(16))) float;
__device__ __forceinline__ int crow(int r, int hi) { return (r & 3) + 8 * (r >> 2) + 4 * hi; }
__device__ __forceinline__ int b_off(int k, int n8, int NB32) { return ((k >> 3) * NB32 + (n8 >> 2)) * 512 + (k & 7) * 64 + (n8 & 3) * 16; }
__device__ __forceinline__ int tr_lane(int lane, int NB32) { return (((lane & 15) >> 2) * 64) + (((lane >> 4) & 1) * 32) + ((lane & 3) * 8) + (lane >> 5) * NB32 * 512; }
__device__ __forceinline__ s16x4 tr_read(int addr) { s16x4 r; asm volatile("ds_read_b64_tr_b16 %0, %1" : "=&v"(r) : "v"(addr) : "memory"); return r; }
template <int MT, int KS, bool SWAP = false>
__device__ __forceinline__ void mma_block(f32x16 (&acc)[MT][2], const bf16x8 (&af)[MT][KS], int base, int NB32, int nb0) {
#pragma unroll
    for (int ks = 0; ks < KS; ++ks) {
        const int a0 = base + ((2 * ks) * NB32 + nb0) * 512;
        const s16x4 l0 = tr_read(a0), h0 = tr_read(a0 + 256), l1 = tr_read(a0 + 512), h1 = tr_read(a0 + 512 + 256);
        asm volatile("s_waitcnt lgkmcnt(0)" ::: "memory"); __builtin_amdgcn_sched_barrier(0);
        const bf16x8 b0 = (bf16x8){l0[0], l0[1], l0[2], l0[3], h0[0], h0[1], h0[2], h0[3]}, b1 = (bf16x8){l1[0], l1[1], l1[2], l1[3], h1[0], h1[1], h1[2], h1[3]};
#pragma unroll
        for (int mt = 0; mt < MT; ++mt) {
            if constexpr (SWAP) { acc[mt][0] = __builtin_amdgcn_mfma_f32_32x32x16_bf16(b0, af[mt][ks], acc[mt][0], 0, 0, 0); acc[mt][1] = __builtin_amdgcn_mfma_f32_32x32x16_bf16(b1, af[mt][ks], acc[mt][1], 0, 0, 0); }
            else { acc[mt][0] = __builtin_amdgcn_mfma_f32_32x32x16_bf16(af[mt][ks], b0, acc[mt][0], 0, 0, 0); acc[mt][1] = __builtin_amdgcn_mfma_f32_32x32x16_bf16(af[mt][ks], b1, acc[mt][1], 0, 0, 0); } }
    }
}
template <int KR, int NC>
__device__ __forceinline__ void stage_b(char* lds, const bf16_t* src, size_t ld, int tid) {
    constexpr int CH = NC / 8, TOT = KR * CH;
#pragma unroll
    for (int c = tid; c < TOT; c += 512) { const int k = c / CH, n8 = c % CH;
        *(bf16x8*)(lds + b_off(k, n8, NC / 32)) = *(const bf16x8*)(src + (size_t)k * ld + n8 * 8); }
}
}

__device__ __forceinline__ void phase_fft_a(const Params& p, lds_t* lds_) {
    char* lds = (char*)lds_;
    const int tid = tid_(p.wv), w = p.wv, lane = tid & 63, r32 = lane & 31, hi = lane >> 5, kb = w & 3;
    sg::bf16x8 af[2][8];
#pragma unroll
    for (int mt = 0; mt < 2; ++mt)
#pragma unroll
        for (int ks = 0; ks < 8; ++ks) af[mt][ks] = *(const sg::bf16x8*)(WSP(bf16_t, OFF_FA) + (size_t)(kb * 64 + mt * 32 + r32) * 128 + ks * 16 + 8 * hi);
    const int base = (int)(uintptr_t)lds + sg::tr_lane(lane, 4);
    for (int u = bid_(); u < 512; u += gridDim.x) {
        const int b = u >> 7, T = u & 127;
        sg::stage_b<128, 128>(lds, SP(bf16_t, S_ABUF) + (size_t)b * 8192 * 256 + T * 128, 16384, tid);
        __syncthreads();
        sg::f32x16 acc[2][2] = {};
        sg::mma_block<2, 8>(acc, af, base, 4, 2 * (w >> 2));
        const int n2 = T >> 1, cb = (T & 1) * 128 + 64 * (w >> 2) + r32;
#pragma unroll
        for (int r = 0; r < 16; ++r) { const int k1 = kb * 32 + sg::crow(r, hi); const float2 t = WSP(float2, OFF_TW)[n2 * 128 + k1];
            bf16_t* o = SP(bf16_t, S_UP) + ((((size_t)b * 128 + k1) * 2) * 64 + n2) * 256 + cb;
#pragma unroll
            for (int nt = 0; nt < 2; ++nt) { const float ur = acc[0][nt][r], ui = acc[1][nt][r]; o[nt * 32] = f2bf(ur * t.x + ui * t.y); o[64 * 256 + nt * 32] = f2bf(ui * t.x - ur * t.y); } }
        __syncthreads();
    }
}
__device__ __forceinline__ void phase_fft_c(const Params& p, lds_t* lds_) {
    char* lds = (char*)lds_;
    const int tid = tid_(p.wv), w = p.wv, lane = tid & 63, r32 = lane & 31, hi = lane >> 5, rio = w & 1;
    sg::bf16x8 af[2][8];
#pragma unroll
    for (int mt = 0; mt < 2; ++mt)
#pragma unroll
        for (int ks = 0; ks < 8; ++ks) af[mt][ks] = *(const sg::bf16x8*)(WSP(bf16_t, OFF_GM) + (size_t)(rio * 64 + mt * 32 + r32) * 128 + ks * 16 + 8 * hi);
    const int base = (int)(uintptr_t)lds + sg::tr_lane(lane, 8);
    for (int u = bid_(); u < 512; u += gridDim.x) {
        const int b = u >> 7, k1 = u & 127;
        sg::stage_b<128, 256>(lds, SP(bf16_t, S_UP) + (size_t)u * 128 * 256, 256, tid);
        __syncthreads();
        sg::f32x16 acc[2][2] = {};
        sg::mma_block<2, 8>(acc, af, base, 8, 2 * (w >> 1));
#pragma unroll
        for (int mt = 0; mt < 2; ++mt)
#pragma unroll
            for (int r = 0; r < 16; ++r) { const int k2 = mt * 32 + sg::crow(r, hi);
                bf16_t* o = SP(bf16_t, S_CAT) + ((size_t)b * 8192 + k1 + 128 * k2) * 1280 + rio * 256 + 64 * (w >> 1) + r32;
                o[0] = f2bf(acc[mt][0][r]); o[32] = f2bf(acc[mt][1][r]); }
        __syncthreads();
    }
}
__device__ __forceinline__ void phase_dft_ctx(const Params& p, lds_t* lds_) {
    char* lds = (char*)lds_;
    const int tid = tid_(p.wv), w = p.wv, lane = tid & 63, r32 = lane & 31, hi = lane >> 5;
    const int base = (int)(uintptr_t)lds + sg::tr_lane(lane, 4);
    for (int u = (int)gridDim.x - 64 - bid_(); u < 32; u += gridDim.x) { if (u < 0) continue;
        const int b = u >> 3, mb = (u >> 1) & 3, nh = u & 1;
        sg::bf16x8 af[1][16];
#pragma unroll
        for (int ks = 0; ks < 16; ++ks) af[0][ks] = *(const sg::bf16x8*)(WSP(bf16_t, OFF_FC) + (size_t)(mb * 128 + 32 * (w & 3) + r32) * 256 + ks * 16 + 8 * hi);
        sg::stage_b<256, 128>(lds, SP(bf16_t, S_ABUF) + ((size_t)TL + b * 256) * 256 + nh * 128, 256, tid);
        __syncthreads();
        sg::f32x16 acc[1][2] = {};
        sg::mma_block<1, 16>(acc, af, base, 4, 2 * (w >> 2));
#pragma unroll
        for (int r = 0; r < 16; ++r) { const int row = mb * 128 + 32 * (w & 3) + sg::crow(r, hi), ri = row >> 8, k = row & 255;
            bf16_t* o = SP(bf16_t, S_CAT) + ((size_t)TL + b * 256 + k) * 1280 + ri * 256 + nh * 128 + 64 * (w >> 2) + r32;
            o[0] = f2bf(acc[0][0][r]); o[32] = f2bf(acc[0][1][r]); }
        __syncthreads();
    }
}
__device__ __forceinline__ void phase_sgu(const Params& p, lds_t* lds_, int l) {
    char* lds = (char*)lds_;
    const int tid = tid_(p.wv), w = p.wv, lane = tid & 63, r32 = lane & 31, hi = lane >> 5, g = w >> 1, mh = w & 1;
    sg::bf16x8 af[2][8];
#pragma unroll
    for (int mt = 0; mt < 2; ++mt)
#pragma unroll
        for (int ks = 0; ks < 8; ++ks) { const float* src = p.sgu_w + ((size_t)(l * 4 + g) * 128 + mh * 64 + mt * 32 + r32) * 128 + ks * 16 + 8 * hi;
            const float4 a = *(const float4*)src, b = *(const float4*)(src + 4); const float v[8] = {a.x, a.y, a.z, a.w, b.x, b.y, b.z, b.w}; const pg8::u32x4 pk = pack8(v); af[mt][ks] = *(const sg::bf16x8*)&pk; }
    const int base = (int)(uintptr_t)lds + sg::tr_lane(lane, 8);
    const int nch = l == 0 ? RR / 128 : TL / 128;
    for (int u = (int)gridDim.x - 1 - bid_(); u < nch; u += gridDim.x) {
        const int r0 = u * 128;
#pragma unroll
        for (int c = tid; c < 128 * 32; c += 512) { const int q = c >> 5, n8 = c & 31;
            const float* st = WSP(float, OFF_LNS) + (size_t)(r0 + q) * 8; const float4 sa = *(const float4*)st, sb = *(const float4*)(st + 4);
            const float s1 = (sa.x + sa.z) + (sb.x + sb.z), s2 = (sa.y + sa.w) + (sb.y + sb.w), mu = s1 * (1.f / 256.f), rstd = rsqrtf(fmaxf(s2 * (1.f / 256.f) - mu * mu, 0.f) + EPS);
            const pg8::u32x4 raw = *(const pg8::u32x4*)(SP(bf16_t, S_VG) + (size_t)(r0 + q) * 256 + n8 * 8); float v[8];
#pragma unroll
            for (int e = 0; e < 4; ++e) { v[2 * e] = (__uint_as_float(raw[e] << 16) - mu) * rstd; v[2 * e + 1] = (__uint_as_float(raw[e] & 0xffff0000u) - mu) * rstd; }
            *(pg8::u32x4*)(lds + sg::b_off(q, n8, 8)) = pack8(v); }
        __syncthreads();
        sg::f32x16 acc[2][2] = {};
        sg::mma_block<2, 8, true>(acc, af, base, 8, 2 * g);
        bf16_t* simg = (bf16_t*)(lds + 65536);
#pragma unroll
        for (int mt = 0; mt < 2; ++mt) { const int pp = mh * 64 + mt * 32 + r32; const float bias = p.sgu_b[(l * 4 + g) * 128 + pp];
#pragma unroll
            for (int nt = 0; nt < 2; ++nt)
#pragma unroll
                for (int t4 = 0; t4 < 4; ++t4) { pg8::u32x2 w; w.x = pg8::cvt_pk_bf16(acc[mt][nt][4 * t4] + bias, acc[mt][nt][4 * t4 + 1] + bias); w.y = pg8::cvt_pk_bf16(acc[mt][nt][4 * t4 + 2] + bias, acc[mt][nt][4 * t4 + 3] + bias);
                    *(pg8::u32x2*)(simg + pp * 256 + g * 64 + nt * 32 + 8 * t4 + 4 * hi) = w; } }
        __syncthreads();
#pragma unroll
        for (int c = tid; c < 128 * 32; c += 512) { const int pp = c >> 5, n8 = c & 31; const size_t row = (size_t)r0 + pp;
            const pg8::u32x4 sv = *(const pg8::u32x4*)(simg + pp * 256 + n8 * 8), uv = *(const pg8::u32x4*)(SP(bf16_t, S_U) + row * 256 + n8 * 8); float v[8];
#pragma unroll
            for (int e = 0; e < 4; ++e) { v[2 * e] = __uint_as_float(sv[e] << 16) * __uint_as_float(uv[e] << 16); v[2 * e + 1] = __uint_as_float(sv[e] & 0xffff0000u) * __uint_as_float(uv[e] & 0xffff0000u); }
            *(pg8::u32x4*)(SP(bf16_t, S_CAT) + row * 1280 + 1024 + n8 * 8) = pack8(v); }
    }
    __syncthreads();
}
enum { PH_CVT = 0, PH_FFN_GU, PH_FFN_DN, PH_MOE_GU, PH_MOE_DN, PH_INPROJ, PH_UP, PH_OUTPROJ, PH_MLA, PH_WIN, PH_FFTA, PH_FFTC, PH_DFTC, PH_SGU, PH_PROA, PH_PROB, PH_NORM1, PH_POSTMIX, PH_ASSIGN, PH_POSTFFN };

__device__ __forceinline__ float wave_sum(float v) {
    const int l4 = lane_() << 2;
#pragma unroll
    for (int o = 32; o > 0; o >>= 1) v += __int_as_float(__builtin_amdgcn_ds_bpermute(l4 ^ (o << 2), __float_as_int(v)));
    return v;
}
__device__ __forceinline__ const float* hx_in_row(const Params& p, int l, int r) {
    if (l == 0) return r < TL ? p.x + (size_t)r * 1024 : p.ctx + (size_t)(r - TL) * 1024;
    return r < TL ? p.out + (size_t)r * 1024 : WSP(float, OFF_HXC) + (size_t)(r - TL) * 1024;
}
__device__ __forceinline__ float* hx_row(const Params& p, int r) { return r < TL ? p.out + (size_t)r * 1024 : WSP(float, OFF_HXC) + (size_t)(r - TL) * 1024; }
__device__ __forceinline__ void store4bf(bf16_t* dst, const float4 v) { pg8::u32x2 w; w.x = pg8::cvt_pk_bf16(v.x, v.y); w.y = pg8::cvt_pk_bf16(v.z, v.w); *(pg8::u32x2*)dst = w; }
__device__ __forceinline__ float4 load4bf(const bf16_t* src) { const pg8::u32x2 w = *(const pg8::u32x2*)src; return make_float4(__uint_as_float(w.x << 16), __uint_as_float(w.x & 0xffff0000u), __uint_as_float(w.y << 16), __uint_as_float(w.y & 0xffff0000u)); }
__device__ __forceinline__ float4 hx_load4(const Params& p, int kind, int r, int k) {
    if (kind == 0) return *(const float4*)((r < TL ? p.x + (size_t)r * 1024 : p.ctx + (size_t)(r - TL) * 1024) + k);
    if (r < TL) return load4bf((const bf16_t*)((const char*)p.out + (size_t)r * 4096 + 2048) + k);
    return *(const float4*)(WSP(float, OFF_HXC) + (size_t)(r - TL) * 1024 + k);
}
__device__ __forceinline__ void hx_store4(const Params& p, int r, int k, const float4 v) {
    if (r < TL) store4bf((bf16_t*)((char*)p.out + (size_t)r * 4096 + 2048) + k, v);
    else *(float4*)(WSP(float, OFF_HXC) + (size_t)(r - TL) * 1024 + k) = v;
}
#define F4OP(dst, expr) do { (dst).x = (expr(x)); (dst).y = (expr(y)); (dst).z = (expr(z)); (dst).w = (expr(w)); } while (0)
__device__ __forceinline__ float half_sum(float v) {
    const int l4 = lane_() << 2;
#pragma unroll
    for (int o = 16; o > 0; o >>= 1) v += __int_as_float(__builtin_amdgcn_ds_bpermute(l4 ^ (o << 2), __float_as_int(v)));
    return v;
}
__device__ __forceinline__ float qsum(float v) {
    const int l4 = lane_() << 2;
#pragma unroll
    for (int o = 8; o > 0; o >>= 1) v += __int_as_float(__builtin_amdgcn_ds_bpermute(l4 ^ (o << 2), __float_as_int(v)));
    return v;
}
#define SQ4(v) ((v).x * (v).x + (v).y * (v).y + (v).z * (v).z + (v).w * (v).w)
struct V8 { float v[8]; };
__device__ __forceinline__ V8 ld8_f32(const float* q) { const float4 a = *(const float4*)q, b = *(const float4*)(q + 4); return V8{{a.x, a.y, a.z, a.w, b.x, b.y, b.z, b.w}}; }
__device__ __forceinline__ V8 ld8_bf16(const bf16_t* q) { const pg8::u32x4 w = *(const pg8::u32x4*)q; V8 r;
#pragma unroll
    for (int e = 0; e < 4; ++e) { r.v[2 * e] = __uint_as_float(w[e] << 16); r.v[2 * e + 1] = __uint_as_float(w[e] & 0xffff0000u); } return r; }
__device__ __forceinline__ void st8_bf16(bf16_t* q, const V8& a) { *(pg8::u32x4*)q = pack8(a.v); }
__device__ __forceinline__ void st8_f32nt(float* q, const V8& a) { __builtin_nontemporal_store((pg8::f32x4){a.v[0], a.v[1], a.v[2], a.v[3]}, (pg8::f32x4*)q); __builtin_nontemporal_store((pg8::f32x4){a.v[4], a.v[5], a.v[6], a.v[7]}, (pg8::f32x4*)(q + 4)); }
__device__ __forceinline__ void st8_fp8(unsigned char* q, const V8& a) { pg8::u32x2 w; w.x = fp8x4(clamp448(a.v[0]), clamp448(a.v[1]), clamp448(a.v[2]), clamp448(a.v[3])); w.y = fp8x4(clamp448(a.v[4]), clamp448(a.v[5]), clamp448(a.v[6]), clamp448(a.v[7])); *(pg8::u32x2*)q = w; }
__device__ __forceinline__ float sq8(const V8& a) { float s = 0;
#pragma unroll
    for (int e = 0; e < 8; ++e) s += a.v[e] * a.v[e]; return s; }
__device__ __forceinline__ V8 hx_load8(const Params& p, int kind, int r, int k) {
    if (kind == 0) return ld8_f32((r < TL ? p.x + (size_t)r * 1024 : p.ctx + (size_t)(r - TL) * 1024) + k);
    if (r < TL) return ld8_bf16((const bf16_t*)((const char*)p.out + (size_t)r * 4096 + 2048) + k);
    return ld8_f32(WSP(float, OFF_HXC) + (size_t)(r - TL) * 1024 + k);
}
__device__ __forceinline__ void hx_store8(const Params& p, int r, int k, const V8& a) {
    if (r < TL) st8_bf16((bf16_t*)((char*)p.out + (size_t)r * 4096 + 2048) + k, a);
    else { *(float4*)(WSP(float, OFF_HXC) + (size_t)(r - TL) * 1024 + k) = make_float4(a.v[0], a.v[1], a.v[2], a.v[3]); *(float4*)(WSP(float, OFF_HXC) + (size_t)(r - TL) * 1024 + k + 4) = make_float4(a.v[4], a.v[5], a.v[6], a.v[7]); }
}
typedef __attribute__((address_space(3))) float lds_fl;
__device__ __forceinline__ V8 lds8(const lds_fl* q) { const pg8::f32x4 a = *(const __attribute__((address_space(3))) pg8::f32x4*)q, b = *(const __attribute__((address_space(3))) pg8::f32x4*)(q + 4); return V8{{a[0], a[1], a[2], a[3], b[0], b[1], b[2], b[3]}}; }
constexpr int EW_PAR_OFF = 49152;
__device__ __forceinline__ int seg_end(int r0, int rend) { const int nb = r0 < TL ? ((((r0 >> 13) + 1) << 13) < TL ? (((r0 >> 13) + 1) << 13) : TL) : RR; return nb < rend ? nb : rend; }
__device__ __forceinline__ void phase_norm1(const Params& p, lds_t* lds, int l) {
    const int tid = tid_(p.wv), lane = tid & 63, sl0 = lane & 15, q = p.wv * 4 + (lane >> 4), G = gridDim.x, RPB = (RR + G - 1) / G;
    lds_fl* par = (lds_fl*)(lds + EW_PAR_OFF);
    const int rbeg = bid_() * RPB, rend = rbeg + RPB < RR ? rbeg + RPB : RR;
    for (int r0 = rbeg; r0 < rend;) { const int r1 = seg_end(r0, rend); const float* mod = WSP(float, OFF_MOD) + ((size_t)l * 5 + row_cond(r0)) * 6144;
        __syncthreads();
        for (int i = tid; i < 1024; i += 512) { par[i] = p.g_pre_mix[l * 1024 + i]; par[1024 + i] = 1.f + mod[1024 + i]; par[2048 + i] = mod[i]; }
        __syncthreads();
        for (int rw = r0 + p.wv * 4; rw < r1; rw += 32) {
            int sl = sl0; asm volatile("" : "+v"(sl));
            const int rr = rw + (lane >> 4); const bool ok = rr < r1; const int r = ok ? rr : r0;
            V8 v[8]; float ss = 0;
#pragma unroll
            for (int i = 0; i < 8; ++i) { v[i] = hx_load8(p, l == 0 ? 0 : 1, r, sl * 8 + 128 * i); ss += sq8(v[i]); }
            const float rstd = rsqrtf(qsum(ss) * (1.f / 1024.f) + EPS);
#pragma unroll
            for (int i = 0; i < 8; ++i) { const int k = sl * 8 + 128 * i; const V8 gg = lds8(par + k), sc = lds8(par + 1024 + k), sh = lds8(par + 2048 + k); V8 y;
#pragma unroll
                for (int e = 0; e < 8; ++e) y.v[e] = v[i].v[e] * rstd * gg.v[e] * sc.v[e] + sh.v[e];
                if (ok) st8_bf16(WSP(bf16_t, OFF_XN) + (size_t)r * 1024 + k, y); }
        }
        r0 = r1; }
    __syncthreads(); (void)q;
}
__device__ __forceinline__ void phase_postmix(const Params& p, lds_t* lds, int l) {
    const int tid = tid_(p.wv), lane = tid & 63, sl0 = lane & 15, G = gridDim.x, g = (bid_() * 8 + p.wv) * 4 + (lane >> 4);
    const int nrows = l == 0 ? RR : TL, RPB = (nrows + G - 1) / G;
    if (l == 1) for (int i = bid_() * 512 + tid; i < NSORT; i += G * 512) WSP(int, OFF_ROWIDX)[i] = 0;
    int wcnt[8] = {0, 0, 0, 0, 0, 0, 0, 0};
    typedef __attribute__((address_space(3))) pg8::f32x4 lds_f4;
    const lds_f4* wrl = (const lds_f4*)lds;
    lds_fl* par = (lds_fl*)(lds + EW_PAR_OFF);
    if (l == 1) { for (int i = tid; i < 2048; i += 512) ((lds_f4*)lds)[i] = ((const pg8::f32x4*)p.moe_w_router)[i]; }
    const int rbeg = bid_() * RPB, rend = rbeg + RPB < nrows ? rbeg + RPB : nrows;
    for (int r0 = rbeg; r0 < rend;) { const int r1 = seg_end(r0, rend); const float* mod = WSP(float, OFF_MOD) + ((size_t)l * 5 + row_cond(r0)) * 6144;
        __syncthreads();
        for (int i = tid; i < 1024; i += 512) { par[i] = p.g_post_mix[l * 1024 + i] * mod[2048 + i]; par[1024 + i] = p.g_pre_ffn[l * 1024 + i] * (1.f + mod[4096 + i]); par[2048 + i] = mod[3072 + i]; }
        __syncthreads();
        for (int rw = r0 + p.wv * 4; rw < r1; rw += 32) {
            int sl = sl0; asm volatile("" : "+v"(sl));
            const int rr = rw + (lane >> 4); const bool ok = rr < r1; const int r = ok ? rr : r0;
            pg8::u32x4 mp[8]; V8 hv[8]; float ss = 0;
#pragma unroll
            for (int i = 0; i < 8; ++i) mp[i] = *(const pg8::u32x4*)(SP(bf16_t, S_MX) + (size_t)r * 1024 + sl * 8 + 128 * i);
#pragma unroll
            for (int i = 0; i < 8; ++i) hv[i] = hx_load8(p, l == 0 ? 0 : 1, r, sl * 8 + 128 * i);
#pragma unroll
            for (int i = 0; i < 8; ++i)
#pragma unroll
                for (int e = 0; e < 4; ++e) { const float a_ = __uint_as_float(mp[i][e] << 16), b_ = __uint_as_float(mp[i][e] & 0xffff0000u); ss += a_ * a_ + b_ * b_; }
            const float rstd = rsqrtf(qsum(ss) * (1.f / 1024.f) + EPS); float s2 = 0;
#pragma unroll
            for (int i = 0; i < 8; ++i) { const int k = sl * 8 + 128 * i; const V8 gg = lds8(par + k);
#pragma unroll
                for (int e = 0; e < 4; ++e) { hv[i].v[2 * e] += gg.v[2 * e] * (__uint_as_float(mp[i][e] << 16) * rstd); hv[i].v[2 * e + 1] += gg.v[2 * e + 1] * (__uint_as_float(mp[i][e] & 0xffff0000u) * rstd); }
                if (ok) hx_store8(p, r, k, hv[i]);
                s2 += sq8(hv[i]); }
            const float rstd2 = rsqrtf(qsum(s2) * (1.f / 1024.f) + EPS);
            float lg[8] = {0, 0, 0, 0, 0, 0, 0, 0};
#pragma unroll
            for (int i = 0; i < 8; ++i) { const int k = sl * 8 + 128 * i; const V8 gg = lds8(par + 1024 + k), sh = lds8(par + 2048 + k); V8 fx;
#pragma unroll
                for (int e = 0; e < 8; ++e) fx.v[e] = hv[i].v[e] * rstd2 * gg.v[e] + sh.v[e];
                if (ok) { if (l == 1 || DENSE_FP8 == 1) st8_fp8((unsigned char*)WSP(bf16_t, OFF_XN) + (size_t)r * 1024 + k, fx); else st8_bf16(WSP(bf16_t, OFF_XN) + (size_t)r * 1024 + k, fx); }
                hv[i] = fx; }
            if (l == 1) {
#pragma unroll
                for (int i = 0; i < 8; ++i) { const lds_f4* wr = wrl + (sl * 8 + 128 * i) * 2;
#pragma unroll
                    for (int e = 0; e < 8; ++e) { const float f = hv[i].v[e]; const pg8::f32x4 wa = wr[e * 2], wb = wr[e * 2 + 1];
                        lg[0] += f * wa[0]; lg[1] += f * wa[1]; lg[2] += f * wa[2]; lg[3] += f * wa[3]; lg[4] += f * wb[0]; lg[5] += f * wb[1]; lg[6] += f * wb[2]; lg[7] += f * wb[3]; } }
#pragma unroll
                for (int e = 0; e < 8; ++e) lg[e] = qsum(lg[e]);
                int e0 = 0; float v0 = lg[0];
#pragma unroll
                for (int e = 1; e < 8; ++e) if (lg[e] > v0) { v0 = lg[e]; e0 = e; }
                int e1 = -1; float v1 = -3.0e38f;
#pragma unroll
                for (int e = 0; e < 8; ++e) if (e != e0 && lg[e] > v1) { v1 = lg[e]; e1 = e; }
                if (ok) {
#pragma unroll
                    for (int e = 0; e < 8; ++e) wcnt[e] += (e0 == e) + (e1 == e);
                    if (sl == 0) { const float w1 = __expf(v1 - v0), inv = 1.f / (1.f + w1);
                        WSP(int, OFF_TOKE)[r * 2] = e0; WSP(int, OFF_TOKE)[r * 2 + 1] = e1; WSP(float, OFF_TOKW)[r * 2] = inv; WSP(float, OFF_TOKW)[r * 2 + 1] = w1 * inv; } }
            }
        }
        r0 = r1; }
    if (l == 1) {
        __syncthreads();
        int* lc = (int*)(lds + 40960);
        if (sl0 == 0) { int4* dst = (int4*)(WSP(int, OFF_LNS) + (size_t)g * 8); dst[0] = make_int4(wcnt[0], wcnt[1], wcnt[2], wcnt[3]); dst[1] = make_int4(wcnt[4], wcnt[5], wcnt[6], wcnt[7]);
            const int o_ = p.wv * 4 + (lane >> 4);
#pragma unroll
            for (int e = 0; e < 8; ++e) lc[o_ * 8 + e] = wcnt[e]; }
        __syncthreads();
        if (tid < 8) { int t_ = 0;
#pragma unroll
            for (int o_ = 0; o_ < 32; ++o_) t_ += lc[o_ * 8 + tid];
            WSP(int, OFF_LNS)[(size_t)G * 32 * 8 + bid_() * 8 + tid] = t_; }
    }
    __syncthreads();
}
__device__ __forceinline__ void phase_moe_assign(const Params& p) {
    const int tid = tid_(p.wv), lane = tid & 63, gw = bid_() * 8 + p.wv, nown = gridDim.x * 32;
    const int* cntW = WSP(int, OFF_LNS); const int* cntB = cntW + (size_t)gridDim.x * 32 * 8;
    int tot[8] = {0, 0, 0, 0, 0, 0, 0, 0}, pre[8] = {0, 0, 0, 0, 0, 0, 0, 0};
    const int myb = bid_();
    for (int b = lane; b < (int)gridDim.x; b += 64) { const int4 a = *(const int4*)(cntB + (size_t)b * 8), c4 = *(const int4*)(cntB + (size_t)b * 8 + 4); const int c[8] = {a.x, a.y, a.z, a.w, c4.x, c4.y, c4.z, c4.w}; const int m = b < myb ? 1 : 0;
#pragma unroll
        for (int e = 0; e < 8; ++e) { tot[e] += c[e]; pre[e] += m * c[e]; } }
    if (lane < 32) { const int go = myb * 32 + lane; const int4 a = *(const int4*)(cntW + (size_t)go * 8), c4 = *(const int4*)(cntW + (size_t)go * 8 + 4); const int c[8] = {a.x, a.y, a.z, a.w, c4.x, c4.y, c4.z, c4.w}; const int m = go < 4 * gw ? 1 : 0;
#pragma unroll
        for (int e = 0; e < 8; ++e) pre[e] += m * c[e]; }
#pragma unroll
    for (int e = 0; e < 8; ++e)
#pragma unroll
        for (int o = 32; o > 0; o >>= 1) { tot[e] += __builtin_amdgcn_ds_bpermute((lane << 2) ^ (o << 2), tot[e]); pre[e] += __builtin_amdgcn_ds_bpermute((lane << 2) ^ (o << 2), pre[e]); }
    int off[9]; { int o = 0;
#pragma unroll
        for (int e = 0; e < 8; ++e) { off[e] = o; o += ((tot[e] + 255) >> 8) << 8; } off[8] = o; }
    int* cw = (int*)p.ws;
    if (gw == 0 && lane == 0) cw[CW_NT] = off[8] >> 8;
    for (int t = bid_() * 512 + tid; t < 272; t += gridDim.x * 512) { int e = 0;
#pragma unroll
        for (int q = 1; q < 8; ++q) if (t * 256 >= off[q]) e = q;
        WSP(int, OFF_TILEE)[t] = e; }
    int base[8];
#pragma unroll
    for (int e = 0; e < 8; ++e) base[e] = off[e] + pre[e];
    const int j = lane & 15, G = gridDim.x, RPB = (TL + G - 1) / G, rbeg = bid_() * RPB, rend = rbeg + RPB < TL ? rbeg + RPB : TL;
    const unsigned char* xn8 = (const unsigned char*)WSP(bf16_t, OFF_XN); unsigned char* xs8 = (unsigned char*)SP(bf16_t, S_YS);
    for (int r0 = rbeg; r0 < rend;) { const int r1 = seg_end(r0, rend);
        for (int k0 = 0; r0 + p.wv * 4 + 32 * k0 < r1; k0 += 8) {
            const int r = r0 + p.wv * 4 + (lane >> 4) + 32 * (k0 + (j >> 1)); const bool ok = r < r1;
            const int e = ok ? WSP(int, OFF_TOKE)[r * 2 + (j & 1)] : -1; int pos = 0;
#pragma unroll
            for (int q = 0; q < 8; ++q) { const unsigned long long mk = __ballot(e == q); if (e == q) pos = base[q] + __popcll(mk & ((1ull << lane) - 1ull)); base[q] += __popcll(mk); }
            if (ok) { WSP(int, OFF_ROWIDX)[pos] = r; WSP(int, OFF_TOKS)[r * 2 + (j & 1)] = pos; }
#pragma unroll
            for (int q = 0; q < 64; ++q) { const int rq = __builtin_amdgcn_readlane(r, q), pq = __builtin_amdgcn_readlane(pos, q), okq = __builtin_amdgcn_readlane((int)ok, q);
                if (okq) *(uint4*)(xs8 + (size_t)pq * 1024 + lane * 16) = *(const uint4*)(xn8 + (size_t)rq * 1024 + lane * 16); }
        }
        r0 = r1; }
}
__device__ __forceinline__ void phase_postffn(const Params& p, lds_t* lds, int l) {
    const int tid = tid_(p.wv), lane = tid & 63, sl0 = lane & 15, G = gridDim.x;
    const int nrows = l == 0 ? RR : TL, RPB = (nrows + G - 1) / G;
    lds_fl* par = (lds_fl*)(lds + EW_PAR_OFF);
    const int rbeg = bid_() * RPB, rend = rbeg + RPB < nrows ? rbeg + RPB : nrows;
    for (int r0 = rbeg; r0 < rend;) { const int r1 = seg_end(r0, rend); const float* mod = WSP(float, OFF_MOD) + ((size_t)l * 5 + row_cond(r0)) * 6144; const float* mod1 = WSP(float, OFF_MOD) + ((size_t)5 + row_cond(r0)) * 6144;
        __syncthreads();
        for (int i = tid; i < 1024; i += 512) { par[i] = p.g_post_ffn[l * 1024 + i] * mod[5120 + i]; if (l == 0) { par[1024 + i] = p.g_pre_mix[1024 + i] * (1.f + mod1[1024 + i]); par[2048 + i] = mod1[i]; } }
        __syncthreads();
        for (int rw = r0 + p.wv * 4; rw < r1; rw += 32) {
            int sl = sl0; asm volatile("" : "+v"(sl));
            const int rr = rw + (lane >> 4); const bool ok = rr < r1; const int r = ok ? rr : r0;
            V8 y[8], hv[8]; float ss = 0;
            if (l == 0) {
#pragma unroll
                for (int i = 0; i < 8; ++i) y[i] = ld8_bf16(WSP(bf16_t, OFF_XN) + (size_t)r * 1024 + sl * 8 + 128 * i);
#pragma unroll
                for (int i = 0; i < 8; ++i) hv[i] = hx_load8(p, 1, r, sl * 8 + 128 * i);
            } else { const bf16_t* y0 = ys_row(p, WSP(int, OFF_TOKS)[r * 2]); const bf16_t* y1 = ys_row(p, WSP(int, OFF_TOKS)[r * 2 + 1]); const float w0 = WSP(float, OFF_TOKW)[r * 2], w1 = WSP(float, OFF_TOKW)[r * 2 + 1];
                pg8::u32x4 ya[8], yb[8];
#pragma unroll
                for (int i = 0; i < 8; ++i) { ya[i] = *(const pg8::u32x4*)(y0 + sl * 8 + 128 * i); yb[i] = *(const pg8::u32x4*)(y1 + sl * 8 + 128 * i); }
#pragma unroll
                for (int i = 0; i < 8; ++i) hv[i] = hx_load8(p, 1, r, sl * 8 + 128 * i);
#pragma unroll
                for (int i = 0; i < 8; ++i)
#pragma unroll
                    for (int e = 0; e < 4; ++e) { y[i].v[2 * e] = w0 * __uint_as_float(ya[i][e] << 16) + w1 * __uint_as_float(yb[i][e] << 16); y[i].v[2 * e + 1] = w0 * __uint_as_float(ya[i][e] & 0xffff0000u) + w1 * __uint_as_float(yb[i][e] & 0xffff0000u); } }
#pragma unroll
            for (int i = 0; i < 8; ++i) ss += sq8(y[i]);
            const float rstd = rsqrtf(qsum(ss) * (1.f / 1024.f) + EPS); float s2 = 0;
#pragma unroll
            for (int i = 0; i < 8; ++i) { const int k = sl * 8 + 128 * i; const V8 gg = lds8(par + k);
#pragma unroll
                for (int e = 0; e < 8; ++e) hv[i].v[e] += gg.v[e] * (y[i].v[e] * rstd);
                if (l == 0 && ok) hx_store8(p, r, k, hv[i]); s2 += sq8(hv[i]); }
            if (l == 1) {
                asm volatile("s_waitcnt vmcnt(0)" ::: "memory");
                if (ok) {
#pragma unroll
                    for (int i = 0; i < 8; ++i) st8_f32nt(p.out + (size_t)r * 1024 + sl * 8 + 128 * i, hv[i]); } }
            if (l == 0) { const float rstd2 = rsqrtf(qsum(s2) * (1.f / 1024.f) + EPS);
#pragma unroll
                for (int i = 0; i < 8; ++i) { const int k = sl * 8 + 128 * i; const V8 gg = lds8(par + 1024 + k), sh = lds8(par + 2048 + k); V8 v;
#pragma unroll
                    for (int e = 0; e < 8; ++e) v.v[e] = hv[i].v[e] * rstd2 * gg.v[e] + sh.v[e];
                    if (ok) st8_bf16(WSP(bf16_t, OFF_XN) + (size_t)r * 1024 + k, v); } }
        }
        r0 = r1; }
    __syncthreads();
}
constexpr size_t S_MODP = 0;
__device__ __forceinline__ void phase_pro_a(const Params& p, lds_t* lds) {
    const int gt = bid_() * 512 + tid_(p.wv), ng = gridDim.x * 512;
    const double PI2 = 6.283185307179586476925;
    for (int i = gt; i < 8192; i += ng) {
        if (i < 128 * 16) { const int co = i >> 4, j = i & 15; const double a = (double)co * pow(10000.0, -(double)j / 16.0); WSP(float2, OFF_ROPEW)[i] = make_float2((float)cos(a), (float)sin(a)); }
        if (i < 128 * 8) { const int co = i >> 3, j = i & 7; const double a = (double)co * pow(10000.0, -(double)j / 8.0); WSP(float2, OFF_ROPEM)[i] = make_float2((float)cos(a), (float)sin(a)); }
        if (i < 64 * 128) { const int n2 = i >> 7, k1 = i & 127; const double a = PI2 * (double)(k1 * n2) / 8192.0; WSP(float2, OFF_TW)[i] = make_float2((float)cos(a), (float)sin(a)); }
    }
    for (int i = gt; i < 512 * 256; i += ng) {
        if (i < 256 * 128) { const int m = i >> 7, n1 = i & 127, kb = m >> 6, ri = (m >> 5) & 1, k1 = kb * 32 + (m & 31); float sn, cs; sincospif((float)((k1 * n1) & 127) * (1.f / 64.f), &sn, &cs);
            WSP(bf16_t, OFF_FA)[i] = f2bf((ri ? -sn : cs) * (1.f / 724.0773439350247f)); }
        if (i < 128 * 128) { const int m = i >> 7, kc = i & 127, rio = m >> 6, k2 = m & 63, rii = kc >> 6, n2 = kc & 63; float sn, cs; sincospif((float)((n2 * k2) & 63) * (1.f / 32.f), &sn, &cs);
            WSP(bf16_t, OFF_GM)[i] = f2bf(rio == rii ? cs : (rio == 0 ? sn : -sn)); }
        { const int row = i >> 8, n = i & 255, ri = row >> 8, k = row & 255; float sn, cs; sincospif((float)((k * n) & 255) * (1.f / 128.f), &sn, &cs);
            WSP(bf16_t, OFF_FC)[i] = f2bf((ri ? -sn : cs) * (1.f / 128.f)); }
    }
    { const int t = tid_(p.wv); float2* trig = (float2*)lds;
      if (t < 64) { float sn, cs; sincospif((float)t * (1.f / 32.f), &sn, &cs); trig[t] = make_float2(cs, sn); }
      __syncthreads();
      for (int i = gt; i < 2 * 512 * 256; i += ng) { const int j = i & 255, row = (i >> 8) & 511, l = i >> 17, ri = row >> 8, g = (row >> 6) & 3, c = row & 63; float acc = 0;
#pragma unroll 8
        for (int cp = 0; cp < 64; ++cp) { const float2 tv = trig[(c * cp) & 63]; acc += (ri ? tv.y : tv.x) * p.w_fourier[(size_t)l * 65536 + (g * 64 + cp) * 256 + j]; }
        WSP(float, OFF_M12)[i] = acc; }
      __syncthreads(); }
    { const int t = tid_(p.wv), w = p.wv, lane = t & 63; float* sil = (float*)lds  , *red = (float*)lds + 5 * 1024;
      if (bid_() < 2 * 96) { for (int i = t; i < 5 * 1024; i += 512) { const int k = i / 5, r = i % 5; sil[i] = silu_f(r < 4 ? p.c[r * 1024 + k] : p.c_ctx[k]); } }
      __syncthreads();
      for (int it = bid_(); it < 2 * 96; it += gridDim.x) { const int l = it / 96, n = (it % 96) * 64 + lane; const float* W = p.w_mod + (size_t)l * 1024 * 6144 + n;
        float acc[5] = {0, 0, 0, 0, 0};
#pragma unroll 8
        for (int kk = 0; kk < 128; ++kk) { const int k = w * 128 + kk; const float wv = W[(size_t)k * 6144];
#pragma unroll
            for (int r = 0; r < 5; ++r) acc[r] += sil[k * 5 + r] * wv; }
        __syncthreads();
#pragma unroll
        for (int r = 0; r < 5; ++r) red[(w * 5 + r) * 64 + lane] = acc[r];
        __syncthreads();
        if (t < 320) { const int r = t >> 6; float a = p.b_mod[l * 6144 + n];
#pragma unroll
            for (int ww = 0; ww < 8; ++ww) a += red[(ww * 5 + r) * 64 + lane];
            WSP(float, OFF_MOD)[((size_t)l * 5 + r) * 6144 + n] = a; } }
      __syncthreads(); }
    phase_cvt(p, lds, 0, gridDim.x == 256 ? CVT_MOE0 : CVT_TOT, bid_(), gridDim.x);
}
__device__ __forceinline__ void phase_pro_b(const Params& p, lds_t* lds) {
    const int tid = tid_(p.wv), hk = tid >> 8, o4 = (tid & 255) * 4;
    typedef __attribute__((address_space(3))) float lds_f;
    lds_f* mrow = (lds_f*)lds;
    for (int it = bid_(); it < 2 * 64; it += gridDim.x) { const int l = it >> 6, k0 = (it & 63) * 8;
        __syncthreads();
        for (int i = tid; i < 8 * 256; i += 512) mrow[i] = ld_f(WSP(float, OFF_M12) + ((size_t)l * 512 + k0) * 256 + i);
        __syncthreads();
        const float* wo = p.w_out + (size_t)l * 1024 * 1024 + o4; const lds_f* m = mrow + hk * 4 * 256;
        float4 acc[4];
#pragma unroll
        for (int q = 0; q < 4; ++q) acc[q] = make_float4(0.f, 0.f, 0.f, 0.f);
#pragma unroll 8
        for (int j = 0; j < 256; ++j) { const float4 w4 = *(const float4*)(wo + (size_t)j * 1024);
#pragma unroll
            for (int q = 0; q < 4; ++q) { const float mv = m[q * 256 + j]; acc[q].x += mv * w4.x; acc[q].y += mv * w4.y; acc[q].z += mv * w4.z; acc[q].w += mv * w4.w; } }
#pragma unroll
        for (int q = 0; q < 4; ++q) *(float4*)(WSP(float, OFF_WOF) + ((size_t)l * 512 + k0 + hk * 4 + q) * 1024 + o4) = acc[q];
    }
    __syncthreads();
}
__device__ __forceinline__ void phase_cvt_wof(const Params& p, lds_t* lds) {
    const int t = tid_(p.wv), lane = t & 63, gw = bid_() * 8 + p.wv, nw = gridDim.x * 8, kq = lane >> 4, oc = (lane & 15) * 4;
    unsigned char* T = (unsigned char*)lds + p.wv * 9216;
    for (int ti = gw; ti < 2 * 20 * 16; ti += nw) { const int l = ti / 320, kb = (ti % 320) / 16, ob = ti % 16, k0 = kb * 64, o0 = ob * 64;
        const float* src = k0 < 512 ? WSP(float, OFF_WOF) + ((size_t)l * 512 + k0) * 1024 : p.w_out + (size_t)l * 1024 * 1024 + (size_t)(k0 - 256) * 1024;
        float4 v[16];
#pragma unroll
        for (int q = 0; q < 16; ++q) v[q] = *(const float4*)(src + (size_t)(16 * (q >> 2) + 4 * kq + (q & 3)) * 1024 + o0 + oc);
        cvt_wave_store(v, false, WP(W_O) + (size_t)l * 1024 * 1280, 1280, o0, k0, T, lane);
    }
    __syncthreads();
}

#define XB_TMO      128
#define XB_XCNT(j)  (256  + 64 * (j))
#define XB_XSUB(j)  (1280 + 64 * (j))
#define XB_XGEN(j)  (2304 + 64 * (j))
#define XB_TOP      3328
#define XB_TOPGEN   3392
#define XCD_BAR_WORDS 3456
#define XB_SPIN_CAP (1u << 20)
#define LAS __attribute__((address_space(3)))
__device__ __forceinline__ unsigned xb_ld(unsigned* p)              { return __hip_atomic_load(p, __ATOMIC_RELAXED, __HIP_MEMORY_SCOPE_AGENT); }
__device__ __forceinline__ unsigned xb_add(unsigned* p, unsigned v) { return __hip_atomic_fetch_add(p, v, __ATOMIC_RELAXED, __HIP_MEMORY_SCOPE_AGENT); }
__device__ __forceinline__ unsigned xb_xcc_id() { return (unsigned)__builtin_amdgcn_s_getreg((3 << 11) | 20) & 0xFu; }
#define XB_SPIN(cond, bar) do { unsigned _sp = 0; while (cond) { __builtin_amdgcn_s_sleep(1); \
    if ((++_sp & 255u) == 0u) { if (xb_ld(&(bar)[XB_TMO])) break; if (_sp > XB_SPIN_CAP) { atomicAdd(&(bar)[XB_TMO], 1u); break; } } } } while (0)
struct XcdBarrier { unsigned* bar; unsigned x; volatile LAS unsigned* st; int wv; };
__device__ __forceinline__ XcdBarrier xcd_barrier_post(unsigned* bar, volatile LAS unsigned* st, int wv) {
    XcdBarrier b; b.bar = bar; b.x = xb_xcc_id(); b.st = st; b.wv = wv;
    if (tid_(wv) == 0) (void)xb_add(&bar[XB_XCNT(b.x)], 1u);
    return b;
}
__device__ __forceinline__ void xcd_barrier_complete(unsigned* bar, unsigned x, unsigned& nloc, unsigned& nx) {
    const unsigned G = gridDim.x * gridDim.y * gridDim.z;
    unsigned sum, cnt, mine, sp = 0u;
    for (;;) {
        sum = 0u; cnt = 0u; mine = 0u;
#pragma unroll
        for (unsigned j = 0; j < 16; ++j) { const unsigned c = xb_ld(&bar[XB_XCNT(j)]); sum += c; cnt += (c > 0u) ? 1u : 0u; mine = (j == x) ? c : mine; }
        if (sum == G) break;
        __builtin_amdgcn_s_sleep(1);
        if ((++sp & 255u) == 0u) { if (xb_ld(&bar[XB_TMO])) break; if (sp > XB_SPIN_CAP) { atomicAdd(&bar[XB_TMO], 1u); break; } }
    }
    nloc = mine > 0u ? mine : 1u; nx = cnt > 0u ? cnt : 1u;
}
__device__ __forceinline__ void xcd_barrier(const XcdBarrier& b) {
    asm volatile("s_waitcnt vmcnt(0)" ::: "memory");
    __syncthreads();
    if (tid_(b.wv) == 0) {
        unsigned* bar = b.bar; unsigned bx = b.x; asm volatile("" : "+s"(bx));
        __builtin_amdgcn_s_waitcnt(0);
        unsigned nloc = b.st[0], nx = b.st[1];
        if (nloc == 0u) { xcd_barrier_complete(bar, bx, nloc, nx); b.st[0] = nloc; b.st[1] = nx; }
        const unsigned old = xb_add(&bar[XB_XSUB(bx)], 1u);
        const unsigned gen = old / nloc;
        if (old + 1u == (gen + 1u) * nloc) {
            __builtin_amdgcn_fence(__ATOMIC_RELEASE, "agent");
            asm volatile("s_waitcnt vmcnt(0)" ::: "memory");
            const unsigned og = xb_add(&bar[XB_TOP], 1u);
            const unsigned tg = og / nx;
            if (og + 1u == (tg + 1u) * nx) xb_add(&bar[XB_TOPGEN], 1u);
            else XB_SPIN(xb_ld(&bar[XB_TOPGEN]) == tg, bar);
            __builtin_amdgcn_fence(__ATOMIC_ACQUIRE, "agent");
            xb_add(&bar[XB_XGEN(bx)], 1u);
            asm volatile("s_waitcnt vmcnt(0)" ::: "memory");
        } else {
            XB_SPIN(xb_ld(&bar[XB_XGEN(bx)]) == gen, bar);
            __builtin_amdgcn_fence(__ATOMIC_ACQUIRE, "agent");
            asm volatile("s_waitcnt vmcnt(0)" ::: "memory");
        }
    }
    __syncthreads();
}


constexpr int LDS_BAR_OFF = 131072 + 8192;
__global__ void __launch_bounds__(OPT_THREADS, 2) mk_fwd(Params p) {
    extern __shared__ __attribute__((aligned(16))) unsigned char lds_raw[];
    lds_t* lds = (lds_t*)lds_raw;
    p.wv = __builtin_amdgcn_readfirstlane(threadIdx.x >> 6);
    volatile LAS unsigned* bst = (volatile LAS unsigned*)(lds + LDS_BAR_OFF);
    { const int t0_ = tid_(p.wv); if (t0_ < 4) bst[t0_] = 0u; }
    __syncthreads();
    XcdBarrier bar = xcd_barrier_post((unsigned*)p.ws, bst, p.wv);
#define LP() ({ Params q_ = p; unsigned long long w_ = (unsigned long long)(uintptr_t)q_.ws; asm volatile("" : "+s"(w_)); \
    q_.ws = (char*)(uintptr_t)(((unsigned long long)(unsigned)__builtin_amdgcn_readfirstlane((int)(w_ >> 32)) << 32) | (unsigned)__builtin_amdgcn_readfirstlane((int)w_)); q_; })
#define REPN(bit) ([]() { int n_ = 1 + ((MK_REP >> (bit)) & 1); asm volatile("" : "+s"(n_)); return n_; }())
#define REP(bit, stmt) do { const int n__ = REPN(bit); _Pragma("unroll 1") for (int rep_ = 0; rep_ < n__; ++rep_) { stmt; } } while (0)
    REP(0, phase_pro_a(LP(), lds));
    xcd_barrier(bar);
    REP(8, phase_pro_b(LP(), lds)); REP(13, phase_norm1(LP(), lds, 0));
    xcd_barrier(bar);
#pragma unroll 1
    for (int l = 0; l < 2; ++l) {
        REP(1, phase_inproj(LP(), lds, l)); if (l == 0) cvt_in_tail(LP(), lds, 132 * 7, 0, 1800);
        xcd_barrier(bar);
        if (l == 0) phase_cvt_wof(LP(), lds);
        REP(2, phase_up(LP(), lds, l)); REP(10, phase_fft_a(LP(), lds)); REP(11, phase_sgu(LP(), lds, l)); if (l == 0) phase_dft_ctx(LP(), lds);
        xcd_barrier(bar);
        REP(3, phase_mla(LP(), lds, l)); REP(4, phase_win(LP(), lds, l)); REP(12, phase_fft_c(LP(), lds));
        xcd_barrier(bar);
        REP(5, phase_outproj(LP(), lds, l)); if (l == 0) cvt_in_tail(LP(), lds, 132 * 4, 1800, 5500);
        xcd_barrier(bar);
        if (l == 0) { REP(9, phase_postmix(LP(), lds, l)); } else phase_postmix(LP(), lds, l);
        xcd_barrier(bar);
        if (l == 0) {
            REP(6, phase_ffn_gu_dense(LP(), lds)); cvt_in_tail(LP(), lds, 132 * 28, 5500, 8500); xcd_barrier(bar);
            REP(6, phase_ffn_dn_dense(LP(), lds)); cvt_in_tail(LP(), lds, 132 * 4, 8500, CVT_TOT - CVT_MOE0); xcd_barrier(bar);
        } else {
            phase_moe_assign(LP()); xcd_barrier(bar);
            REP(7, phase_moe_gu(p, lds)); xcd_barrier(bar);
            REP(7, phase_moe_dn(p, lds)); xcd_barrier(bar);
        }
        phase_postffn(LP(), lds, l);
        if (l == 0) xcd_barrier(bar);
    }
#ifdef MK_XBAR
#pragma unroll 1
    for (int i = 0; i < MK_XBAR; ++i) xcd_barrier(bar);
#endif
}

template <int PH>
__global__ void __launch_bounds__(OPT_THREADS, 2) opt_k(Params p, int l, int a0) {
    extern __shared__ __attribute__((aligned(16))) unsigned char lds_raw[];
    lds_t* lds = (lds_t*)lds_raw;
    p.wv = __builtin_amdgcn_readfirstlane(threadIdx.x >> 6);
    if constexpr (PH == PH_CVT) phase_cvt(p, lds, 0, CVT_TOT, blockIdx.x, gridDim.x);
    if constexpr (PH == PH_FFN_GU) phase_ffn_gu_dense(p, lds);
    if constexpr (PH == PH_FFN_DN) phase_ffn_dn_dense(p, lds);
    if constexpr (PH == PH_MOE_GU) phase_moe_gu(p, lds);
    if constexpr (PH == PH_MOE_DN) phase_moe_dn(p, lds);
    if constexpr (PH == PH_INPROJ) phase_inproj(p, lds, l);
    if constexpr (PH == PH_UP) phase_up(p, lds, l);
    if constexpr (PH == PH_OUTPROJ) phase_outproj(p, lds, l);
    if constexpr (PH == PH_MLA) phase_mla(p, lds, l);
    if constexpr (PH == PH_WIN) phase_win(p, lds, l);
    if constexpr (PH == PH_FFTA) phase_fft_a(p, lds);
    if constexpr (PH == PH_FFTC) phase_fft_c(p, lds);
    if constexpr (PH == PH_DFTC) phase_dft_ctx(p, lds);
    if constexpr (PH == PH_SGU) phase_sgu(p, lds, l);
    if constexpr (PH == PH_PROA) phase_pro_a(p, lds);
    if constexpr (PH == PH_PROB) { phase_pro_b(p, lds); }
    if constexpr (PH == PH_NORM1) { if (l == 0 && a0 == 1) phase_cvt_wof(p, lds); }
    if constexpr (PH == PH_NORM1) phase_norm1(p, lds, l);
    if constexpr (PH == PH_POSTMIX) phase_postmix(p, lds, l);
    if constexpr (PH == PH_ASSIGN) phase_moe_assign(p);
    if constexpr (PH == PH_POSTFFN) phase_postffn(p, lds, l);
}
template <int PH> static void launch_opt(const Params& p, int l, int a0, hipStream_t stream) {
    static bool init = false;
    if (!init) { (void)hipFuncSetAttribute((const void*)opt_k<PH>, hipFuncAttributeMaxDynamicSharedMemorySize, OPT_LDS); init = true; }
    hipLaunchKernelGGL(opt_k<PH>, dim3(256), dim3(OPT_THREADS), OPT_LDS, stream, p, l, a0);
}

constexpr bool USE_MK = true;
extern "C" void kernel_launch(void* const* d_in, const int* in_sizes, int n_in, void* d_out, int out_size, void* d_ws, size_t ws_size, hipStream_t stream) {
    if (n_in != 27 || ws_size < WS_NEED) { fprintf(stderr, "kernel_launch: bad args n_in %d ws %zu need %zu\n", n_in, ws_size, WS_NEED); return; }
    Params p{};
    const float** pp = (const float**)&p;
    for (int i = 0; i < 27; ++i) pp[i] = (const float*)d_in[i];
    p.out = (float*)d_out; p.ws = (char*)d_ws;
    if (USE_MK) {
        static int grid = 0;
        if (!grid) {
            int dev = 0, cus = 0, per_cu = 0;
            hipGetDevice(&dev); hipDeviceGetAttribute(&cus, hipDeviceAttributeMultiprocessorCount, dev);
            if (hipFuncSetAttribute((const void*)mk_fwd, hipFuncAttributeMaxDynamicSharedMemorySize, OPT_LDS) != hipSuccess) { fprintf(stderr, "kernel_launch: hipFuncSetAttribute failed\n"); return; }
            if (hipOccupancyMaxActiveBlocksPerMultiprocessor(&per_cu, (const void*)mk_fwd, OPT_THREADS, OPT_LDS) != hipSuccess || per_cu < 1) fprintf(stderr, "kernel_launch: note: occupancy query says %d blocks per CU; launching one per CU anyway\n", per_cu);
            grid = cus > 0 ? cus : 256;
        }
        hipMemsetAsync(d_ws, 0, 65536, stream);
        hipLaunchKernelGGL(mk_fwd, dim3(grid), dim3(OPT_THREADS), OPT_LDS, stream, p);
        return;
    }
    hipMemsetAsync(d_ws, 0, 65536, stream);
    launch_opt<PH_PROA>(p, 0, 0, stream);
    launch_opt<PH_PROB>(p, 0, 0, stream);
    launch_opt<PH_NORM1>(p, 0, 1, stream);
    for (int l = 0; l < 2; ++l) {
        launch_opt<PH_INPROJ>(p, l, 0, stream);
        launch_opt<PH_UP>(p, l, 0, stream);
        launch_opt<PH_SGU>(p, l, 0, stream);
        launch_opt<PH_FFTA>(p, l, 0, stream);
        launch_opt<PH_FFTC>(p, l, 0, stream);
        if (l == 0) launch_opt<PH_DFTC>(p, l, 0, stream);
        launch_opt<PH_WIN>(p, l, 0, stream);
        launch_opt<PH_MLA>(p, l, 0, stream);
        launch_opt<PH_OUTPROJ>(p, l, 0, stream);
        launch_opt<PH_POSTMIX>(p, l, 0, stream);
        if (l == 0) {
            launch_opt<PH_FFN_GU>(p, l, 0, stream);
            launch_opt<PH_FFN_DN>(p, l, 0, stream);
        } else {
            launch_opt<PH_ASSIGN>(p, l, 0, stream);
            launch_opt<PH_MOE_GU>(p, l, 0, stream);
            launch_opt<PH_MOE_DN>(p, l, 0, stream);
        }
        launch_opt<PH_POSTFFN>(p, l, 0, stream);
    }
}
```

```cpp
#include <hip/hip_runtime.h>
#include <stdint.h>
#include <stdio.h>

typedef unsigned short bf16_t;
#ifndef MK_REP
#define MK_REP 0
#endif
constexpr int TL = 32768, TC = 1024, RR = TL + TC, DM = 1024, NKEY = 8448, DFF = 3584, NE = 8, DIN = 1696;
constexpr int NSORT = 264 * 256;
constexpr float EPS = 1e-6f;

__device__ __forceinline__ float bf2f(bf16_t v) { return __uint_as_float(((unsigned)v) << 16); }
__device__ __forceinline__ bf16_t f2bf(float f) { unsigned u = __float_as_uint(f); u += 0x7fffu + ((u >> 16) & 1u); return (bf16_t)(u >> 16); }
__device__ __forceinline__ int row_cond(int r) { return r < TL ? (r >> 13) : 4; }
__device__ __forceinline__ int row_batch(int r) { return r < TL ? (r >> 13) : ((r - TL) >> 8); }
__device__ __forceinline__ int row_key(int r) { return r < TL ? (r & 8191) : 8192 + ((r - TL) & 255); }
__device__ __forceinline__ float silu_f(float x) { return x / (1.f + __expf(-x)); }
__device__ __forceinline__ float gelu_f(float x) { return 0.5f * x * (1.f + erff(x * 0.70710678118654752f)); }

constexpr size_t al256(size_t x) { return (x + 255) / 256 * 256; }
constexpr size_t OFF_CTL = 0;
constexpr size_t OFF_MOD = OFF_CTL + 65536;
constexpr size_t OFF_ROPEW = OFF_MOD + al256(2 * 5 * 6144 * 4);
constexpr size_t OFF_ROPEM = OFF_ROPEW + 128 * 16 * 8;
constexpr size_t OFF_TW = OFF_ROPEM + 128 * 8 * 8;
constexpr size_t OFF_CS8K = OFF_TW + 64 * 128 * 8;
constexpr size_t OFF_FA = OFF_CS8K + 8192 * 8;
constexpr size_t OFF_GM = OFF_FA + 256 * 128 * 2;
constexpr size_t OFF_FC = OFF_GM + 128 * 128 * 2;
constexpr size_t OFF_M12 = OFF_FC + 512 * 256 * 2;
constexpr size_t OFF_HXC = OFF_M12 + 2 * 512 * 256 * 4;
constexpr size_t OFF_WOF = OFF_HXC + 1024 * 1024 * 4;
constexpr size_t OFF_TOKE = OFF_WOF + (size_t)2 * 512 * 1024 * 4;
constexpr size_t OFF_TOKW = OFF_TOKE + TL * 2 * 4;
constexpr size_t OFF_TOKS = OFF_TOKW + TL * 2 * 4;
constexpr size_t OFF_ROWIDX = OFF_TOKS + TL * 2 * 4;
constexpr size_t OFF_TILEE = OFF_ROWIDX + NSORT * 4;
constexpr size_t OFF_SSQQ = OFF_TILEE + al256(272 * 4);
constexpr size_t OFF_SSQKV = OFF_SSQQ + (size_t)RR * 16;
constexpr size_t OFF_LNS = OFF_SSQKV + (size_t)RR * 16;
constexpr size_t OFF_XN = OFF_LNS + (size_t)RR * 32;
constexpr size_t OFF_W = OFF_XN + (size_t)RR * 1024 * 2;
constexpr size_t W_BYTES = (size_t)2 * 1792 * 1024 * 2 + (size_t)2 * 1024 * 384 * 2 + (size_t)2 * 1024 * 1280 * 2 + (size_t)7168 * 1024 * 2 + (size_t)1024 * 3584 * 2 + (size_t)8 * 7168 * 1024 + (size_t)8 * 1024 * 3584;
constexpr size_t OFF_S = OFF_W + W_BYTES;
constexpr size_t S_CAT = 0;
constexpr size_t S_ABUF = S_CAT + (size_t)RR * 1280 * 2;
constexpr size_t S_QW = S_ABUF + (size_t)RR * 256 * 2;
constexpr size_t S_KW = S_QW + (size_t)RR * 256 * 2;
constexpr size_t S_VW = S_KW + (size_t)4 * NKEY * 128 * 2;
constexpr size_t S_C2 = S_VW + (size_t)4 * NKEY * 128 * 2;
constexpr size_t S_KM = S_C2 + (size_t)RR * 384 * 2;
constexpr size_t S_VM = S_KM + (size_t)16 * NKEY * 96 * 2;
constexpr size_t S_U = S_VM + (size_t)16 * NKEY * 64 * 2;
constexpr size_t S_VG = S_U + (size_t)RR * 256 * 2;
constexpr size_t S_QM = S_VG + (size_t)RR * 256 * 2;
constexpr size_t S_UP = S_QM + (size_t)RR * 384 * 2;
constexpr size_t S_END_MIX = S_UP + (size_t)4 * 128 * 2 * 64 * 256 * 2;
constexpr size_t S_MX = S_ABUF;
constexpr size_t S_H = 0;
constexpr size_t S_YS = S_H + (size_t)RR * 3584 * 2;
constexpr size_t S_END = S_YS + (size_t)NSORT * 1024 * 2;
static_assert(S_END_MIX <= S_END, "S region");
static_assert(S_MX + (size_t)RR * 1024 * 2 <= S_END_MIX, "MX overlay");
static_assert((size_t)NSORT * 3584 <= (size_t)RR * 3584 * 2, "fp8 H fits");
constexpr size_t WS_NEED = OFF_S + S_END;

constexpr int CW_CNT = 4096;
constexpr int CW_CUR = 4112;
constexpr int CW_OFF = 4128;
constexpr int CW_NT = 4144;

struct Params {
    const float *x, *c, *ctx, *c_ctx, *w_mod, *b_mod, *g_pre_mix, *g_post_mix, *g_pre_ffn, *g_post_ffn, *w_in, *w_out, *w_fourier, *win_sink,
        *mla_g_q, *mla_g_kv, *mla_w_uq, *mla_w_ukv, *sgu_w, *sgu_b, *ffn_w_gate, *ffn_w_up, *ffn_w_down, *moe_w_router, *moe_w_gate, *moe_w_up, *moe_w_down;
    float* out; char* ws;
    int wv, pad_;
};
#define WSP(T, off) ((T*)(p.ws + (off)))
#define SP(T, off) ((T*)(p.ws + OFF_S + (off)))

__device__ __forceinline__ float sum4(const float* q) { return (q[0] + q[1]) + (q[2] + q[3]); }
__device__ __forceinline__ int ld_i(const int* q) { return __hip_atomic_load(q, __ATOMIC_RELAXED, __HIP_MEMORY_SCOPE_AGENT); }
__device__ __forceinline__ float ld_f(const float* q) { return __hip_atomic_load(q, __ATOMIC_RELAXED, __HIP_MEMORY_SCOPE_AGENT); }
__device__ __forceinline__ int bid_() { int b = blockIdx.x; asm volatile("" : "+s"(b)); return b; }
__device__ __forceinline__ int lane_() { int l; asm volatile("v_mbcnt_lo_u32_b32 %0, -1, 0\n\tv_mbcnt_hi_u32_b32 %0, -1, %0" : "=v"(l)); return l; }
__device__ __forceinline__ int tid_(int wv) { return (wv << 6) | lane_(); }
namespace pg8 {
#define PG8_LAS __attribute__((address_space(3)))
typedef short bf16x8 __attribute__((ext_vector_type(8)));
typedef float f32x4 __attribute__((ext_vector_type(4)));
typedef unsigned u32x4 __attribute__((ext_vector_type(4)));
typedef unsigned u32x2 __attribute__((ext_vector_type(2)));
typedef int v8i_t __attribute__((ext_vector_type(8)));
typedef int v4i_t __attribute__((ext_vector_type(4)));
constexpr int BM = 256, BK = 64, HALF = 128, HTB = HALF * BK * 2, STAGE_BYTES = 8 * HTB, NXCD = 8, WGM = 4;
__host__ __device__ __forceinline__ int lds_byte(int r, int c) { const int st = (r >> 4) * 2 + (c >> 5), rr = r & 15, cc = c & 31, ob = rr * 64 + cc * 2; return st * 1024 + (ob ^ (((ob >> 9) & 1) << 5)); }
__host__ __device__ __forceinline__ void stage_rc(int b, int& R, int& C) { const int st = b / 1024, sb = b % 1024, swz = sb ^ (((sb >> 9) & 1) << 5); R = (st >> 1) * 16 + swz / 64; C = (st & 1) * 32 + (swz % 64) / 2; }
__host__ __device__ __forceinline__ int perm32(int rho) { const int n = rho >> 4, i = rho & 15; return 8 * (i >> 2) + 4 * n + (i & 3); }
struct Unit { int pm, pn; };
struct Gemm { int lda, ldb, K, wv; };
__device__ __forceinline__ unsigned cvt_pk_bf16(float lo, float hi) { unsigned r; asm volatile("v_cvt_pk_bf16_f32 %0, %1, %2" : "=v"(r) : "v"(lo), "v"(hi)); return r; }

struct OrderBase {
    int nM, nN, nwg, G, c;
    __device__ void init(int nM_, int nN_, int G_, int c_) { nM = nM_; nN = nN_; nwg = nM * nN; G = G_; c = c_; }
    __device__ bool next(int i, Unit& u) const {
        const long L = (long)i * G + c; if (L >= nwg) return false;
        int wgid = (int)L; { const int q = nwg / NXCD, r = nwg % NXCD, xcd = wgid % NXCD, off = wgid / NXCD; wgid = (xcd < r ? xcd * (q + 1) : r * (q + 1) + (xcd - r) * q) + off; }
        const int nig = WGM * nN, gid = wgid / nig, fm = gid * WGM, gsz = (nM - fm) < WGM ? (nM - fm) : WGM;
        u.pm = fm + ((wgid % nig) % gsz); u.pn = (wgid % nig) / gsz; return true;
    }
};

__device__ __forceinline__ void glds16_s(const char* sbase, unsigned voff, unsigned lds_addr) {
    unsigned keep;
    asm volatile("s_mov_b32 %0, m0\n\ts_mov_b32 m0, %3\n\ts_nop 0\n\tglobal_load_lds_dwordx4 %1, %2\n\ts_mov_b32 m0, %0" : "=&s"(keep) : "v"(voff), "s"(sbase), "s"(lds_addr) : "memory");
}
template <class Epi, class Sched, bool GATHER, bool FP8 = false>
__device__ __forceinline__ void gemm_phase(PG8_LAS unsigned char* lds, const Gemm g, const Sched& S, const Epi& E) {
    int wid_ = g.wv; asm volatile("" : "+s"(wid_));
    const int tid = tid_(g.wv), wid = wid_, lane = tid & 63, wr = wid >> 2, wc = wid & 3, fr = lane & 15, fq = lane >> 4;
    const int K = g.K, nt = K / BK;
    int mxs = 0x7f7f7f7f; asm volatile("" : "+v"(mxs));
    unsigned voffA[2], voffB[2]; int RA[2];
#pragma unroll
    for (int i = 0; i < 2; ++i) { int R, C; stage_rc(tid * 16 + i * 8192, R, C); const int Rb = Epi::PERM ? ((R & ~31) + perm32(R & 31)) : R;
        RA[i] = R; voffA[i] = GATHER ? (unsigned)(C * 2) : (unsigned)(R * g.lda + C) * 2u; voffB[i] = (unsigned)(Rb * g.ldb + C) * 2u; }
    const size_t kstep = (size_t)(BK * 2);
    const size_t hstepA = GATHER ? 0 : (size_t)HALF * g.lda * 2, hstepB = (size_t)HALF * g.ldb * 2, rstepA = (size_t)64 * g.lda * 2, rstepB = (size_t)64 * g.ldb * 2;
    const unsigned ldsw = (unsigned)wid * 1024u, ldsbase = (unsigned)(uintptr_t)lds;
    const int aoff = lds_byte(wr * 64 + fr, fq * 8), boff = lds_byte(wc * 32 + fr, fq * 8);
    unsigned gC[2] = {0, 0}, gN[2] = {0, 0};
#define PG8_SA(b, h) (((b) * 2 + (h)) * HTB)
#define PG8_SB(b, h) ((4 + (b) * 2 + (h)) * HTB)
#define PG8_STAGE_B(bufoff, gbase) do { _Pragma("unroll") for (int _i = 0; _i < 2; ++_i) { \
        if constexpr (FP8) glds16_s((const char*)(gbase) + _i * rstepB, voffB[0], ldsbase + (unsigned)(bufoff) + ldsw + _i * 8192u); \
        else __builtin_amdgcn_global_load_lds((const unsigned*)((const char*)(gbase) + _i * rstepB + voffB[0]), (PG8_LAS unsigned*)(lds + (bufoff) + ldsw + _i * 8192), 16, 0, 0); } } while (0)
#define PG8_STAGE_A(bufoff, gbase, h, usenext) do { _Pragma("unroll") for (int _i = 0; _i < 2; ++_i) { \
        const unsigned _o = GATHER ? voffA[0] + ((((usenext) ? gN[h] : gC[h]) >> (16 * _i)) & 0xffffu) * (unsigned)(g.lda * 2) : voffA[0]; \
        if constexpr (FP8) glds16_s((const char*)(gbase) + (h) * hstepA + (GATHER ? 0 : _i) * rstepA, _o, ldsbase + (unsigned)(bufoff) + ldsw + _i * 8192u); \
        else __builtin_amdgcn_global_load_lds((const unsigned*)((const char*)(gbase) + (h) * hstepA + (GATHER ? 0 : _i) * rstepA + _o), (PG8_LAS unsigned*)(lds + (bufoff) + ldsw + _i * 8192), 16, 0, 0); } } while (0)
#define PG8_LDA(dst, b, h) do { _Pragma("unroll") for (int m = 0; m < 4; ++m) { if constexpr (FP8) { const v4i_t lo_ = *(const PG8_LAS v4i_t*)(lds + PG8_SA(b, h) + aoff + m * 2048), hi_ = *(const PG8_LAS v4i_t*)(lds + PG8_SA(b, h) + aoff + m * 2048 + 1024); \
        dst##8[m] = __builtin_shufflevector(lo_, hi_, 0, 1, 2, 3, 4, 5, 6, 7); } else { _Pragma("unroll") for (int k = 0; k < 2; ++k) dst[m][k] = *(const PG8_LAS bf16x8*)(lds + PG8_SA(b, h) + aoff + m * 2048 + k * 1024); } } } while (0)
#define PG8_LDB(dst, b, h) do { _Pragma("unroll") for (int n = 0; n < 2; ++n) { if constexpr (FP8) { const v4i_t lo_ = *(const PG8_LAS v4i_t*)(lds + PG8_SB(b, h) + boff + n * 2048), hi_ = *(const PG8_LAS v4i_t*)(lds + PG8_SB(b, h) + boff + n * 2048 + 1024); \
        dst##8[n] = __builtin_shufflevector(lo_, hi_, 0, 1, 2, 3, 4, 5, 6, 7); } else { _Pragma("unroll") for (int k = 0; k < 2; ++k) dst[n][k] = *(const PG8_LAS bf16x8*)(lds + PG8_SB(b, h) + boff + n * 2048 + k * 1024); } } } while (0)
#define PG8_MMA(ai, bj, At, Bt) do { __builtin_amdgcn_s_setprio(1); _Pragma("unroll") for (int m = 0; m < 4; ++m) _Pragma("unroll") for (int n = 0; n < 2; ++n) { \
        if constexpr (FP8) acc[ai][bj][m][n] = __builtin_amdgcn_mfma_scale_f32_16x16x128_f8f6f4(Bt##8[n], At##8[m], acc[ai][bj][m][n], 0, 0, 0, mxs, 0, mxs); \
        else { _Pragma("unroll") for (int k = 0; k < 2; ++k) acc[ai][bj][m][n] = __builtin_amdgcn_mfma_f32_16x16x32_bf16(Bt[n][k], At[m][k], acc[ai][bj][m][n], 0, 0, 0); } } \
        __builtin_amdgcn_s_setprio(0); } while (0)
#define PG8_WAIT_V(n) asm volatile("s_waitcnt vmcnt(" #n ")" ::: "memory")
#define PG8_WAIT_L(n) asm volatile("s_waitcnt lgkmcnt(" #n ")" ::: "memory")
#define PG8_BAR __builtin_amdgcn_s_barrier()
#define PG8_SCHED __builtin_amdgcn_sched_barrier(0)
    Unit cur, nxt; int ui = 0;
    if (!S.next(0, cur)) return;
    f32x4 acc[2][2][4][2];
#pragma unroll
    for (int a = 0; a < 2; ++a)
#pragma unroll
        for (int b = 0; b < 2; ++b)
#pragma unroll
            for (int m = 0; m < 4; ++m)
#pragma unroll
                for (int n = 0; n < 2; ++n) acc[a][b][m][n] = (f32x4){0.f, 0.f, 0.f, 0.f};
    bf16x8 At[4][2], B0[2][2], B1[2][2]; v8i_t At8[4], B08[2], B18[2];
    const char* cA = S.a_base(cur); const char* cB = S.b_base(cur);
    if constexpr (GATHER) {
#pragma unroll
        for (int h = 0; h < 2; ++h) gC[h] = (unsigned)S.row(cur, h * HALF + RA[0]) | ((unsigned)S.row(cur, h * HALF + RA[1]) << 16);
    }
    PG8_STAGE_B(PG8_SB(0, 0), cB); PG8_STAGE_B(PG8_SB(0, 1), cB + hstepB); PG8_STAGE_A(PG8_SA(0, 0), cA, 0, false); PG8_STAGE_A(PG8_SA(0, 1), cA, 1, false);
    if (wr == 1) PG8_BAR;
    PG8_WAIT_V(2); PG8_BAR;
    PG8_STAGE_B(PG8_SB(1, 0), cB + kstep); PG8_STAGE_A(PG8_SA(1, 0), cA + kstep, 0, false); PG8_STAGE_B(PG8_SB(1, 1), cB + hstepB + kstep);
    PG8_WAIT_V(6); PG8_BAR;
    for (;;) {
        const bool has_next = S.next(ui + 1, nxt);
        if (!has_next) nxt = cur;
        const char* nA = S.a_base(nxt); const char* nB = S.b_base(nxt);
        if constexpr (GATHER) { int R0_, R1_, C_; const int t3_ = tid_(g.wv); stage_rc(t3_ * 16, R0_, C_); stage_rc(t3_ * 16 + 8192, R1_, C_);
#pragma unroll
            for (int h = 0; h < 2; ++h) gN[h] = (unsigned)S.row(nxt, h * HALF + R0_) | ((unsigned)S.row(nxt, h * HALF + R1_) << 16);
        }
        asm volatile(".p2align 8");
#pragma unroll 1
        for (int t = 0; t < nt; t += 2) {
            const bool last = (t == nt - 2);
            const char* a1 = cA + (size_t)(t + 1) * kstep;
            const char* a2 = last ? nA : cA + (size_t)(t + 2) * kstep; const char* b2 = last ? nB : cB + (size_t)(t + 2) * kstep;
            const char* a3 = a2 + kstep; const char* b3 = b2 + kstep;
            PG8_LDB(B0, 0, 0); PG8_LDB(B1, 0, 1); PG8_SCHED; PG8_LDA(At, 0, 0); PG8_STAGE_A(PG8_SA(1, 1), a1, 1, false);
            PG8_WAIT_V(8); PG8_WAIT_L(0); PG8_BAR; PG8_MMA(0, 0, At, B0); PG8_MMA(0, 1, At, B1); PG8_BAR; PG8_SCHED;
            PG8_LDA(At, 0, 1); PG8_STAGE_B(PG8_SB(0, 0), b2); PG8_STAGE_B(PG8_SB(0, 1), b2 + hstepB); PG8_STAGE_A(PG8_SA(0, 0), a2, 0, last);
            PG8_WAIT_V(8); PG8_WAIT_L(0); PG8_BAR; PG8_MMA(1, 0, At, B0); PG8_MMA(1, 1, At, B1); PG8_BAR; PG8_SCHED;
            PG8_LDB(B0, 1, 0); PG8_LDB(B1, 1, 1); PG8_SCHED; PG8_LDA(At, 1, 0); PG8_STAGE_A(PG8_SA(0, 1), a2, 1, last);
            PG8_WAIT_V(8); PG8_WAIT_L(0); PG8_BAR; PG8_MMA(0, 0, At, B0); PG8_MMA(0, 1, At, B1); PG8_BAR; PG8_SCHED;
            PG8_LDA(At, 1, 1); PG8_STAGE_B(PG8_SB(1, 0), b3); PG8_STAGE_B(PG8_SB(1, 1), b3 + hstepB); PG8_STAGE_A(PG8_SA(1, 0), a3, 0, last);
            PG8_WAIT_V(8); PG8_WAIT_L(0); PG8_BAR; PG8_MMA(1, 0, At, B0); PG8_MMA(1, 1, At, B1); PG8_BAR; PG8_SCHED;
        }
        if (wr == 0) PG8_BAR;
        { const int t2_ = tid_(g.wv), fr_ = t2_ & 15, fq_ = (t2_ >> 4) & 3;
          E(acc, cur, wr, wc, fr_, fq_); }
        if (!has_next) break;
#pragma unroll
        for (int a = 0; a < 2; ++a)
#pragma unroll
            for (int b = 0; b < 2; ++b)
#pragma unroll
                for (int m = 0; m < 4; ++m)
#pragma unroll
                    for (int n = 0; n < 2; ++n) acc[a][b][m][n] = (f32x4){0.f, 0.f, 0.f, 0.f};
        cur = nxt; cA = nA; cB = nB; ++ui;
        if constexpr (GATHER) { gC[0] = gN[0]; gC[1] = gN[1]; }
        if (wr == 1) PG8_BAR;
    }
    PG8_WAIT_V(0);
    PG8_BAR;
#undef PG8_SA
#undef PG8_SB
#undef PG8_STAGE_A
#undef PG8_STAGE_B
#undef PG8_LDA
#undef PG8_LDB
#undef PG8_MMA
#undef PG8_WAIT_V
#undef PG8_WAIT_L
#undef PG8_BAR
#undef PG8_SCHED
}
}

constexpr int OPT_THREADS = 512, OPT_LDS = 147456;
__device__ __forceinline__ bf16_t* ys_row(const Params& p, int srow) { return SP(bf16_t, S_YS) + (size_t)srow * 1024; }
__device__ __forceinline__ unsigned fp8x4(float a, float b, float c, float d) { int r = __builtin_amdgcn_cvt_pk_fp8_f32(a, b, 0, false); return (unsigned)__builtin_amdgcn_cvt_pk_fp8_f32(c, d, r, true); }
__device__ __forceinline__ float clamp448(float v) { return __builtin_amdgcn_fmed3f(v, -448.f, 448.f); }
constexpr size_t W_IN = 0;
constexpr size_t W_UP = W_IN + (size_t)2 * 1792 * 1024 * 2;
constexpr size_t W_O = W_UP + (size_t)2 * 1024 * 384 * 2;
constexpr size_t W_GU = W_O + (size_t)2 * 1024 * 1280 * 2;
constexpr size_t W_D = W_GU + (size_t)7168 * 1024 * 2;
constexpr size_t W_MGU = W_D + (size_t)1024 * 3584 * 2;
constexpr size_t W_MD = W_MGU + (size_t)8 * 7168 * 1024;
constexpr size_t W_END = W_MD + (size_t)8 * 1024 * 3584;
static_assert(W_END == W_BYTES, "weights region");
#ifndef MK_TEST
#define MK_TEST 0
#endif
#ifndef DENSE_FP8
#define DENSE_FP8 2
#endif
constexpr float WSCALE = 64.f, HSCALE = 8.f;
#define WP(off) ((bf16_t*)(p.ws + OFF_W + (off)))

struct CvtJob { bf16_t* dst; int ldd; const float* s0; const float* s1; int lds_, kind; const float* scale; const float* scale2; bool f8; };
__device__ __forceinline__ const float* cvt_src(const CvtJob& j, int k, int n, float& sc) {
    sc = 1.f;
    if (j.kind == 0) return j.s0 + (size_t)k * j.lds_ + n;
    if (j.kind == 1) { if (n < 1184) return j.s0 + (size_t)k * j.lds_ + n; if (n >= 1280) return j.s0 + (size_t)k * j.lds_ + n - 96; return nullptr; }
    if (j.kind == 2) { const int tl = n >> 8, jj = n & 255; return (jj < 128 ? j.s0 : j.s1) + (size_t)k * j.lds_ + tl * 128 + (jj & 127); }
    if (n < 384 && k < 256) { sc = j.scale[k]; return j.s0 + (size_t)k * 384 + n; }
    if (n >= 512 && k >= 256) { sc = j.scale2[k - 256]; return j.s1 + (size_t)(k - 256) * 512 + (n - 512); }
    return nullptr;
}
__device__ __forceinline__ void cvt_wave_store(const float4 (&v)[16], bool f8, void* dst, int ldd, int n0, int k0, unsigned char* T, int lane) {
    const int kq = lane >> 4, nc = (lane & 15) * 4;
    if (f8) {
#pragma unroll
        for (int i = 0; i < 4; ++i) { const int kb = 16 * i + 4 * kq;
            *(unsigned*)(T + (nc + 0) * 68 + kb) = fp8x4(v[4 * i].x, v[4 * i + 1].x, v[4 * i + 2].x, v[4 * i + 3].x);
            *(unsigned*)(T + (nc + 1) * 68 + kb) = fp8x4(v[4 * i].y, v[4 * i + 1].y, v[4 * i + 2].y, v[4 * i + 3].y);
            *(unsigned*)(T + (nc + 2) * 68 + kb) = fp8x4(v[4 * i].z, v[4 * i + 1].z, v[4 * i + 2].z, v[4 * i + 3].z);
            *(unsigned*)(T + (nc + 3) * 68 + kb) = fp8x4(v[4 * i].w, v[4 * i + 1].w, v[4 * i + 2].w, v[4 * i + 3].w); }
        asm volatile("s_waitcnt lgkmcnt(0)" ::: "memory");
#pragma unroll
        for (int r = 0; r < 8; ++r) { const int n = r * 8 + (lane >> 3), kc = (lane & 7) * 8; uint2 w; w.x = *(const unsigned*)(T + n * 68 + kc); w.y = *(const unsigned*)(T + n * 68 + kc + 4);
            *(uint2*)((unsigned char*)dst + (size_t)(n0 + n) * ldd + k0 + kc) = w; }
    } else {
#pragma unroll
        for (int i = 0; i < 4; ++i) { const int kb = (16 * i + 4 * kq) * 2;
            *(unsigned*)(T + (nc + 0) * 132 + kb) = pg8::cvt_pk_bf16(v[4 * i].x, v[4 * i + 1].x); *(unsigned*)(T + (nc + 0) * 132 + kb + 4) = pg8::cvt_pk_bf16(v[4 * i + 2].x, v[4 * i + 3].x);
            *(unsigned*)(T + (nc + 1) * 132 + kb) = pg8::cvt_pk_bf16(v[4 * i].y, v[4 * i + 1].y); *(unsigned*)(T + (nc + 1) * 132 + kb + 4) = pg8::cvt_pk_bf16(v[4 * i + 2].y, v[4 * i + 3].y);
            *(unsigned*)(T + (nc + 2) * 132 + kb) = pg8::cvt_pk_bf16(v[4 * i].z, v[4 * i + 1].z); *(unsigned*)(T + (nc + 2) * 132 + kb + 4) = pg8::cvt_pk_bf16(v[4 * i + 2].z, v[4 * i + 3].z);
            *(unsigned*)(T + (nc + 3) * 132 + kb) = pg8::cvt_pk_bf16(v[4 * i].w, v[4 * i + 1].w); *(unsigned*)(T + (nc + 3) * 132 + kb + 4) = pg8::cvt_pk_bf16(v[4 * i + 2].w, v[4 * i + 3].w); }
        asm volatile("s_waitcnt lgkmcnt(0)" ::: "memory");
#pragma unroll
        for (int r = 0; r < 8; ++r) { const int n = r * 8 + (lane >> 3), kc = (lane & 7) * 16; uint4 w;
            w.x = *(const unsigned*)(T + n * 132 + kc); w.y = *(const unsigned*)(T + n * 132 + kc + 4); w.z = *(const unsigned*)(T + n * 132 + kc + 8); w.w = *(const unsigned*)(T + n * 132 + kc + 12);
            *(uint4*)((bf16_t*)dst + (size_t)(n0 + n) * ldd + k0 + (lane & 7) * 8) = w; }
    }
    asm volatile("s_waitcnt lgkmcnt(0)" ::: "memory");
}
__device__ __forceinline__ void cvt_wave_tile(const CvtJob& j, int n0, int k0, unsigned char* T  , int lane) {
    const int kq = lane >> 4, nc = (lane & 15) * 4;
    float4 v[16]; float sc[16];
#pragma unroll
    for (int q = 0; q < 16; ++q) { const float* src = cvt_src(j, k0 + 16 * (q >> 2) + 4 * kq + (q & 3), n0 + nc, sc[q]); v[q] = src ? *(const float4*)src : make_float4(0.f, 0.f, 0.f, 0.f); }
#pragma unroll
    for (int q = 0; q < 16; ++q) { const float s_ = j.f8 ? WSCALE : sc[q]; v[q].x *= s_; v[q].y *= s_; v[q].z *= s_; v[q].w *= s_; }
    cvt_wave_store(v, j.f8, j.dst, j.ldd, n0, k0, T, lane);
}
typedef __attribute__((address_space(3))) unsigned char lds_t;
__device__ __forceinline__ float silu_fast(float x) { return x * __builtin_amdgcn_rcpf(1.f + __expf(-x)); }

__device__ __forceinline__ void cvt_decode(const Params& p, int ti, CvtJob& j, int& n0, int& k0) {
    constexpr int T_IN = 448, T_UP = 96, T_GU = 1792, T_D = 896;
    int idx = ti, kt; j = CvtJob{};
    if (idx < 2 * T_IN) { const int l = idx / T_IN; idx %= T_IN; j.dst = WP(W_IN) + (size_t)l * 1792 * 1024; j.ldd = 1024; j.s0 = p.w_in + (size_t)l * 1024 * DIN; j.lds_ = DIN; j.kind = 1; kt = 16; }
    else if ((idx -= 2 * T_IN) < 2 * T_UP) { const int l = idx / T_UP; idx %= T_UP; j.dst = WP(W_UP) + (size_t)l * 1024 * 384; j.ldd = 384; j.s0 = p.mla_w_uq + (size_t)l * 256 * 384; j.s1 = p.mla_w_ukv + (size_t)l * 128 * 512;
        j.scale = p.mla_g_q + l * 256; j.scale2 = p.mla_g_kv + l * 128; j.kind = 3; kt = 6; }
    else if ((idx -= 2 * T_UP) < T_GU) { j.dst = WP(W_GU); j.ldd = 1024; j.s0 = p.ffn_w_gate; j.s1 = p.ffn_w_up; j.lds_ = DFF; j.kind = 2; j.f8 = (DENSE_FP8 == 1); kt = 16; }
    else if ((idx -= T_GU) < T_D) { j.dst = WP(W_D); j.ldd = DFF; j.s0 = p.ffn_w_down; j.lds_ = 1024; j.kind = 0; j.f8 = (DENSE_FP8 != 0); kt = 56; }
    else if ((idx -= T_D) < 8 * T_GU) { const int e = idx / T_GU; idx %= T_GU; j.dst = (bf16_t*)(p.ws + OFF_W + W_MGU + (size_t)e * 7168 * 1024); j.ldd = 1024; j.s0 = p.moe_w_gate + (size_t)e * 1024 * DFF; j.s1 = p.moe_w_up + (size_t)e * 1024 * DFF; j.lds_ = DFF; j.kind = 2; j.f8 = true; kt = 16; }
    else { idx -= 8 * T_GU; const int e = idx / T_D; idx %= T_D; j.dst = (bf16_t*)(p.ws + OFF_W + W_MD + (size_t)e * 1024 * DFF); j.ldd = DFF; j.s0 = p.moe_w_down + (size_t)e * DFF * 1024; j.lds_ = 1024; j.kind = 0; j.f8 = true; kt = 56; }
    const int ntn = j.kind == 1 ? 28 : (j.kind == 3 ? 16 : (j.kind == 2 ? 112 : 16)); (void)kt;
    n0 = (idx % ntn) * 64; k0 = (idx / ntn) * 64;
}
constexpr int CVT_TOT = 2 * 448 + 2 * 96 + 1792 + 896 + 8 * (1792 + 896), CVT_MOE0 = 2 * 448 + 2 * 96 + 1792 + 896;
__device__ __forceinline__ void phase_cvt(const Params& p, lds_t* lds, int begin, int end, int wb, int nwb) {
    const int t = tid_(p.wv), lane = t & 63;
    unsigned char* T = (unsigned char*)lds + p.wv * 9216;
    for (int ti = begin + wb * 8 + p.wv; ti < end; ti += nwb * 8) { CvtJob j; int n0, k0; cvt_decode(p, ti, j, n0, k0); cvt_wave_tile(j, n0, k0, T, lane); }
    __syncthreads();
}
__device__ __forceinline__ void cvt_in_tail(const Params& p, lds_t* lds, int nunits, int begin, int end) {
    const int G = gridDim.x, c = bid_(), heavy = nunits % G;
    if (G != 256 || heavy == 0 || c < heavy) return;
    phase_cvt(p, lds, CVT_MOE0 + begin, CVT_MOE0 + end, c - heavy, G - heavy);
}

struct SchedDense : pg8::OrderBase {
    const char *A, *B; size_t ta, tb;
    __device__ const char* a_base(const pg8::Unit& u) const { return A + (size_t)u.pm * ta; }
    __device__ const char* b_base(const pg8::Unit& u) const { return B + (size_t)u.pn * tb; }
    __device__ int row(const pg8::Unit&, int) const { return 0; }
};
struct SchedMoE : pg8::OrderBase {
    const char *A, *B; size_t ta, tb, te; int t0; const int* tile_e; const int* rowidx;
    __device__ const char* a_base(const pg8::Unit& u) const { return A + (size_t)u.pm * ta; }
    __device__ const char* b_base(const pg8::Unit& u) const { return B + (size_t)__builtin_amdgcn_readfirstlane(ld_i(tile_e + t0 + u.pm)) * te + (size_t)u.pn * tb; }
    __device__ int row(const pg8::Unit& u, int r) const { return rowidx[(t0 + u.pm) * 256 + r]; }
};
struct EpiSwiGLU {
    static constexpr bool PERM = true;
    bf16_t* H;
    __device__ __forceinline__ void operator()(const pg8::f32x4 (&acc)[2][2][4][2], const pg8::Unit& u, int wr, int wc, int fr, int fq) const {
#pragma unroll
        for (int ai = 0; ai < 2; ++ai)
#pragma unroll
            for (int m = 0; m < 4; ++m) {
                const int row = u.pm * 256 + ai * 128 + wr * 64 + m * 16 + fr;
                const pg8::f32x4 g0 = acc[ai][0][m][0], g1 = acc[ai][0][m][1], u0 = acc[ai][1][m][0], u1 = acc[ai][1][m][1];
                pg8::u32x4 w;
                w.x = pg8::cvt_pk_bf16(silu_fast(g0[0]) * u0[0], silu_fast(g0[1]) * u0[1]); w.y = pg8::cvt_pk_bf16(silu_fast(g0[2]) * u0[2], silu_fast(g0[3]) * u0[3]);
                w.z = pg8::cvt_pk_bf16(silu_fast(g1[0]) * u1[0], silu_fast(g1[1]) * u1[1]); w.w = pg8::cvt_pk_bf16(silu_fast(g1[2]) * u1[2], silu_fast(g1[3]) * u1[3]);
                *(pg8::u32x4*)(H + (size_t)row * DFF + u.pn * 128 + wc * 32 + 8 * fq) = w;
            }
    }
};
template <bool WS = true> struct EpiSwiGLU8T {
    static constexpr bool PERM = true;
    unsigned char* H;
    __device__ __forceinline__ void operator()(const pg8::f32x4 (&acc)[2][2][4][2], const pg8::Unit& u, int wr, int wc, int fr, int fq) const {
        constexpr float IS = WS ? 1.f / WSCALE : 1.f;
#pragma unroll
        for (int ai = 0; ai < 2; ++ai)
#pragma unroll
            for (int m = 0; m < 4; ++m) {
                const int row = u.pm * 256 + ai * 128 + wr * 64 + m * 16 + fr;
                const pg8::f32x4 g0 = acc[ai][0][m][0] * IS, g1 = acc[ai][0][m][1] * IS, u0 = acc[ai][1][m][0] * (IS * HSCALE), u1 = acc[ai][1][m][1] * (IS * HSCALE);
                pg8::u32x2 w;
                w.x = fp8x4(clamp448(silu_fast(g0[0]) * u0[0]), clamp448(silu_fast(g0[1]) * u0[1]), clamp448(silu_fast(g0[2]) * u0[2]), clamp448(silu_fast(g0[3]) * u0[3]));
                w.y = fp8x4(clamp448(silu_fast(g1[0]) * u1[0]), clamp448(silu_fast(g1[1]) * u1[1]), clamp448(silu_fast(g1[2]) * u1[2]), clamp448(silu_fast(g1[3]) * u1[3]));
                *(pg8::u32x2*)(H + (size_t)row * DFF + u.pn * 128 + wc * 32 + 8 * fq) = w;
            }
    }
};
typedef EpiSwiGLU8T<true> EpiSwiGLU8;
template <bool MOE, bool SCALED = MOE> struct EpiRowsBf16 {
    static constexpr bool PERM = true;
    Params p; bf16_t* O; int t0;
    __device__ __forceinline__ void operator()(const pg8::f32x4 (&acc)[2][2][4][2], const pg8::Unit& u, int wr, int wc, int fr, int fq) const {
#pragma unroll
        for (int ai = 0; ai < 2; ++ai)
#pragma unroll
            for (int m = 0; m < 4; ++m) {
                const int row = u.pm * 256 + ai * 128 + wr * 64 + m * 16 + fr;
                bf16_t* rp = MOE ? ys_row(p, t0 * 256 + row) : O + (size_t)row * 1024;
#pragma unroll
                for (int bj = 0; bj < 2; ++bj) { constexpr float SC = SCALED ? 1.f / (WSCALE * HSCALE) : 1.f; const pg8::f32x4 v0 = acc[ai][bj][m][0] * SC, v1 = acc[ai][bj][m][1] * SC; pg8::u32x4 w;
                    w.x = pg8::cvt_pk_bf16(v0[0], v0[1]); w.y = pg8::cvt_pk_bf16(v0[2], v0[3]); w.z = pg8::cvt_pk_bf16(v1[0], v1[1]); w.w = pg8::cvt_pk_bf16(v1[2], v1[3]);
                    *(pg8::u32x4*)(rp + u.pn * 256 + bj * 128 + wc * 32 + 8 * fq) = w; }
            }
    }
};
__device__ __forceinline__ void phase_ffn_gu_dense(const Params& p, lds_t* lds) {
#if DENSE_FP8 == 1
    SchedDense S; S.init(RR / 256, 28, gridDim.x, bid_()); S.A = (const char*)WSP(bf16_t, OFF_XN); S.B = (const char*)WP(W_GU); S.ta = (size_t)256 * 1024; S.tb = (size_t)256 * 1024;
    EpiSwiGLU8 E{(unsigned char*)SP(bf16_t, S_H)};
    pg8::gemm_phase<EpiSwiGLU8, SchedDense, false, true>(lds, pg8::Gemm{512, 512, 512, p.wv}, S, E);
#elif DENSE_FP8 == 2
    SchedDense S; S.init(RR / 256, 28, gridDim.x, bid_()); S.A = (const char*)WSP(bf16_t, OFF_XN); S.B = (const char*)WP(W_GU); S.ta = (size_t)256 * 1024 * 2; S.tb = (size_t)256 * 1024 * 2;
    EpiSwiGLU8T<false> E{(unsigned char*)SP(bf16_t, S_H)};
    pg8::gemm_phase<EpiSwiGLU8T<false>, SchedDense, false>(lds, pg8::Gemm{1024, 1024, 1024, p.wv}, S, E);
#else
    SchedDense S; S.init(RR / 256, 28, gridDim.x, bid_()); S.A = (const char*)WSP(bf16_t, OFF_XN); S.B = (const char*)WP(W_GU); S.ta = (size_t)256 * 1024 * 2; S.tb = (size_t)256 * 1024 * 2;
    EpiSwiGLU E{SP(bf16_t, S_H)};
    pg8::gemm_phase<EpiSwiGLU, SchedDense, false>(lds, pg8::Gemm{1024, 1024, 1024, p.wv}, S, E);
#endif
}
__device__ __forceinline__ void phase_ffn_dn_dense(const Params& p, lds_t* lds) {
#if DENSE_FP8
    SchedDense S; S.init(RR / 256, 4, gridDim.x, bid_()); S.A = (const char*)SP(bf16_t, S_H); S.B = (const char*)WP(W_D); S.ta = (size_t)256 * DFF; S.tb = (size_t)256 * DFF;
    EpiRowsBf16<false, true> E{p, WSP(bf16_t, OFF_XN), 0};
    pg8::gemm_phase<EpiRowsBf16<false, true>, SchedDense, false, true>(lds, pg8::Gemm{DFF / 2, DFF / 2, DFF / 2, p.wv}, S, E);
#else
    SchedDense S; S.init(RR / 256, 4, gridDim.x, bid_()); S.A = (const char*)SP(bf16_t, S_H); S.B = (const char*)WP(W_D); S.ta = (size_t)256 * DFF * 2; S.tb = (size_t)256 * DFF * 2;
    EpiRowsBf16<false> E{p, WSP(bf16_t, OFF_XN), 0};
    pg8::gemm_phase<EpiRowsBf16<false>, SchedDense, false>(lds, pg8::Gemm{DFF, DFF, DFF, p.wv}, S, E);
#endif
}
__device__ __forceinline__ void phase_moe_gu(const Params& p, lds_t* lds) {
    const int NT = ld_i((const int*)p.ws + CW_NT);
    SchedMoE S; S.init(NT, 28, gridDim.x, bid_()); S.A = (const char*)SP(bf16_t, S_YS); S.B = (const char*)(p.ws + OFF_W + W_MGU); S.ta = (size_t)256 * 1024; S.tb = (size_t)256 * 1024; S.te = (size_t)7168 * 1024;
    S.t0 = 0; S.tile_e = WSP(int, OFF_TILEE); S.rowidx = WSP(int, OFF_ROWIDX);
    EpiSwiGLU8 E{(unsigned char*)SP(bf16_t, S_H)};
    pg8::gemm_phase<EpiSwiGLU8, SchedMoE, false, true>(lds, pg8::Gemm{512, 512, 512, p.wv}, S, E);
}
__device__ __forceinline__ void phase_moe_dn(const Params& p, lds_t* lds) {
    const int NT = ld_i((const int*)p.ws + CW_NT);
    SchedMoE S; S.init(NT, 4, gridDim.x, bid_()); S.A = (const char*)SP(bf16_t, S_H); S.B = (const char*)(p.ws + OFF_W + W_MD); S.ta = (size_t)256 * DFF; S.tb = (size_t)256 * DFF; S.te = (size_t)1024 * DFF;
    S.t0 = 0; S.tile_e = WSP(int, OFF_TILEE); S.rowidx = WSP(int, OFF_ROWIDX);
    EpiRowsBf16<true> E{p, nullptr, 0};
    pg8::gemm_phase<EpiRowsBf16<true>, SchedMoE, false, true>(lds, pg8::Gemm{DFF / 2, DFF / 2, DFF / 2, p.wv}, S, E);
}

typedef float f32x2 __attribute__((ext_vector_type(2)));
__device__ __forceinline__ f32x2 gelu_pk(f32x2 v) {
    const f32x2 av = __builtin_elementwise_abs(v), d = av * 0.2316418882f + 1.0f;
    f32x2 t; t.x = __builtin_amdgcn_rcpf(d.x); t.y = __builtin_amdgcn_rcpf(d.y);
    f32x2 q = t * 0.5307027145f + (-0.7265760135f); q = q * t + 0.7107068705f; q = q * t + (-0.142248368f); q = q * t + 0.127414796f; q = q * t;
    const f32x2 s = (v * v) * (-0.72134752044f);
    f32x2 e; e.x = __builtin_amdgcn_exp2f(s.x); e.y = __builtin_amdgcn_exp2f(s.y);
    const f32x2 m = v * (q * e), r = v - m;
    f32x2 o; o.x = v.x < 0.f ? m.x : r.x; o.y = v.y < 0.f ? m.y : r.y; return o;
}
__device__ __forceinline__ pg8::u32x4 pack8(const float* v) { pg8::u32x4 w; w.x = pg8::cvt_pk_bf16(v[0], v[1]); w.y = pg8::cvt_pk_bf16(v[2], v[3]); w.z = pg8::cvt_pk_bf16(v[4], v[5]); w.w = pg8::cvt_pk_bf16(v[6], v[7]); return w; }
__device__ __forceinline__ void rope8(float* v, const float2* cs) {
    const float4 a = *(const float4*)cs, b = *(const float4*)(cs + 2);
    const float c[4] = {a.x, a.z, b.x, b.z}, sn[4] = {a.y, a.w, b.y, b.w};
#pragma unroll
    for (int q = 0; q < 4; ++q) { const float x1 = v[2 * q], x2 = v[2 * q + 1]; v[2 * q] = x1 * c[q] - x2 * sn[q]; v[2 * q + 1] = x1 * sn[q] + x2 * c[q]; }
}
__device__ __forceinline__ const float2* rope_ptr(const float2* tab, int nf, int pos, int pi0) { const int co = pi0 < nf ? (pos >> 6) : (pos & 63); return tab + co * nf + (pi0 < nf ? pi0 : pi0 - nf); }

__device__ __forceinline__ void rope8r(float* v, const float4 a, const float4 b) {
    const float c[4] = {a.x, a.z, b.x, b.z}, sn[4] = {a.y, a.w, b.y, b.w};
#pragma unroll
    for (int q = 0; q < 4; ++q) { const float x1 = v[2 * q], x2 = v[2 * q + 1]; v[2 * q] = x1 * c[q] - x2 * sn[q]; v[2 * q + 1] = x1 * sn[q] + x2 * c[q]; }
}
struct EpiInProj {
    static constexpr bool PERM = true;
    Params p;
    __device__ __forceinline__ void operator()(const pg8::f32x4 (&acc)[2][2][4][2], const pg8::Unit& u, int wr, int wc, int fr, int fq) const {
        const int pn = u.pn;
        const bool lat_t = u.pm < TL / 256, roped = lat_t && (pn == 1 || pn == 2 || (pn == 4 && wc == 0));
        const int nf = pn == 4 ? 8 : 16, pb = pn == 4 ? 4 * fq : (wc & 1) * 16 + 4 * fq; const bool rowt = pb < nf;
        float4 ra[4], rb[4];
#pragma unroll
        for (int q = 0; q < 4; ++q) { ra[q] = make_float4(1.f, 0.f, 1.f, 0.f); rb[q] = ra[q]; }
        if (roped) { const float2* tab = pn == 4 ? WSP(float2, OFF_ROPEM) : WSP(float2, OFF_ROPEW);
#pragma unroll
            for (int q = 0; q < 4; ++q) { const int coord = rowt ? ((u.pm * 4 + (q & 1) * 2 + wr) & 127) : (q * 16 + fr); const float2* t = tab + coord * nf + (rowt ? pb : pb - nf);
                ra[q] = *(const float4*)t; rb[q] = *(const float4*)(t + 2); } }
#pragma unroll
        for (int ai = 0; ai < 2; ++ai)
#pragma unroll
            for (int m = 0; m < 4; ++m) {
                const int r = u.pm * 256 + ai * 128 + wr * 64 + m * 16 + fr;
                const int bb = row_batch(r), key = row_key(r);
                const float4 ca = rowt ? ra[ai] : ra[m], cb = rowt ? rb[ai] : rb[m];
                float s1 = 0.f, s2 = 0.f;
#pragma unroll
                for (int bj = 0; bj < 2; ++bj) {
                    const int c0 = bj * 128 + wc * 32 + 8 * fq;
                    float v[8];
#pragma unroll
                    for (int e = 0; e < 4; ++e) { v[e] = acc[ai][bj][m][0][e]; v[4 + e] = acc[ai][bj][m][1][e]; }
                    if (pn == 0) { *(pg8::u32x4*)(SP(bf16_t, S_ABUF) + (size_t)r * 256 + c0) = pack8(v); }
                    else if (pn == 1) { rope8r(v, ca, cb);
#pragma unroll
                        for (int e = 0; e < 8; ++e) v[e] *= 0.125f;
                        *(pg8::u32x4*)(SP(bf16_t, S_QW) + (size_t)r * 256 + c0) = pack8(v); }
                    else if (pn == 2) {
                        if (bj == 0) { rope8r(v, ca, cb); *(pg8::u32x4*)(SP(bf16_t, S_KW) + ((size_t)bb * NKEY + key) * 128 + c0) = pack8(v); }
                        else *(pg8::u32x4*)(SP(bf16_t, S_VW) + ((size_t)bb * NKEY + key) * 128 + (c0 - 128)) = pack8(v); }
                    else if (pn == 3) {
#pragma unroll
                        for (int e = 0; e < 8; ++e) s2 += v[e] * v[e];
                        *(pg8::u32x4*)(SP(bf16_t, S_C2) + (size_t)r * 384 + c0) = pack8(v); }
                    else if (pn == 4) {
                        if (bj == 0) {
#pragma unroll
                            for (int e = 0; e < 8; ++e) s2 += v[e] * v[e];
                            *(pg8::u32x4*)(SP(bf16_t, S_C2) + (size_t)r * 384 + 256 + c0) = pack8(v); }
                        else if (wc == 0) { rope8r(v, ca, cb); const pg8::u32x4 w = pack8(v);
#pragma unroll
                            for (int h = 0; h < 4; ++h) *(pg8::u32x4*)(SP(bf16_t, S_KM) + (((size_t)bb * 4 + h) * NKEY + key) * 96 + 64 + 8 * fq) = w; } }
                    else {
#pragma unroll
                        for (int e = 0; e < 8; e += 2) { const f32x2 gq = gelu_pk((f32x2){v[e], v[e + 1]}); v[e] = gq.x; v[e + 1] = gq.y; }
                        if (pn == 6) {
#pragma unroll
                            for (int e = 0; e < 8; ++e) { s1 += v[e]; s2 += v[e] * v[e]; } }
                        *(pg8::u32x4*)(SP(bf16_t, pn == 5 ? S_U : S_VG) + (size_t)r * 256 + c0) = pack8(v); }
                }
                if (pn == 3 || pn == 4 || pn == 6) {
                    { const int l4_ = lane_() << 2; s1 += __int_as_float(__builtin_amdgcn_ds_bpermute(l4_ ^ 64, __float_as_int(s1))); s1 += __int_as_float(__builtin_amdgcn_ds_bpermute(l4_ ^ 128, __float_as_int(s1))); s2 += __int_as_float(__builtin_amdgcn_ds_bpermute(l4_ ^ 64, __float_as_int(s2))); s2 += __int_as_float(__builtin_amdgcn_ds_bpermute(l4_ ^ 128, __float_as_int(s2))); }
                    if (fq == 0) { if (pn == 3) WSP(float, OFF_SSQQ)[(size_t)r * 4 + wc] = s2; else if (pn == 4) WSP(float, OFF_SSQKV)[(size_t)r * 4 + wc] = s2;
                        else { WSP(float, OFF_LNS)[(size_t)r * 8 + wc * 2] = s1; WSP(float, OFF_LNS)[(size_t)r * 8 + wc * 2 + 1] = s2; } }
                }
            }
    }
};
template <int KV> struct EpiUp {
    static constexpr bool PERM = true;
    Params p;
    __device__ __forceinline__ void operator()(const pg8::f32x4 (&acc)[2][2][4][2], const pg8::Unit& u, int wr, int wc, int fr, int fq) const {
        const int pn = u.pn;
        float rs8[8];
#pragma unroll
        for (int q = 0; q < 8; ++q) { const int r = u.pm * 256 + (q >> 2) * 128 + wr * 64 + (q & 3) * 16 + fr; const float4 sq4 = *(const float4*)(WSP(float, KV ? OFF_SSQKV : OFF_SSQQ) + (size_t)r * 4);
            rs8[q] = rsqrtf(((sq4.x + sq4.y) + (sq4.z + sq4.w)) * (KV ? 1.f / 128.f : 1.f / 256.f) + EPS) * (KV ? 1.f : 0.10206207261596575f); }
#pragma unroll
        for (int ai = 0; ai < 2; ++ai)
#pragma unroll
            for (int m = 0; m < 4; ++m) {
                const int r = u.pm * 256 + ai * 128 + wr * 64 + m * 16 + fr;
                const bool lat = r < TL; const int pos = r & 8191, bb = row_batch(r), key = row_key(r);
                const float rs = rs8[ai * 4 + m];
#pragma unroll
                for (int bj = 0; bj < 2; ++bj) {
                    const int c0 = bj * 128 + wc * 32 + 8 * fq, n = pn * 256 + c0;
                    float v[8];
#pragma unroll
                    for (int e = 0; e < 4; ++e) { v[e] = acc[ai][bj][m][0][e] * rs; v[4 + e] = acc[ai][bj][m][1][e] * rs; }
                    if (!KV) { if (n < 384) { const int i = n % 96;
                            if (i >= 64 && lat) rope8(v, rope_ptr(WSP(float2, OFF_ROPEM), 8, pos, (i - 64) >> 1));
                            *(pg8::u32x4*)(SP(bf16_t, S_QM) + (size_t)r * 384 + n) = pack8(v); } }
                    else { const int h = n >> 7, j0 = n & 127;
                        if (j0 < 64) *(pg8::u32x4*)(SP(bf16_t, S_KM) + (((size_t)bb * 4 + h) * NKEY + key) * 96 + j0) = pack8(v);
                        else *(pg8::u32x4*)(SP(bf16_t, S_VM) + (((size_t)bb * 4 + h) * NKEY + key) * 64 + (j0 - 64)) = pack8(v); }
                }
            }
    }
};
__device__ __forceinline__ void phase_inproj(const Params& p, lds_t* lds, int l) {
    SchedDense S; S.init(RR / 256, 7, gridDim.x, bid_()); S.A = (const char*)WSP(bf16_t, OFF_XN); S.B = (const char*)(WP(W_IN) + (size_t)l * 1792 * 1024); S.ta = (size_t)256 * 1024 * 2; S.tb = (size_t)256 * 1024 * 2;
    EpiInProj E{p};
    pg8::gemm_phase<EpiInProj, SchedDense, false>(lds, pg8::Gemm{1024, 1024, 1024, p.wv}, S, E);
}
__device__ __forceinline__ void phase_up(const Params& p, lds_t* lds, int l) {
    { SchedDense S; S.init(RR / 256, 2, gridDim.x, bid_()); S.A = (const char*)SP(bf16_t, S_C2); S.B = (const char*)(WP(W_UP) + (size_t)l * 1024 * 384); S.ta = (size_t)256 * 384 * 2; S.tb = (size_t)256 * 384 * 2;
      EpiUp<0> E{p}; pg8::gemm_phase<EpiUp<0>, SchedDense, false>(lds, pg8::Gemm{384, 384, 256, p.wv}, S, E); }
    { SchedDense S; S.init(RR / 256, 2, gridDim.x, (int)gridDim.x - 1 - bid_()); S.A = (const char*)(SP(bf16_t, S_C2) + 256); S.B = (const char*)(WP(W_UP) + (size_t)l * 1024 * 384 + (size_t)512 * 384 + 256); S.ta = (size_t)256 * 384 * 2; S.tb = (size_t)256 * 384 * 2;
      EpiUp<1> E{p}; pg8::gemm_phase<EpiUp<1>, SchedDense, false>(lds, pg8::Gemm{384, 384, 128, p.wv}, S, E); }
}
__device__ __forceinline__ void phase_outproj(const Params& p, lds_t* lds, int l) {
    SchedDense S; S.init(l == 0 ? RR / 256 : TL / 256, 4, gridDim.x, bid_()); S.A = (const char*)SP(bf16_t, S_CAT); S.B = (const char*)(WP(W_O) + (size_t)l * 1024 * 1280); S.ta = (size_t)256 * 1280 * 2; S.tb = (size_t)256 * 1280 * 2;
    EpiRowsBf16<false> E{p, SP(bf16_t, S_MX), 0};
    pg8::gemm_phase<EpiRowsBf16<false>, SchedDense, false>(lds, pg8::Gemm{1280, 1280, 1280, p.wv}, S, E);
}


namespace att {
using bf16x8 = __attribute__((ext_vector_type(8))) short;
using s16x4 = __attribute__((ext_vector_type(4))) short;
using f32x16 = __attribute__((ext_vector_type(16))) float;
using u32x4 = __attribute__((ext_vector_type(4))) unsigned;
#define KSWZ(row, colB) ((row) * 256 + ((colB) ^ (((row) & 15) << 4)))
#define SBAR() __builtin_amdgcn_sched_barrier(0)
constexpr float THR = 8.f, LOG2E = 1.4426950408889634f;
constexpr int SHM_K = 64 * 256, SHM_V = 64 * 64 * 2;
constexpr int NBUF = 3;
constexpr int ATT_LDS = NBUF * SHM_K + NBUF * SHM_V + 8 * 64 * 4;
__device__ __forceinline__ int crow(int r, int hi) { return (r & 3) + 8 * (r >> 2) + 4 * hi; }
__device__ __forceinline__ unsigned cvtpk(float lo, float hi) { unsigned r; asm volatile("v_cvt_pk_bf16_f32 %0, %1, %2" : "=v"(r) : "v"(lo), "v"(hi)); return r; }
__device__ __forceinline__ void partialSM(f32x16& p0, f32x16& p1, float& m_reg, float& mn, float& alpha) {
    float pmax = p0[0];
#pragma unroll
    for (int r = 1; r < 16; ++r) pmax = fmaxf(pmax, p0[r]);
#pragma unroll
    for (int r = 0; r < 16; ++r) pmax = fmaxf(pmax, p1[r]);
    { auto rr = __builtin_amdgcn_permlane32_swap(__float_as_uint(pmax), __float_as_uint(pmax), false, false); pmax = fmaxf(__uint_as_float(rr[0]), __uint_as_float(rr[1])); }
    if (__builtin_expect(__all(pmax - m_reg <= THR), 1)) { mn = m_reg; alpha = 1.f; }
    else { mn = fmaxf(m_reg, pmax); alpha = __builtin_amdgcn_exp2f((m_reg - mn) * LOG2E); m_reg = mn; }
    const float mnC = -mn * LOG2E;
#pragma unroll
    for (int r = 0; r < 16; ++r) p0[r] = fmaf(p0[r], LOG2E, mnC);
#pragma unroll
    for (int r = 0; r < 16; ++r) p1[r] = fmaf(p1[r], LOG2E, mnC);
#pragma unroll
    for (int r = 0; r < 16; ++r) p0[r] = __builtin_amdgcn_exp2f(p0[r]);
}
__device__ __forceinline__ void finishSM(f32x16& p0, f32x16& p1, bf16x8& pa0, bf16x8& pa1, bf16x8& pa2, bf16x8& pa3) {
#pragma unroll
    for (int r = 0; r < 16; ++r) p1[r] = __builtin_amdgcn_exp2f(p1[r]);
#define PK4(P, BASE, OUT) do { u32x4 w = {cvtpk(P[BASE + 0], P[BASE + 1]), cvtpk(P[BASE + 2], P[BASE + 3]), cvtpk(P[BASE + 4], P[BASE + 5]), cvtpk(P[BASE + 6], P[BASE + 7])}; OUT = *reinterpret_cast<bf16x8*>(&w); } while (0)
    PK4(p0, 0, pa0); PK4(p0, 8, pa1); PK4(p1, 0, pa2); PK4(p1, 8, pa3);
#undef PK4
}
template <int DQK>
__device__ __forceinline__ void qkt(f32x16& p0, f32x16& p1, const char* Ks, const bf16x8* qr, int r32, int hi) {
    p0 = f32x16{}; p1 = f32x16{};
#pragma unroll
    for (int d0 = 0; d0 < DQK / 16; ++d0) { const int cb = (d0 * 16 + hi * 8) * 2;
        const bf16x8 b0 = *reinterpret_cast<const bf16x8*>(Ks + KSWZ(r32, cb));
        const bf16x8 b1 = *reinterpret_cast<const bf16x8*>(Ks + KSWZ(32 + r32, cb));
        p0 = __builtin_amdgcn_mfma_f32_32x32x16_bf16(b0, qr[d0], p0, 0, 0, 0);
        p1 = __builtin_amdgcn_mfma_f32_32x32x16_bf16(b1, qr[d0], p1, 0, 0, 0); }
}
__device__ __forceinline__ void maskband(f32x16& p0, f32x16& p1, int kp0, int qp, int hi) {
#pragma unroll
    for (int r = 0; r < 16; ++r) { const int d0 = kp0 + crow(r, hi) - qp; if (d0 > 128 || d0 < -128) p0[r] = -1e30f; const int d1 = d0 + 32; if (d1 > 128 || d1 < -128) p1[r] = -1e30f; }
}
__device__ __forceinline__ int v_st(int k, int c) { const int kk = k; return ((kk >> 3) * 2 + (c >> 5)) * 512 + ((kk & 7) * 32 + (c & 31)) * 2; }
__device__ __forceinline__ int v_rd_base(int lane) { return ((lane & 3) << 3) | (((lane >> 2) & 3) << 6) | (((lane >> 4) & 1) << 5) | (((lane >> 5) & 1) << 8); }
constexpr int v_rd_off(int d0, int ks, int half) { return d0 * 512 + ks * 2048 + half * 1024; }
template <int OFF> __device__ __forceinline__ s16x4 tr_read(int vb) { s16x4 r; asm volatile("ds_read_b64_tr_b16 %0, %1 offset:%2" : "=&v"(r) : "v"(vb), "i"(OFF) : "memory"); return r; }
template <int D0> __device__ __forceinline__ void pv_one(f32x16& od, int vb, bf16x8 pa0, bf16x8 pa1, bf16x8 pa2, bf16x8 pa3) {
    const s16x4 l0 = tr_read<v_rd_off(D0, 0, 0)>(vb), h0 = tr_read<v_rd_off(D0, 0, 1)>(vb), l1 = tr_read<v_rd_off(D0, 1, 0)>(vb), h1 = tr_read<v_rd_off(D0, 1, 1)>(vb);
    const s16x4 l2 = tr_read<v_rd_off(D0, 2, 0)>(vb), h2 = tr_read<v_rd_off(D0, 2, 1)>(vb), l3 = tr_read<v_rd_off(D0, 3, 0)>(vb), h3 = tr_read<v_rd_off(D0, 3, 1)>(vb);
    asm volatile("s_waitcnt lgkmcnt(0)" ::: "memory"); SBAR();
#define PK(L, H) (bf16x8){L[0], L[1], L[2], L[3], H[0], H[1], H[2], H[3]}
    od = __builtin_amdgcn_mfma_f32_32x32x16_bf16(pa0, PK(l0, h0), od, 0, 0, 0);
    od = __builtin_amdgcn_mfma_f32_32x32x16_bf16(pa1, PK(l1, h1), od, 0, 0, 0);
    od = __builtin_amdgcn_mfma_f32_32x32x16_bf16(pa2, PK(l2, h2), od, 0, 0, 0);
    od = __builtin_amdgcn_mfma_f32_32x32x16_bf16(pa3, PK(l3, h3), od, 0, 0, 0);
#undef PK
}
__device__ __forceinline__ void pv_pair(f32x16& o0, f32x16& o1, int vb, bf16x8 pa0, bf16x8 pa1, bf16x8 pa2, bf16x8 pa3) {
    const s16x4 l0 = tr_read<v_rd_off(0, 0, 0)>(vb), h0 = tr_read<v_rd_off(0, 0, 1)>(vb), l1 = tr_read<v_rd_off(0, 1, 0)>(vb), h1 = tr_read<v_rd_off(0, 1, 1)>(vb);
    const s16x4 l2 = tr_read<v_rd_off(0, 2, 0)>(vb), h2 = tr_read<v_rd_off(0, 2, 1)>(vb), l3 = tr_read<v_rd_off(0, 3, 0)>(vb), h3 = tr_read<v_rd_off(0, 3, 1)>(vb);
    const s16x4 m0 = tr_read<v_rd_off(1, 0, 0)>(vb), n0 = tr_read<v_rd_off(1, 0, 1)>(vb), m1 = tr_read<v_rd_off(1, 1, 0)>(vb), n1 = tr_read<v_rd_off(1, 1, 1)>(vb);
    const s16x4 m2 = tr_read<v_rd_off(1, 2, 0)>(vb), n2 = tr_read<v_rd_off(1, 2, 1)>(vb), m3 = tr_read<v_rd_off(1, 3, 0)>(vb), n3 = tr_read<v_rd_off(1, 3, 1)>(vb);
#define PK(L, H) (bf16x8){L[0], L[1], L[2], L[3], H[0], H[1], H[2], H[3]}
    asm volatile("s_waitcnt lgkmcnt(8)" ::: "memory"); SBAR();
    o0 = __builtin_amdgcn_mfma_f32_32x32x16_bf16(pa0, PK(l0, h0), o0, 0, 0, 0); o0 = __builtin_amdgcn_mfma_f32_32x32x16_bf16(pa1, PK(l1, h1), o0, 0, 0, 0);
    o0 = __builtin_amdgcn_mfma_f32_32x32x16_bf16(pa2, PK(l2, h2), o0, 0, 0, 0); o0 = __builtin_amdgcn_mfma_f32_32x32x16_bf16(pa3, PK(l3, h3), o0, 0, 0, 0);
    asm volatile("s_waitcnt lgkmcnt(0)" ::: "memory"); SBAR();
    o1 = __builtin_amdgcn_mfma_f32_32x32x16_bf16(pa0, PK(m0, n0), o1, 0, 0, 0); o1 = __builtin_amdgcn_mfma_f32_32x32x16_bf16(pa1, PK(m1, n1), o1, 0, 0, 0);
    o1 = __builtin_amdgcn_mfma_f32_32x32x16_bf16(pa2, PK(m2, n2), o1, 0, 0, 0); o1 = __builtin_amdgcn_mfma_f32_32x32x16_bf16(pa3, PK(m3, n3), o1, 0, 0, 0);
#undef PK
}
struct Unit {
    const bf16_t* Q; int ldq;
    const bf16_t* K; int ldk;
    const bf16_t* V; int ldv;
    bf16_t* O; int ldo;
    int NT, n1, k1, k2;
    int qpos0;
    float sink; int has_sink, wv;
};
template <int DQK, bool WIN>
__device__ __forceinline__ void attn_unit(const Unit& U, char* lds) {
    constexpr int NCH = DQK / 8;
    const int tid = tid_(U.wv), wid = U.wv, lane = tid & 63, r32 = lane & 31, hi = lane >> 5;
    char* V_lds = lds; char* K_lds = lds + NBUF * SHM_V;
    float* ws = (float*)(lds + NBUF * SHM_V + NBUF * SHM_K) + wid * 64; float* li_l = ws; float* al_l = ws + 32;
    float m_reg = -1e30f; f32x16 o[2] = {}, lacc = {}; bf16x8 qr[DQK / 16];
    const bf16x8 ones = {0x3F80, 0x3F80, 0x3F80, 0x3F80, 0x3F80, 0x3F80, 0x3F80, 0x3F80};
    const bf16_t* Qw = U.Q + (size_t)(wid * 32 + r32) * U.ldq + hi * 8;
#pragma unroll
    for (int d0 = 0; d0 < DQK / 16; ++d0) qr[d0] = *reinterpret_cast<const bf16x8*>(Qw + d0 * 16);
    const int kc0 = tid, kr0 = kc0 / NCH, kcol0 = (kc0 % NCH) * 8;
    const int kc1 = tid + 512, kr1 = kc1 / NCH, kcol1 = (kc1 % NCH) * 8; const bool has1 = kc1 < 64 * NCH;
    const int vr = tid >> 3, vc = (tid & 7) * 8, vst = v_st(vr, vc);
    const int kst0 = KSWZ(kr0, kcol0 * 2), kst1 = KSWZ(kr1, kcol1 * 2);
    const int vb0 = (int)(uintptr_t)V_lds + v_rd_base(lane);
    const int qp = U.qpos0 + wid * 32 + r32;
    struct { bf16x8 k0, k1, v; } sr_[2];
#define TKEY(j) ((j) < U.n1 ? U.k1 + 64 * (j) : U.k2 + 64 * ((j) - U.n1))
#define SLOAD(i, j) do { const int _k0 = TKEY(j); sr_[i].k0 = *reinterpret_cast<const bf16x8*>(U.K + (size_t)(_k0 + kr0) * U.ldk + kcol0); \
    if (has1) sr_[i].k1 = *reinterpret_cast<const bf16x8*>(U.K + (size_t)(_k0 + kr1) * U.ldk + kcol1); \
    sr_[i].v = *reinterpret_cast<const bf16x8*>(U.V + (size_t)(_k0 + vr) * U.ldv + vc); } while (0)
#define SWRITE(b, i) do { *(bf16x8*)(V_lds + (b) * SHM_V + vst) = sr_[i].v; *(bf16x8*)(K_lds + (b) * SHM_K + kst0) = sr_[i].k0; \
    if (has1) *(bf16x8*)(K_lds + (b) * SHM_K + kst1) = sr_[i].k1; } while (0)
#define RESC(a) do { if (__any((a) < 1.f)) { if (hi == 0) al_l[r32] = (a); asm volatile("s_waitcnt lgkmcnt(0)" ::: "memory"); \
    _Pragma("unroll") for (int r = 0; r < 16; ++r) { const float a_ = al_l[crow(r, hi)]; o[0][r] *= a_; o[1][r] *= a_; lacc[r] *= a_; } } } while (0)
#define MASK(P0, P1, j) do { if (WIN && (j) >= U.n1) maskband(P0, P1, TKEY(j), qp, hi); } while (0)
#define PVD(vbase) do { pv_one<0>(o[0], vbase, pa0, pa1, pa2, pa3); pv_one<1>(o[1], vbase, pa0, pa1, pa2, pa3); \
    lacc = __builtin_amdgcn_mfma_f32_32x32x16_bf16(pa0, ones, lacc, 0, 0, 0); lacc = __builtin_amdgcn_mfma_f32_32x32x16_bf16(pa1, ones, lacc, 0, 0, 0); \
    lacc = __builtin_amdgcn_mfma_f32_32x32x16_bf16(pa2, ones, lacc, 0, 0, 0); lacc = __builtin_amdgcn_mfma_f32_32x32x16_bf16(pa3, ones, lacc, 0, 0, 0); } while (0)
    f32x16 pA0, pA1, pB0, pB1; float mnA, mnB, alA, alB; bf16x8 pa0, pa1, pa2, pa3; const int NT = U.NT;
    SLOAD(0, 0); asm volatile("s_waitcnt vmcnt(0)" ::: "memory"); SWRITE(0, 0); __syncthreads();
    qkt<DQK>(pA0, pA1, K_lds, qr, r32, hi); MASK(pA0, pA1, 0); partialSM(pA0, pA1, m_reg, mnA, alA);
    SLOAD(1, 1); if (2 < NT) SLOAD(0, 2);
    SWRITE(1, 1); __syncthreads();
    int bc = 1, bp = 0, bn = 2;
    for (int j = 1; j + 1 < NT; j += 2) {
        SLOAD(1, j + 2);
        SBAR(); qkt<DQK>(pB0, pB1, K_lds + bc * SHM_K, qr, r32, hi); MASK(pB0, pB1, j);
        finishSM(pA0, pA1, pa0, pa1, pa2, pa3); SBAR();
        PVD(vb0 + bp * SHM_V); partialSM(pB0, pB1, m_reg, mnB, alB);
        SWRITE(bn, 0);
        RESC(alB); __syncthreads();
        { const int t_ = bp; bp = bc; bc = bn; bn = t_; }
        if (j + 3 < NT) SLOAD(0, j + 3);
        SBAR(); qkt<DQK>(pA0, pA1, K_lds + bc * SHM_K, qr, r32, hi); MASK(pA0, pA1, j + 1);
        finishSM(pB0, pB1, pa0, pa1, pa2, pa3); SBAR();
        PVD(vb0 + bp * SHM_V); partialSM(pA0, pA1, m_reg, mnA, alA);
        SWRITE(bn, 1);
        RESC(alA); __syncthreads();
        { const int t_ = bp; bp = bc; bc = bn; bn = t_; }
    }
    SBAR(); qkt<DQK>(pB0, pB1, K_lds + bc * SHM_K, qr, r32, hi); MASK(pB0, pB1, NT - 1);
    finishSM(pA0, pA1, pa0, pa1, pa2, pa3); SBAR();
    PVD(vb0 + bp * SHM_V); partialSM(pB0, pB1, m_reg, mnB, alB);
    RESC(alB);
    finishSM(pB0, pB1, pa0, pa1, pa2, pa3); SBAR();
    PVD(vb0 + bc * SHM_V);
    if (WIN && U.has_sink) {
        if (hi == 0) li_l[r32] = __builtin_amdgcn_exp2f((U.sink - m_reg) * LOG2E); asm volatile("s_waitcnt lgkmcnt(0)" ::: "memory");
#pragma unroll
        for (int r = 0; r < 16; ++r) lacc[r] += li_l[crow(r, hi)]; }
    float rli[16];
#pragma unroll
    for (int r = 0; r < 16; ++r) rli[r] = __builtin_amdgcn_rcpf(lacc[r]);
    bf16_t* Ow = U.O + (size_t)(wid * 32) * U.ldo;
#pragma unroll
    for (int r = 0; r < 16; ++r) { const int orow = crow(r, hi);
#pragma unroll
        for (int d0 = 0; d0 < 2; ++d0) Ow[(size_t)orow * U.ldo + d0 * 32 + r32] = f2bf(o[d0][r] * rli[r]); }
    __syncthreads();
#undef TKEY
#undef SLOAD
#undef SWRITE
#undef RESC
#undef MASK
#undef PVD
}

typedef __bf16 bf16x2_t __attribute__((ext_vector_type(2)));
typedef float f32x2_t __attribute__((ext_vector_type(2)));
__device__ __forceinline__ unsigned cvtpk2(float lo, float hi) { f32x2_t f = {lo, hi}; bf16x2_t b = __builtin_convertvector(f, bf16x2_t); return *reinterpret_cast<unsigned*>(&b); }
__device__ __forceinline__ void sl_pk(const f32x16& p, bf16x8& lo, bf16x8& hi) {
#define PK4(BASE, OUT) do { u32x4 w = {cvtpk2(p[BASE + 0], p[BASE + 1]), cvtpk2(p[BASE + 2], p[BASE + 3]), cvtpk2(p[BASE + 4], p[BASE + 5]), cvtpk2(p[BASE + 6], p[BASE + 7])}; OUT = *reinterpret_cast<bf16x8*>(&w); } while (0)
    PK4(0, lo); PK4(8, hi);
#undef PK4
}
template <int DQK>
__device__ __forceinline__ void attn_mla2(const Unit& U, char* lds) {
    constexpr int NCH = DQK / 8; constexpr float PLIM = 1073741824.f;
    const int tid = tid_(U.wv), wid = U.wv, lane = tid & 63, r32 = lane & 31, hi = lane >> 5;
    char* V_lds = lds; char* K_lds = lds + 4 * SHM_V;
    float* ws = (float*)(lds + 4 * SHM_V + 4 * SHM_K) + wid * 64; float* li_l = ws; float* al_l = ws + 32;
    float mA, mB, lA, lB; f32x16 oA[2], oB[2]; bf16x8 qA[DQK / 16], qB[DQK / 16]; bool refA, refB, force = false;
    { const bf16_t* Qw = U.Q + (size_t)(wid * 64 + r32) * U.ldq + hi * 8;
#pragma unroll
      for (int d0 = 0; d0 < DQK / 16; ++d0) { qA[d0] = *reinterpret_cast<const bf16x8*>(Qw + d0 * 16); qB[d0] = *reinterpret_cast<const bf16x8*>(Qw + (size_t)32 * U.ldq + d0 * 16);
#pragma unroll
        for (int e = 0; e < 8; ++e) { qA[d0][e] = (short)f2bf(bf2f((bf16_t)qA[d0][e]) * LOG2E); qB[d0][e] = (short)f2bf(bf2f((bf16_t)qB[d0][e]) * LOG2E); } } }
    const int kc0 = tid, kr0 = kc0 / NCH, kcol0 = (kc0 % NCH) * 8;
    const int kc1 = tid + 512, kr1 = kc1 / NCH, kcol1 = (kc1 % NCH) * 8; const bool has1 = kc1 < 64 * NCH;
    const int vr = tid >> 3, vc = (tid & 7) * 8, vst = v_st(vr, vc);
    const int kst0 = KSWZ(kr0, kcol0 * 2), kst1 = KSWZ(kr1, kcol1 * 2);
    const int vb0 = (int)(uintptr_t)V_lds + v_rd_base(lane);
    bf16x8 sk0, sk1, sv;
    typedef __attribute__((address_space(1))) const char* g_c_p; typedef __attribute__((address_space(1))) const bf16x8* g_b8_p;
    const unsigned ko0 = (unsigned)(kr0 * U.ldk + kcol0) * 2u, ko1 = (unsigned)(kr1 * U.ldk + kcol1) * 2u, vo = (unsigned)(vr * U.ldv + vc) * 2u;
#define SLOAD4(j) do { unsigned long long kj_ = (unsigned long long)((const char*)U.K + (size_t)(64 * (j)) * U.ldk * 2), vj_ = (unsigned long long)((const char*)U.V + (size_t)(64 * (j)) * U.ldv * 2); \
    asm volatile("" : "+s"(kj_), "+s"(vj_)); g_c_p Kj_ = (g_c_p)kj_; g_c_p Vj_ = (g_c_p)vj_; \
    sk0 = *(g_b8_p)(Kj_ + ko0); if (has1) sk1 = *(g_b8_p)(Kj_ + ko1); sv = *(g_b8_p)(Vj_ + vo); } while (0)
#define SWRITE4(b) do { *(bf16x8*)(V_lds + (b) * SHM_V + vst) = sv; *(bf16x8*)(K_lds + (b) * SHM_K + kst0) = sk0; if (has1) *(bf16x8*)(K_lds + (b) * SHM_K + kst1) = sk1; } while (0)
#define SOFTMAX4(S0, S1, q, m, refnz, l, o, f0, f1, f2, f3, Ks) do { \
    float ps_ = 0.f; \
    if (refnz) { _Pragma("unroll") for (int r = 0; r < 16; ++r) { S0[r] -= (m); S1[r] -= (m); } } \
    _Pragma("unroll") for (int r = 0; r < 16; ++r) S0[r] = __builtin_amdgcn_exp2f(S0[r]); \
    _Pragma("unroll") for (int r = 0; r < 16; ++r) S1[r] = __builtin_amdgcn_exp2f(S1[r]); \
    _Pragma("unroll") for (int r = 0; r < 16; ++r) ps_ += S0[r]; \
    _Pragma("unroll") for (int r = 0; r < 16; ++r) ps_ += S1[r]; \
    { auto rr_ = __builtin_amdgcn_permlane32_swap(__float_as_uint(ps_), __float_as_uint(ps_), false, false); ps_ = __uint_as_float(rr_[0]) + __uint_as_float(rr_[1]); } \
    if (__builtin_expect(force || (MK_TEST == 1 && first_) || __any(!(ps_ <= PLIM)), 0)) { \
        qkt<DQK>(S0, S1, Ks, q, r32, hi); \
        float pm_ = S0[0]; \
        _Pragma("unroll") for (int r = 1; r < 16; ++r) pm_ = fmaxf(pm_, S0[r]); \
        _Pragma("unroll") for (int r = 0; r < 16; ++r) pm_ = fmaxf(pm_, S1[r]); \
        { auto rr_ = __builtin_amdgcn_permlane32_swap(__float_as_uint(pm_), __float_as_uint(pm_), false, false); pm_ = fmaxf(__uint_as_float(rr_[0]), __uint_as_float(rr_[1])); } \
        const float mn_ = fmaxf(m, pm_), al_ = __builtin_amdgcn_exp2f((m) - mn_); m = mn_; l *= al_; refnz = true; \
        if (hi == 0) al_l[r32] = al_; asm volatile("s_waitcnt lgkmcnt(0)" ::: "memory"); \
        _Pragma("unroll") for (int r = 0; r < 16; ++r) { const float a_ = al_l[crow(r, hi)]; o[0][r] *= a_; o[1][r] *= a_; } \
        ps_ = 0.f; \
        _Pragma("unroll") for (int r = 0; r < 16; ++r) { S0[r] = __builtin_amdgcn_exp2f(S0[r] - mn_); ps_ += S0[r]; } \
        _Pragma("unroll") for (int r = 0; r < 16; ++r) { S1[r] = __builtin_amdgcn_exp2f(S1[r] - mn_); ps_ += S1[r]; } \
        { auto rr_ = __builtin_amdgcn_permlane32_swap(__float_as_uint(ps_), __float_as_uint(ps_), false, false); ps_ = __uint_as_float(rr_[0]) + __uint_as_float(rr_[1]); } \
    } \
    l += ps_; \
    { bf16x8 t0_, t1_; sl_pk(S0, t0_, t1_); f0 = t0_; f1 = t1_; sl_pk(S1, t0_, t1_); f2 = t0_; f3 = t1_; } \
} while (0)
    const int NT = U.NT;
#define TILE4(b) do { \
        f32x16 pA0 = {}, pA1 = {}, pB0 = {}, pB1 = {}; \
        const char* Ks = K_lds + (b) * SHM_K; \
        _Pragma("unroll") for (int d0 = 0; d0 < DQK / 16; ++d0) { const int cb = (d0 * 16 + hi * 8) * 2; \
            const bf16x8 k0 = *reinterpret_cast<const bf16x8*>(Ks + KSWZ(r32, cb)), k1 = *reinterpret_cast<const bf16x8*>(Ks + KSWZ(32 + r32, cb)); \
            pA0 = __builtin_amdgcn_mfma_f32_32x32x16_bf16(k0, qA[d0], pA0, 0, 0, 0); pA1 = __builtin_amdgcn_mfma_f32_32x32x16_bf16(k1, qA[d0], pA1, 0, 0, 0); \
            pB0 = __builtin_amdgcn_mfma_f32_32x32x16_bf16(k0, qB[d0], pB0, 0, 0, 0); pB1 = __builtin_amdgcn_mfma_f32_32x32x16_bf16(k1, qB[d0], pB1, 0, 0, 0); } \
        bf16x8 pa0, pa1, pa2, pa3, pb0, pb1, pb2, pb3; \
        SOFTMAX4(pA0, pA1, qA, mA, refA, lA, oA, pa0, pa1, pa2, pa3, Ks); \
        pv_one<0>(oA[0], vb0 + (b) * SHM_V, pa0, pa1, pa2, pa3); pv_one<1>(oA[1], vb0 + (b) * SHM_V, pa0, pa1, pa2, pa3); \
        SOFTMAX4(pB0, pB1, qB, mB, refB, lB, oB, pb0, pb1, pb2, pb3, Ks); \
        pv_one<0>(oB[0], vb0 + (b) * SHM_V, pb0, pb1, pb2, pb3); pv_one<1>(oB[1], vb0 + (b) * SHM_V, pb0, pb1, pb2, pb3); \
    } while (0)
    int* fl = (int*)(lds + 4 * SHM_V + 4 * SHM_K + 8 * 64 * 4);
#pragma unroll 1
    for (int pass = 0; pass < 2; ++pass) {
    mA = mB = force ? -1e30f : 0.f; lA = lB = 0.f; refA = refB = false; oA[0] = oA[1] = oB[0] = oB[1] = f32x16{};
    SLOAD4(0); asm volatile("s_waitcnt vmcnt(0)" ::: "memory"); SWRITE4(0); SLOAD4(1); asm volatile("s_waitcnt vmcnt(0)" ::: "memory"); SWRITE4(1); __syncthreads();
    asm volatile(".p2align 8");
#pragma unroll 1
    for (int j = 0; j < NT; j += 2) {
        const bool first_ = j == 0;
        const int b0 = j & 3;
        if (j + 2 < NT) SLOAD4(j + 2);
        TILE4(b0);
        if (j + 2 < NT) { SWRITE4(b0 ^ 2); SLOAD4(j + 3); }
        SBAR();
        TILE4(b0 + 1);
        if (j + 2 < NT) SWRITE4((b0 ^ 2) + 1);
        __syncthreads();
    }
    if (pass) break;
    { const bool bad = (MK_TEST == 2) || __any(!(lA > 1e-30f) || !(lB > 1e-30f));
      if (lane == 0) fl[wid] = bad ? 1 : 0; __syncthreads();
      const bool redo = __any(fl[lane & 7] != 0); __syncthreads();
      if (!redo) break; force = true; }
    }
#pragma unroll
    for (int t = 0; t < 2; ++t) {
        if (hi == 0) li_l[r32] = t ? lB : lA; asm volatile("s_waitcnt lgkmcnt(0)" ::: "memory");
        bf16_t* Ow = U.O + (size_t)(wid * 64 + t * 32) * U.ldo;
#pragma unroll
        for (int r = 0; r < 16; ++r) { const int orow = crow(r, hi); const float rl = __builtin_amdgcn_rcpf(li_l[orow]);
#pragma unroll
            for (int d0 = 0; d0 < 2; ++d0) Ow[(size_t)orow * U.ldo + d0 * 32 + r32] = f2bf((t ? oB[d0][r] : oA[d0][r]) * rl); }
        asm volatile("s_waitcnt lgkmcnt(0)" ::: "memory");
    }
    __syncthreads();
#undef SLOAD4
#undef SWRITE4
#undef SOFTMAX4
#undef TILE4
}
}

__device__ __forceinline__ void phase_mla(const Params& p, lds_t* lds, int l) {
    for (int L = bid_(); L < 256; L += gridDim.x) {
        const int u = gridDim.x == 256 ? ((((L & 7) + 8 * ((L >> 3) & 1)) << 4) | (L >> 4)) : L;
        const int qb = u & 15, h = (u >> 4) & 3, b = u >> 6; const int r0 = b * 8192 + qb * 512;
        att::Unit U{}; U.Q = SP(bf16_t, S_QM) + (size_t)r0 * 384 + h * 96; U.NT = 132; U.O = SP(bf16_t, S_CAT) + (size_t)r0 * 1280 + 768 + h * 64;
        U.K = SP(bf16_t, S_KM) + ((size_t)b * 4 + h) * NKEY * 96; U.V = SP(bf16_t, S_VM) + ((size_t)b * 4 + h) * NKEY * 64;
        U.ldq = 384; U.ldk = 96; U.ldv = 64; U.ldo = 1280; U.wv = p.wv;
        att::attn_mla2<96>(U, (char*)lds);
    }
    if (l == 0) for (int c = bid_(); c < 16; c += gridDim.x) {
        const int h = c & 3, b = c >> 2; const int r0 = TL + b * 256;
        att::Unit U{}; U.Q = SP(bf16_t, S_QM) + (size_t)r0 * 384 + h * 96; U.NT = 4; U.n1 = 4; U.k1 = 8192; U.O = SP(bf16_t, S_CAT) + (size_t)r0 * 1280 + 768 + h * 64;
        U.K = SP(bf16_t, S_KM) + ((size_t)b * 4 + h) * NKEY * 96; U.V = SP(bf16_t, S_VM) + ((size_t)b * 4 + h) * NKEY * 64;
        U.ldq = 384; U.ldk = 96; U.ldv = 64; U.ldo = 1280; U.wv = p.wv;
        att::attn_unit<96, false>(U, (char*)lds);
    }
}
__device__ __forceinline__ void phase_win(const Params& p, lds_t* lds, int l) {
    const int nun = 512 + (l == 0 ? 16 : 0);
    for (int u = bid_(); u < nun; u += gridDim.x) {
        att::Unit U{}; int b, h, r0;
        if (u < 512) { const int qb = u & 31; h = (u >> 5) & 3; b = u >> 7; r0 = b * 8192 + qb * 256; const int q0 = qb * 256;
            const int klo = q0 - 128 < 0 ? 0 : q0 - 128, khi = q0 + 384 > 8192 ? 8192 : q0 + 384;
            U.n1 = 4; U.k1 = 8192; U.k2 = klo; U.NT = 4 + (khi - klo) / 64; U.qpos0 = q0; }
        else { h = (u - 512) & 3; b = (u - 512) >> 2; r0 = TL + b * 256; U.n1 = 4; U.k1 = 8192; U.k2 = 0; U.NT = 4; U.qpos0 = 0; }
        U.Q = SP(bf16_t, S_QW) + (size_t)r0 * 256 + h * 64; U.ldq = 256;
        U.K = SP(bf16_t, S_KW) + (size_t)b * NKEY * 128 + (h >> 1) * 64; U.ldk = 128; U.V = SP(bf16_t, S_VW) + (size_t)b * NKEY * 128 + (h >> 1) * 64; U.ldv = 128;
        U.O = SP(bf16_t, S_CAT) + (size_t)r0 * 1280 + 512 + h * 64; U.ldo = 1280; U.sink = p.win_sink[l * 4 + h]; U.has_sink = 1; U.wv = p.wv;
        att::attn_unit<64, true>(U, (char*)lds);
    }
}


namespace sg {
using bf16x8 = __attribute__((ext_vector_type(8))) short;
using s16x4 = __attribute__((ext_vector_type(4))) short;
using f32x16 = __attribute__((ext_vector_type(16))) float;
__device__ __forceinline__ int crow(int r, int hi) { return (r & 3) + 8 * (r >> 2) + 4 * hi; }
__device__ __forceinline__ int b_off(int k, int n8, int NB32) { return ((k >> 3) * NB32 + (n8 >> 2)) * 512 + (k & 7) * 64 + (n8 & 3) * 16; }
__device__ __forceinline__ int tr_lane(int lane, int NB32) { return (((lane & 15) >> 2) * 64) + (((lane >> 4) & 1) * 32) + ((lane & 3) * 8) + (lane >> 5) * NB32 * 512; }
__device__ __forceinline__ s16x4 tr_read(int addr) { s16x4 r; asm volatile("ds_read_b64_tr_b16 %0, %1" : "=&v"(r) : "v"(addr) : "memory"); return r; }
template <int MT, int KS, bool SWAP = false>
__device__ __forceinline__ void mma_block(f32x16 (&acc)[MT][2], const bf16x8 (&af)[MT][KS], int base, int NB32, int nb0) {
#pragma unroll
    for (int ks = 0; ks < KS; ++ks) {
        const int a0 = base + ((2 * ks) * NB32 + nb0) * 512;
        const s16x4 l0 = tr_read(a0), h0 = tr_read(a0 + 256), l1 = tr_read(a0 + 512), h1 = tr_read(a0 + 512 + 256);
        asm volatile("s_waitcnt lgkmcnt(0)" ::: "memory"); __builtin_amdgcn_sched_barrier(0);
        const bf16x8 b0 = (bf16x8){l0[0], l0[1], l0[2], l0[3], h0[0], h0[1], h0[2], h0[3]}, b1 = (bf16x8){l1[0], l1[1], l1[2], l1[3], h1[0], h1[1], h1[2], h1[3]};
#pragma unroll
        for (int mt = 0; mt < MT; ++mt) {
            if constexpr (SWAP) { acc[mt][0] = __builtin_amdgcn_mfma_f32_32x32x16_bf16(b0, af[mt][ks], acc[mt][0], 0, 0, 0); acc[mt][1] = __builtin_amdgcn_mfma_f32_32x32x16_bf16(b1, af[mt][ks], acc[mt][1], 0, 0, 0); }
            else { acc[mt][0] = __builtin_amdgcn_mfma_f32_32x32x16_bf16(af[mt][ks], b0, acc[mt][0], 0, 0, 0); acc[mt][1] = __builtin_amdgcn_mfma_f32_32x32x16_bf16(af[mt][ks], b1, acc[mt][1], 0, 0, 0); } }
    }
}
template <int KR, int NC>
__device__ __forceinline__ void stage_b(char* lds, const bf16_t* src, size_t ld, int tid) {
    constexpr int CH = NC / 8, TOT = KR * CH;
#pragma unroll
    for (int c = tid; c < TOT; c += 512) { const int k = c / CH, n8 = c % CH;
        *(bf16x8*)(lds + b_off(k, n8, NC / 32)) = *(const bf16x8*)(src + (size_t)k * ld + n8 * 8); }
}
}

__device__ __forceinline__ void phase_fft_a(const Params& p, lds_t* lds_) {
    char* lds = (char*)lds_;
    const int tid = tid_(p.wv), w = p.wv, lane = tid & 63, r32 = lane & 31, hi = lane >> 5, kb = w & 3;
    sg::bf16x8 af[2][8];
#pragma unroll
    for (int mt = 0; mt < 2; ++mt)
#pragma unroll
        for (int ks = 0; ks < 8; ++ks) af[mt][ks] = *(const sg::bf16x8*)(WSP(bf16_t, OFF_FA) + (size_t)(kb * 64 + mt * 32 + r32) * 128 + ks * 16 + 8 * hi);
    const int base = (int)(uintptr_t)lds + sg::tr_lane(lane, 4);
    for (int u = bid_(); u < 512; u += gridDim.x) {
        const int b = u >> 7, T = u & 127;
        sg::stage_b<128, 128>(lds, SP(bf16_t, S_ABUF) + (size_t)b * 8192 * 256 + T * 128, 16384, tid);
        __syncthreads();
        sg::f32x16 acc[2][2] = {};
        sg::mma_block<2, 8>(acc, af, base, 4, 2 * (w >> 2));
        const int n2 = T >> 1, cb = (T & 1) * 128 + 64 * (w >> 2) + r32;
#pragma unroll
        for (int r = 0; r < 16; ++r) { const int k1 = kb * 32 + sg::crow(r, hi); const float2 t = WSP(float2, OFF_TW)[n2 * 128 + k1];
            bf16_t* o = SP(bf16_t, S_UP) + ((((size_t)b * 128 + k1) * 2) * 64 + n2) * 256 + cb;
#pragma unroll
            for (int nt = 0; nt < 2; ++nt) { const float ur = acc[0][nt][r], ui = acc[1][nt][r]; o[nt * 32] = f2bf(ur * t.x + ui * t.y); o[64 * 256 + nt * 32] = f2bf(ui * t.x - ur * t.y); } }
        __syncthreads();
    }
}
__device__ __forceinline__ void phase_fft_c(const Params& p, lds_t* lds_) {
    char* lds = (char*)lds_;
    const int tid = tid_(p.wv), w = p.wv, lane = tid & 63, r32 = lane & 31, hi = lane >> 5, rio = w & 1;
    sg::bf16x8 af[2][8];
#pragma unroll
    for (int mt = 0; mt < 2; ++mt)
#pragma unroll
        for (int ks = 0; ks < 8; ++ks) af[mt][ks] = *(const sg::bf16x8*)(WSP(bf16_t, OFF_GM) + (size_t)(rio * 64 + mt * 32 + r32) * 128 + ks * 16 + 8 * hi);
    const int base = (int)(uintptr_t)lds + sg::tr_lane(lane, 8);
    for (int u = bid_(); u < 512; u += gridDim.x) {
        const int b = u >> 7, k1 = u & 127;
        sg::stage_b<128, 256>(lds, SP(bf16_t, S_UP) + (size_t)u * 128 * 256, 256, tid);
        __syncthreads();
        sg::f32x16 acc[2][2] = {};
        sg::mma_block<2, 8>(acc, af, base, 8, 2 * (w >> 1));
#pragma unroll
        for (int mt = 0; mt < 2; ++mt)
#pragma unroll
            for (int r = 0; r < 16; ++r) { const int k2 = mt * 32 + sg::crow(r, hi);
                bf16_t* o = SP(bf16_t, S_CAT) + ((size_t)b * 8192 + k1 + 128 * k2) * 1280 + rio * 256 + 64 * (w >> 1) + r32;
                o[0] = f2bf(acc[mt][0][r]); o[32] = f2bf(acc[mt][1][r]); }
        __syncthreads();
    }
}
__device__ __forceinline__ void phase_dft_ctx(const Params& p, lds_t* lds_) {
    char* lds = (char*)lds_;
    const int tid = tid_(p.wv), w = p.wv, lane = tid & 63, r32 = lane & 31, hi = lane >> 5;
    const int base = (int)(uintptr_t)lds + sg::tr_lane(lane, 4);
    for (int u = (int)gridDim.x - 64 - bid_(); u < 32; u += gridDim.x) { if (u < 0) continue;
        const int b = u >> 3, mb = (u >> 1) & 3, nh = u & 1;
        sg::bf16x8 af[1][16];
#pragma unroll
        for (int ks = 0; ks < 16; ++ks) af[0][ks] = *(const sg::bf16x8*)(WSP(bf16_t, OFF_FC) + (size_t)(mb * 128 + 32 * (w & 3) + r32) * 256 + ks * 16 + 8 * hi);
        sg::stage_b<256, 128>(lds, SP(bf16_t, S_ABUF) + ((size_t)TL + b * 256) * 256 + nh * 128, 256, tid);
        __syncthreads();
        sg::f32x16 acc[1][2] = {};
        sg::mma_block<1, 16>(acc, af, base, 4, 2 * (w >> 2));
#pragma unroll
        for (int r = 0; r < 16; ++r) { const int row = mb * 128 + 32 * (w & 3) + sg::crow(r, hi), ri = row >> 8, k = row & 255;
            bf16_t* o = SP(bf16_t, S_CAT) + ((size_t)TL + b * 256 + k) * 1280 + ri * 256 + nh * 128 + 64 * (w >> 2) + r32;
            o[0] = f2bf(acc[0][0][r]); o[32] = f2bf(acc[0][1][r]); }
        __syncthreads();
    }
}
__device__ __forceinline__ void phase_sgu(const Params& p, lds_t* lds_, int l) {
    char* lds = (char*)lds_;
    const int tid = tid_(p.wv), w = p.wv, lane = tid & 63, r32 = lane & 31, hi = lane >> 5, g = w >> 1, mh = w & 1;
    sg::bf16x8 af[2][8];
#pragma unroll
    for (int mt = 0; mt < 2; ++mt)
#pragma unroll
        for (int ks = 0; ks < 8; ++ks) { const float* src = p.sgu_w + ((size_t)(l * 4 + g) * 128 + mh * 64 + mt * 32 + r32) * 128 + ks * 16 + 8 * hi;
            const float4 a = *(const float4*)src, b = *(const float4*)(src + 4); const float v[8] = {a.x, a.y, a.z, a.w, b.x, b.y, b.z, b.w}; const pg8::u32x4 pk = pack8(v); af[mt][ks] = *(const sg::bf16x8*)&pk; }
    const int base = (int)(uintptr_t)lds + sg::tr_lane(lane, 8);
    const int nch = l == 0 ? RR / 128 : TL / 128;
    for (int u = (int)gridDim.x - 1 - bid_(); u < nch; u += gridDim.x) {
        const int r0 = u * 128;
#pragma unroll
        for (int c = tid; c < 128 * 32; c += 512) { const int q = c >> 5, n8 = c & 31;
            const float* st = WSP(float, OFF_LNS) + (size_t)(r0 + q) * 8; const float4 sa = *(const float4*)st, sb = *(const float4*)(st + 4);
            const float s1 = (sa.x + sa.z) + (sb.x + sb.z), s2 = (sa.y + sa.w) + (sb.y + sb.w), mu = s1 * (1.f / 256.f), rstd = rsqrtf(fmaxf(s2 * (1.f / 256.f) - mu * mu, 0.f) + EPS);
            const pg8::u32x4 raw = *(const pg8::u32x4*)(SP(bf16_t, S_VG) + (size_t)(r0 + q) * 256 + n8 * 8); float v[8];
#pragma unroll
            for (int e = 0; e < 4; ++e) { v[2 * e] = (__uint_as_float(raw[e] << 16) - mu) * rstd; v[2 * e + 1] = (__uint_as_float(raw[e] & 0xffff0000u) - mu) * rstd; }
            *(pg8::u32x4*)(lds + sg::b_off(q, n8, 8)) = pack8(v); }
        __syncthreads();
        sg::f32x16 acc[2][2] = {};
        sg::mma_block<2, 8, true>(acc, af, base, 8, 2 * g);
        bf16_t* simg = (bf16_t*)(lds + 65536);
#pragma unroll
        for (int mt = 0; mt < 2; ++mt) { const int pp = mh * 64 + mt * 32 + r32; const float bias = p.sgu_b[(l * 4 + g) * 128 + pp];
#pragma unroll
            for (int nt = 0; nt < 2; ++nt)
#pragma unroll
                for (int t4 = 0; t4 < 4; ++t4) { pg8::u32x2 w; w.x = pg8::cvt_pk_bf16(acc[mt][nt][4 * t4] + bias, acc[mt][nt][4 * t4 + 1] + bias); w.y = pg8::cvt_pk_bf16(acc[mt][nt][4 * t4 + 2] + bias, acc[mt][nt][4 * t4 + 3] + bias);
                    *(pg8::u32x2*)(simg + pp * 256 + g * 64 + nt * 32 + 8 * t4 + 4 * hi) = w; } }
        __syncthreads();
#pragma unroll
        for (int c = tid; c < 128 * 32; c += 512) { const int pp = c >> 5, n8 = c & 31; const size_t row = (size_t)r0 + pp;
            const pg8::u32x4 sv = *(const pg8::u32x4*)(simg + pp * 256 + n8 * 8), uv = *(const pg8::u32x4*)(SP(bf16_t, S_U) + row * 256 + n8 * 8); float v[8];
#pragma unroll
            for (int e = 0; e < 4; ++e) { v[2 * e] = __uint_as_float(sv[e] << 16) * __uint_as_float(uv[e] << 16); v[2 * e + 1] = __uint_as_float(sv[e] & 0xffff0000u) * __uint_as_float(uv[e] & 0xffff0000u); }
            *(pg8::u32x4*)(SP(bf16_t, S_CAT) + row * 1280 + 1024 + n8 * 8) = pack8(v); }
    }
    __syncthreads();
}
enum { PH_CVT = 0, PH_FFN_GU, PH_FFN_DN, PH_MOE_GU, PH_MOE_DN, PH_INPROJ, PH_UP, PH_OUTPROJ, PH_MLA, PH_WIN, PH_FFTA, PH_FFTC, PH_DFTC, PH_SGU, PH_PROA, PH_PROB, PH_NORM1, PH_POSTMIX, PH_ASSIGN, PH_POSTFFN };

__device__ __forceinline__ float wave_sum(float v) {
    const int l4 = lane_() << 2;
#pragma unroll
    for (int o = 32; o > 0; o >>= 1) v += __int_as_float(__builtin_amdgcn_ds_bpermute(l4 ^ (o << 2), __float_as_int(v)));
    return v;
}
__device__ __forceinline__ const float* hx_in_row(const Params& p, int l, int r) {
    if (l == 0) return r < TL ? p.x + (size_t)r * 1024 : p.ctx + (size_t)(r - TL) * 1024;
    return r < TL ? p.out + (size_t)r * 1024 : WSP(float, OFF_HXC) + (size_t)(r - TL) * 1024;
}
__device__ __forceinline__ float* hx_row(const Params& p, int r) { return r < TL ? p.out + (size_t)r * 1024 : WSP(float, OFF_HXC) + (size_t)(r - TL) * 1024; }
__device__ __forceinline__ void store4bf(bf16_t* dst, const float4 v) { pg8::u32x2 w; w.x = pg8::cvt_pk_bf16(v.x, v.y); w.y = pg8::cvt_pk_bf16(v.z, v.w); *(pg8::u32x2*)dst = w; }
__device__ __forceinline__ float4 load4bf(const bf16_t* src) { const pg8::u32x2 w = *(const pg8::u32x2*)src; return make_float4(__uint_as_float(w.x << 16), __uint_as_float(w.x & 0xffff0000u), __uint_as_float(w.y << 16), __uint_as_float(w.y & 0xffff0000u)); }
__device__ __forceinline__ float4 hx_load4(const Params& p, int kind, int r, int k) {
    if (kind == 0) return *(const float4*)((r < TL ? p.x + (size_t)r * 1024 : p.ctx + (size_t)(r - TL) * 1024) + k);
    if (r < TL) return load4bf((const bf16_t*)((const char*)p.out + (size_t)r * 4096 + 2048) + k);
    return *(const float4*)(WSP(float, OFF_HXC) + (size_t)(r - TL) * 1024 + k);
}
__device__ __forceinline__ void hx_store4(const Params& p, int r, int k, const float4 v) {
    if (r < TL) store4bf((bf16_t*)((char*)p.out + (size_t)r * 4096 + 2048) + k, v);
    else *(float4*)(WSP(float, OFF_HXC) + (size_t)(r - TL) * 1024 + k) = v;
}
#define F4OP(dst, expr) do { (dst).x = (expr(x)); (dst).y = (expr(y)); (dst).z = (expr(z)); (dst).w = (expr(w)); } while (0)
__device__ __forceinline__ float half_sum(float v) {
    const int l4 = lane_() << 2;
#pragma unroll
    for (int o = 16; o > 0; o >>= 1) v += __int_as_float(__builtin_amdgcn_ds_bpermute(l4 ^ (o << 2), __float_as_int(v)));
    return v;
}
__device__ __forceinline__ float qsum(float v) {
    const int l4 = lane_() << 2;
#pragma unroll
    for (int o = 8; o > 0; o >>= 1) v += __int_as_float(__builtin_amdgcn_ds_bpermute(l4 ^ (o << 2), __float_as_int(v)));
    return v;
}
#define SQ4(v) ((v).x * (v).x + (v).y * (v).y + (v).z * (v).z + (v).w * (v).w)
struct V8 { float v[8]; };
__device__ __forceinline__ V8 ld8_f32(const float* q) { const float4 a = *(const float4*)q, b = *(const float4*)(q + 4); return V8{{a.x, a.y, a.z, a.w, b.x, b.y, b.z, b.w}}; }
__device__ __forceinline__ V8 ld8_bf16(const bf16_t* q) { const pg8::u32x4 w = *(const pg8::u32x4*)q; V8 r;
#pragma unroll
    for (int e = 0; e < 4; ++e) { r.v[2 * e] = __uint_as_float(w[e] << 16); r.v[2 * e + 1] = __uint_as_float(w[e] & 0xffff0000u); } return r; }
__device__ __forceinline__ void st8_bf16(bf16_t* q, const V8& a) { *(pg8::u32x4*)q = pack8(a.v); }
__device__ __forceinline__ void st8_f32nt(float* q, const V8& a) { __builtin_nontemporal_store((pg8::f32x4){a.v[0], a.v[1], a.v[2], a.v[3]}, (pg8::f32x4*)q); __builtin_nontemporal_store((pg8::f32x4){a.v[4], a.v[5], a.v[6], a.v[7]}, (pg8::f32x4*)(q + 4)); }
__device__ __forceinline__ void st8_fp8(unsigned char* q, const V8& a) { pg8::u32x2 w; w.x = fp8x4(clamp448(a.v[0]), clamp448(a.v[1]), clamp448(a.v[2]), clamp448(a.v[3])); w.y = fp8x4(clamp448(a.v[4]), clamp448(a.v[5]), clamp448(a.v[6]), clamp448(a.v[7])); *(pg8::u32x2*)q = w; }
__device__ __forceinline__ float sq8(const V8& a) { float s = 0;
#pragma unroll
    for (int e = 0; e < 8; ++e) s += a.v[e] * a.v[e]; return s; }
__device__ __forceinline__ V8 hx_load8(const Params& p, int kind, int r, int k) {
    if (kind == 0) return ld8_f32((r < TL ? p.x + (size_t)r * 1024 : p.ctx + (size_t)(r - TL) * 1024) + k);
    if (r < TL) return ld8_bf16((const bf16_t*)((const char*)p.out + (size_t)r * 4096 + 2048) + k);
    return ld8_f32(WSP(float, OFF_HXC) + (size_t)(r - TL) * 1024 + k);
}
__device__ __forceinline__ void hx_store8(const Params& p, int r, int k, const V8& a) {
    if (r < TL) st8_bf16((bf16_t*)((char*)p.out + (size_t)r * 4096 + 2048) + k, a);
    else { *(float4*)(WSP(float, OFF_HXC) + (size_t)(r - TL) * 1024 + k) = make_float4(a.v[0], a.v[1], a.v[2], a.v[3]); *(float4*)(WSP(float, OFF_HXC) + (size_t)(r - TL) * 1024 + k + 4) = make_float4(a.v[4], a.v[5], a.v[6], a.v[7]); }
}
typedef __attribute__((address_space(3))) float lds_fl;
__device__ __forceinline__ V8 lds8(const lds_fl* q) { const pg8::f32x4 a = *(const __attribute__((address_space(3))) pg8::f32x4*)q, b = *(const __attribute__((address_space(3))) pg8::f32x4*)(q + 4); return V8{{a[0], a[1], a[2], a[3], b[0], b[1], b[2], b[3]}}; }
constexpr int EW_PAR_OFF = 49152;
__device__ __forceinline__ int seg_end(int r0, int rend) { const int nb = r0 < TL ? ((((r0 >> 13) + 1) << 13) < TL ? (((r0 >> 13) + 1) << 13) : TL) : RR; return nb < rend ? nb : rend; }
__device__ __forceinline__ void phase_norm1(const Params& p, lds_t* lds, int l) {
    const int tid = tid_(p.wv), lane = tid & 63, sl0 = lane & 15, q = p.wv * 4 + (lane >> 4), G = gridDim.x, RPB = (RR + G - 1) / G;
    lds_fl* par = (lds_fl*)(lds + EW_PAR_OFF);
    const int rbeg = bid_() * RPB, rend = rbeg + RPB < RR ? rbeg + RPB : RR;
    for (int r0 = rbeg; r0 < rend;) { const int r1 = seg_end(r0, rend); const float* mod = WSP(float, OFF_MOD) + ((size_t)l * 5 + row_cond(r0)) * 6144;
        __syncthreads();
        for (int i = tid; i < 1024; i += 512) { par[i] = p.g_pre_mix[l * 1024 + i]; par[1024 + i] = 1.f + mod[1024 + i]; par[2048 + i] = mod[i]; }
        __syncthreads();
        for (int rw = r0 + p.wv * 4; rw < r1; rw += 32) {
            int sl = sl0; asm volatile("" : "+v"(sl));
            const int rr = rw + (lane >> 4); const bool ok = rr < r1; const int r = ok ? rr : r0;
            V8 v[8]; float ss = 0;
#pragma unroll
            for (int i = 0; i < 8; ++i) { v[i] = hx_load8(p, l == 0 ? 0 : 1, r, sl * 8 + 128 * i); ss += sq8(v[i]); }
            const float rstd = rsqrtf(qsum(ss) * (1.f / 1024.f) + EPS);
#pragma unroll
            for (int i = 0; i < 8; ++i) { const int k = sl * 8 + 128 * i; const V8 gg = lds8(par + k), sc = lds8(par + 1024 + k), sh = lds8(par + 2048 + k); V8 y;
#pragma unroll
                for (int e = 0; e < 8; ++e) y.v[e] = v[i].v[e] * rstd * gg.v[e] * sc.v[e] + sh.v[e];
                if (ok) st8_bf16(WSP(bf16_t, OFF_XN) + (size_t)r * 1024 + k, y); }
        }
        r0 = r1; }
    __syncthreads(); (void)q;
}
__device__ __forceinline__ void phase_postmix(const Params& p, lds_t* lds, int l) {
    const int tid = tid_(p.wv), lane = tid & 63, sl0 = lane & 15, G = gridDim.x, g = (bid_() * 8 + p.wv) * 4 + (lane >> 4);
    const int nrows = l == 0 ? RR : TL, RPB = (nrows + G - 1) / G;
    if (l == 1) for (int i = bid_() * 512 + tid; i < NSORT; i += G * 512) WSP(int, OFF_ROWIDX)[i] = 0;
    int wcnt[8] = {0, 0, 0, 0, 0, 0, 0, 0};
    typedef __attribute__((address_space(3))) pg8::f32x4 lds_f4;
    const lds_f4* wrl = (const lds_f4*)lds;
    lds_fl* par = (lds_fl*)(lds + EW_PAR_OFF);
    if (l == 1) { for (int i = tid; i < 2048; i += 512) ((lds_f4*)lds)[i] = ((const pg8::f32x4*)p.moe_w_router)[i]; }
    const int rbeg = bid_() * RPB, rend = rbeg + RPB < nrows ? rbeg + RPB : nrows;
    for (int r0 = rbeg; r0 < rend;) { const int r1 = seg_end(r0, rend); const float* mod = WSP(float, OFF_MOD) + ((size_t)l * 5 + row_cond(r0)) * 6144;
        __syncthreads();
        for (int i = tid; i < 1024; i += 512) { par[i] = p.g_post_mix[l * 1024 + i] * mod[2048 + i]; par[1024 + i] = p.g_pre_ffn[l * 1024 + i] * (1.f + mod[4096 + i]); par[2048 + i] = mod[3072 + i]; }
        __syncthreads();
        for (int rw = r0 + p.wv * 4; rw < r1; rw += 32) {
            int sl = sl0; asm volatile("" : "+v"(sl));
            const int rr = rw + (lane >> 4); const bool ok = rr < r1; const int r = ok ? rr : r0;
            pg8::u32x4 mp[8]; V8 hv[8]; float ss = 0;
#pragma unroll
            for (int i = 0; i < 8; ++i) mp[i] = *(const pg8::u32x4*)(SP(bf16_t, S_MX) + (size_t)r * 1024 + sl * 8 + 128 * i);
#pragma unroll
            for (int i = 0; i < 8; ++i) hv[i] = hx_load8(p, l == 0 ? 0 : 1, r, sl * 8 + 128 * i);
#pragma unroll
            for (int i = 0; i < 8; ++i)
#pragma unroll
                for (int e = 0; e < 4; ++e) { const float a_ = __uint_as_float(mp[i][e] << 16), b_ = __uint_as_float(mp[i][e] & 0xffff0000u); ss += a_ * a_ + b_ * b_; }
            const float rstd = rsqrtf(qsum(ss) * (1.f / 1024.f) + EPS); float s2 = 0;
#pragma unroll
            for (int i = 0; i < 8; ++i) { const int k = sl * 8 + 128 * i; const V8 gg = lds8(par + k);
#pragma unroll
                for (int e = 0; e < 4; ++e) { hv[i].v[2 * e] += gg.v[2 * e] * (__uint_as_float(mp[i][e] << 16) * rstd); hv[i].v[2 * e + 1] += gg.v[2 * e + 1] * (__uint_as_float(mp[i][e] & 0xffff0000u) * rstd); }
                if (ok) hx_store8(p, r, k, hv[i]);
                s2 += sq8(hv[i]); }
            const float rstd2 = rsqrtf(qsum(s2) * (1.f / 1024.f) + EPS);
            float lg[8] = {0, 0, 0, 0, 0, 0, 0, 0};
#pragma unroll
            for (int i = 0; i < 8; ++i) { const int k = sl * 8 + 128 * i; const V8 gg = lds8(par + 1024 + k), sh = lds8(par + 2048 + k); V8 fx;
#pragma unroll
                for (int e = 0; e < 8; ++e) fx.v[e] = hv[i].v[e] * rstd2 * gg.v[e] + sh.v[e];
                if (ok) { if (l == 1 || DENSE_FP8 == 1) st8_fp8((unsigned char*)WSP(bf16_t, OFF_XN) + (size_t)r * 1024 + k, fx); else st8_bf16(WSP(bf16_t, OFF_XN) + (size_t)r * 1024 + k, fx); }
                hv[i] = fx; }
            if (l == 1) {
#pragma unroll
                for (int i = 0; i < 8; ++i) { const lds_f4* wr = wrl + (sl * 8 + 128 * i) * 2;
#pragma unroll
                    for (int e = 0; e < 8; ++e) { const float f = hv[i].v[e]; const pg8::f32x4 wa = wr[e * 2], wb = wr[e * 2 + 1];
                        lg[0] += f * wa[0]; lg[1] += f * wa[1]; lg[2] += f * wa[2]; lg[3] += f * wa[3]; lg[4] += f * wb[0]; lg[5] += f * wb[1]; lg[6] += f * wb[2]; lg[7] += f * wb[3]; } }
#pragma unroll
                for (int e = 0; e < 8; ++e) lg[e] = qsum(lg[e]);
                int e0 = 0; float v0 = lg[0];
#pragma unroll
                for (int e = 1; e < 8; ++e) if (lg[e] > v0) { v0 = lg[e]; e0 = e; }
                int e1 = -1; float v1 = -3.0e38f;
#pragma unroll
                for (int e = 0; e < 8; ++e) if (e != e0 && lg[e] > v1) { v1 = lg[e]; e1 = e; }
                if (ok) {
#pragma unroll
                    for (int e = 0; e < 8; ++e) wcnt[e] += (e0 == e) + (e1 == e);
                    if (sl == 0) { const float w1 = __expf(v1 - v0), inv = 1.f / (1.f + w1);
                        WSP(int, OFF_TOKE)[r * 2] = e0; WSP(int, OFF_TOKE)[r * 2 + 1] = e1; WSP(float, OFF_TOKW)[r * 2] = inv; WSP(float, OFF_TOKW)[r * 2 + 1] = w1 * inv; } }
            }
        }
        r0 = r1; }
    if (l == 1) {
        __syncthreads();
        int* lc = (int*)(lds + 40960);
        if (sl0 == 0) { int4* dst = (int4*)(WSP(int, OFF_LNS) + (size_t)g * 8); dst[0] = make_int4(wcnt[0], wcnt[1], wcnt[2], wcnt[3]); dst[1] = make_int4(wcnt[4], wcnt[5], wcnt[6], wcnt[7]);
            const int o_ = p.wv * 4 + (lane >> 4);
#pragma unroll
            for (int e = 0; e < 8; ++e) lc[o_ * 8 + e] = wcnt[e]; }
        __syncthreads();
        if (tid < 8) { int t_ = 0;
#pragma unroll
            for (int o_ = 0; o_ < 32; ++o_) t_ += lc[o_ * 8 + tid];
            WSP(int, OFF_LNS)[(size_t)G * 32 * 8 + bid_() * 8 + tid] = t_; }
    }
    __syncthreads();
}
__device__ __forceinline__ void phase_moe_assign(const Params& p) {
    const int tid = tid_(p.wv), lane = tid & 63, gw = bid_() * 8 + p.wv, nown = gridDim.x * 32;
    const int* cntW = WSP(int, OFF_LNS); const int* cntB = cntW + (size_t)gridDim.x * 32 * 8;
    int tot[8] = {0, 0, 0, 0, 0, 0, 0, 0}, pre[8] = {0, 0, 0, 0, 0, 0, 0, 0};
    const int myb = bid_();
    for (int b = lane; b < (int)gridDim.x; b += 64) { const int4 a = *(const int4*)(cntB + (size_t)b * 8), c4 = *(const int4*)(cntB + (size_t)b * 8 + 4); const int c[8] = {a.x, a.y, a.z, a.w, c4.x, c4.y, c4.z, c4.w}; const int m = b < myb ? 1 : 0;
#pragma unroll
        for (int e = 0; e < 8; ++e) { tot[e] += c[e]; pre[e] += m * c[e]; } }
    if (lane < 32) { const int go = myb * 32 + lane; const int4 a = *(const int4*)(cntW + (size_t)go * 8), c4 = *(const int4*)(cntW + (size_t)go * 8 + 4); const int c[8] = {a.x, a.y, a.z, a.w, c4.x, c4.y, c4.z, c4.w}; const int m = go < 4 * gw ? 1 : 0;
#pragma unroll
        for (int e = 0; e < 8; ++e) pre[e] += m * c[e]; }
#pragma unroll
    for (int e = 0; e < 8; ++e)
#pragma unroll
        for (int o = 32; o > 0; o >>= 1) { tot[e] += __builtin_amdgcn_ds_bpermute((lane << 2) ^ (o << 2), tot[e]); pre[e] += __builtin_amdgcn_ds_bpermute((lane << 2) ^ (o << 2), pre[e]); }
    int off[9]; { int o = 0;
#pragma unroll
        for (int e = 0; e < 8; ++e) { off[e] = o; o += ((tot[e] + 255) >> 8) << 8; } off[8] = o; }
    int* cw = (int*)p.ws;
    if (gw == 0 && lane == 0) cw[CW_NT] = off[8] >> 8;
    for (int t = bid_() * 512 + tid; t < 272; t += gridDim.x * 512) { int e = 0;
#pragma unroll
        for (int q = 1; q < 8; ++q) if (t * 256 >= off[q]) e = q;
        WSP(int, OFF_TILEE)[t] = e; }
    int base[8];
#pragma unroll
    for (int e = 0; e < 8; ++e) base[e] = off[e] + pre[e];
    const int j = lane & 15, G = gridDim.x, RPB = (TL + G - 1) / G, rbeg = bid_() * RPB, rend = rbeg + RPB < TL ? rbeg + RPB : TL;
    const unsigned char* xn8 = (const unsigned char*)WSP(bf16_t, OFF_XN); unsigned char* xs8 = (unsigned char*)SP(bf16_t, S_YS);
    for (int r0 = rbeg; r0 < rend;) { const int r1 = seg_end(r0, rend);
        for (int k0 = 0; r0 + p.wv * 4 + 32 * k0 < r1; k0 += 8) {
            const int r = r0 + p.wv * 4 + (lane >> 4) + 32 * (k0 + (j >> 1)); const bool ok = r < r1;
            const int e = ok ? WSP(int, OFF_TOKE)[r * 2 + (j & 1)] : -1; int pos = 0;
#pragma unroll
            for (int q = 0; q < 8; ++q) { const unsigned long long mk = __ballot(e == q); if (e == q) pos = base[q] + __popcll(mk & ((1ull << lane) - 1ull)); base[q] += __popcll(mk); }
            if (ok) { WSP(int, OFF_ROWIDX)[pos] = r; WSP(int, OFF_TOKS)[r * 2 + (j & 1)] = pos; }
#pragma unroll
            for (int q = 0; q < 64; ++q) { const int rq = __builtin_amdgcn_readlane(r, q), pq = __builtin_amdgcn_readlane(pos, q), okq = __builtin_amdgcn_readlane((int)ok, q);
                if (okq) *(uint4*)(xs8 + (size_t)pq * 1024 + lane * 16) = *(const uint4*)(xn8 + (size_t)rq * 1024 + lane * 16); }
        }
        r0 = r1; }
}
__device__ __forceinline__ void phase_postffn(const Params& p, lds_t* lds, int l) {
    const int tid = tid_(p.wv), lane = tid & 63, sl0 = lane & 15, G = gridDim.x;
    const int nrows = l == 0 ? RR : TL, RPB = (nrows + G - 1) / G;
    lds_fl* par = (lds_fl*)(lds + EW_PAR_OFF);
    const int rbeg = bid_() * RPB, rend = rbeg + RPB < nrows ? rbeg + RPB : nrows;
    for (int r0 = rbeg; r0 < rend;) { const int r1 = seg_end(r0, rend); const float* mod = WSP(float, OFF_MOD) + ((size_t)l * 5 + row_cond(r0)) * 6144; const float* mod1 = WSP(float, OFF_MOD) + ((size_t)5 + row_cond(r0)) * 6144;
        __syncthreads();
        for (int i = tid; i < 1024; i += 512) { par[i] = p.g_post_ffn[l * 1024 + i] * mod[5120 + i]; if (l == 0) { par[1024 + i] = p.g_pre_mix[1024 + i] * (1.f + mod1[1024 + i]); par[2048 + i] = mod1[i]; } }
        __syncthreads();
        for (int rw = r0 + p.wv * 4; rw < r1; rw += 32) {
            int sl = sl0; asm volatile("" : "+v"(sl));
            const int rr = rw + (lane >> 4); const bool ok = rr < r1; const int r = ok ? rr : r0;
            V8 y[8], hv[8]; float ss = 0;
            if (l == 0) {
#pragma unroll
                for (int i = 0; i < 8; ++i) y[i] = ld8_bf16(WSP(bf16_t, OFF_XN) + (size_t)r * 1024 + sl * 8 + 128 * i);
#pragma unroll
                for (int i = 0; i < 8; ++i) hv[i] = hx_load8(p, 1, r, sl * 8 + 128 * i);
            } else { const bf16_t* y0 = ys_row(p, WSP(int, OFF_TOKS)[r * 2]); const bf16_t* y1 = ys_row(p, WSP(int, OFF_TOKS)[r * 2 + 1]); const float w0 = WSP(float, OFF_TOKW)[r * 2], w1 = WSP(float, OFF_TOKW)[r * 2 + 1];
                pg8::u32x4 ya[8], yb[8];
#pragma unroll
                for (int i = 0; i < 8; ++i) { ya[i] = *(const pg8::u32x4*)(y0 + sl * 8 + 128 * i); yb[i] = *(const pg8::u32x4*)(y1 + sl * 8 + 128 * i); }
#pragma unroll
                for (int i = 0; i < 8; ++i) hv[i] = hx_load8(p, 1, r, sl * 8 + 128 * i);
#pragma unroll
                for (int i = 0; i < 8; ++i)
#pragma unroll
                    for (int e = 0; e < 4; ++e) { y[i].v[2 * e] = w0 * __uint_as_float(ya[i][e] << 16) + w1 * __uint_as_float(yb[i][e] << 16); y[i].v[2 * e + 1] = w0 * __uint_as_float(ya[i][e] & 0xffff0000u) + w1 * __uint_as_float(yb[i][e] & 0xffff0000u); } }
#pragma unroll
            for (int i = 0; i < 8; ++i) ss += sq8(y[i]);
            const float rstd = rsqrtf(qsum(ss) * (1.f / 1024.f) + EPS); float s2 = 0;
#pragma unroll
            for (int i = 0; i < 8; ++i) { const int k = sl * 8 + 128 * i; const V8 gg = lds8(par + k);
#pragma unroll
                for (int e = 0; e < 8; ++e) hv[i].v[e] += gg.v[e] * (y[i].v[e] * rstd);
                if (l == 0 && ok) hx_store8(p, r, k, hv[i]); s2 += sq8(hv[i]); }
            if (l == 1) {
                asm volatile("s_waitcnt vmcnt(0)" ::: "memory");
                if (ok) {
#pragma unroll
                    for (int i = 0; i < 8; ++i) st8_f32nt(p.out + (size_t)r * 1024 + sl * 8 + 128 * i, hv[i]); } }
            if (l == 0) { const float rstd2 = rsqrtf(qsum(s2) * (1.f / 1024.f) + EPS);
#pragma unroll
                for (int i = 0; i < 8; ++i) { const int k = sl * 8 + 128 * i; const V8 gg = lds8(par + 1024 + k), sh = lds8(par + 2048 + k); V8 v;
#pragma unroll
                    for (int e = 0; e < 8; ++e) v.v[e] = hv[i].v[e] * rstd2 * gg.v[e] + sh.v[e];
                    if (ok) st8_bf16(WSP(bf16_t, OFF_XN) + (size_t)r * 1024 + k, v); } }
        }
        r0 = r1; }
    __syncthreads();
}
constexpr size_t S_MODP = 0;
__device__ __forceinline__ void phase_pro_a(const Params& p, lds_t* lds) {
    const int gt = bid_() * 512 + tid_(p.wv), ng = gridDim.x * 512;
    const double PI2 = 6.283185307179586476925;
    for (int i = gt; i < 8192; i += ng) {
        if (i < 128 * 16) { const int co = i >> 4, j = i & 15; const double a = (double)co * pow(10000.0, -(double)j / 16.0); WSP(float2, OFF_ROPEW)[i] = make_float2((float)cos(a), (float)sin(a)); }
        if (i < 128 * 8) { const int co = i >> 3, j = i & 7; const double a = (double)co * pow(10000.0, -(double)j / 8.0); WSP(float2, OFF_ROPEM)[i] = make_float2((float)cos(a), (float)sin(a)); }
        if (i < 64 * 128) { const int n2 = i >> 7, k1 = i & 127; const double a = PI2 * (double)(k1 * n2) / 8192.0; WSP(float2, OFF_TW)[i] = make_float2((float)cos(a), (float)sin(a)); }
    }
    for (int i = gt; i < 512 * 256; i += ng) {
        if (i < 256 * 128) { const int m = i >> 7, n1 = i & 127, kb = m >> 6, ri = (m >> 5) & 1, k1 = kb * 32 + (m & 31); float sn, cs; sincospif((float)((k1 * n1) & 127) * (1.f / 64.f), &sn, &cs);
            WSP(bf16_t, OFF_FA)[i] = f2bf((ri ? -sn : cs) * (1.f / 724.0773439350247f)); }
        if (i < 128 * 128) { const int m = i >> 7, kc = i & 127, rio = m >> 6, k2 = m & 63, rii = kc >> 6, n2 = kc & 63; float sn, cs; sincospif((float)((n2 * k2) & 63) * (1.f / 32.f), &sn, &cs);
            WSP(bf16_t, OFF_GM)[i] = f2bf(rio == rii ? cs : (rio == 0 ? sn : -sn)); }
        { const int row = i >> 8, n = i & 255, ri = row >> 8, k = row & 255; float sn, cs; sincospif((float)((k * n) & 255) * (1.f / 128.f), &sn, &cs);
            WSP(bf16_t, OFF_FC)[i] = f2bf((ri ? -sn : cs) * (1.f / 128.f)); }
    }
    { const int t = tid_(p.wv); float2* trig = (float2*)lds;
      if (t < 64) { float sn, cs; sincospif((float)t * (1.f / 32.f), &sn, &cs); trig[t] = make_float2(cs, sn); }
      __syncthreads();
      for (int i = gt; i < 2 * 512 * 256; i += ng) { const int j = i & 255, row = (i >> 8) & 511, l = i >> 17, ri = row >> 8, g = (row >> 6) & 3, c = row & 63; float acc = 0;
#pragma unroll 8
        for (int cp = 0; cp < 64; ++cp) { const float2 tv = trig[(c * cp) & 63]; acc += (ri ? tv.y : tv.x) * p.w_fourier[(size_t)l * 65536 + (g * 64 + cp) * 256 + j]; }
        WSP(float, OFF_M12)[i] = acc; }
      __syncthreads(); }
    { const int t = tid_(p.wv), w = p.wv, lane = t & 63; float* sil = (float*)lds  , *red = (float*)lds + 5 * 1024;
      if (bid_() < 2 * 96) { for (int i = t; i < 5 * 1024; i += 512) { const int k = i / 5, r = i % 5; sil[i] = silu_f(r < 4 ? p.c[r * 1024 + k] : p.c_ctx[k]); } }
      __syncthreads();
      for (int it = bid_(); it < 2 * 96; it += gridDim.x) { const int l = it / 96, n = (it % 96) * 64 + lane; const float* W = p.w_mod + (size_t)l * 1024 * 6144 + n;
        float acc[5] = {0, 0, 0, 0, 0};
#pragma unroll 8
        for (int kk = 0; kk < 128; ++kk) { const int k = w * 128 + kk; const float wv = W[(size_t)k * 6144];
#pragma unroll
            for (int r = 0; r < 5; ++r) acc[r] += sil[k * 5 + r] * wv; }
        __syncthreads();
#pragma unroll
        for (int r = 0; r < 5; ++r) red[(w * 5 + r) * 64 + lane] = acc[r];
        __syncthreads();
        if (t < 320) { const int r = t >> 6; float a = p.b_mod[l * 6144 + n];
#pragma unroll
            for (int ww = 0; ww < 8; ++ww) a += red[(ww * 5 + r) * 64 + lane];
            WSP(float, OFF_MOD)[((size_t)l * 5 + r) * 6144 + n] = a; } }
      __syncthreads(); }
    phase_cvt(p, lds, 0, gridDim.x == 256 ? CVT_MOE0 : CVT_TOT, bid_(), gridDim.x);
}
__device__ __forceinline__ void phase_pro_b(const Params& p, lds_t* lds) {
    const int tid = tid_(p.wv), hk = tid >> 8, o4 = (tid & 255) * 4;
    typedef __attribute__((address_space(3))) float lds_f;
    lds_f* mrow = (lds_f*)lds;
    for (int it = bid_(); it < 2 * 64; it += gridDim.x) { const int l = it >> 6, k0 = (it & 63) * 8;
        __syncthreads();
        for (int i = tid; i < 8 * 256; i += 512) mrow[i] = ld_f(WSP(float, OFF_M12) + ((size_t)l * 512 + k0) * 256 + i);
        __syncthreads();
        const float* wo = p.w_out + (size_t)l * 1024 * 1024 + o4; const lds_f* m = mrow + hk * 4 * 256;
        float4 acc[4];
#pragma unroll
        for (int q = 0; q < 4; ++q) acc[q] = make_float4(0.f, 0.f, 0.f, 0.f);
#pragma unroll 8
        for (int j = 0; j < 256; ++j) { const float4 w4 = *(const float4*)(wo + (size_t)j * 1024);
#pragma unroll
            for (int q = 0; q < 4; ++q) { const float mv = m[q * 256 + j]; acc[q].x += mv * w4.x; acc[q].y += mv * w4.y; acc[q].z += mv * w4.z; acc[q].w += mv * w4.w; } }
#pragma unroll
        for (int q = 0; q < 4; ++q) *(float4*)(WSP(float, OFF_WOF) + ((size_t)l * 512 + k0 + hk * 4 + q) * 1024 + o4) = acc[q];
    }
    __syncthreads();
}
__device__ __forceinline__ void phase_cvt_wof(const Params& p, lds_t* lds) {
    const int t = tid_(p.wv), lane = t & 63, gw = bid_() * 8 + p.wv, nw = gridDim.x * 8, kq = lane >> 4, oc = (lane & 15) * 4;
    unsigned char* T = (unsigned char*)lds + p.wv * 9216;
    for (int ti = gw; ti < 2 * 20 * 16; ti += nw) { const int l = ti / 320, kb = (ti % 320) / 16, ob = ti % 16, k0 = kb * 64, o0 = ob * 64;
        const float* src = k0 < 512 ? WSP(float, OFF_WOF) + ((size_t)l * 512 + k0) * 1024 : p.w_out + (size_t)l * 1024 * 1024 + (size_t)(k0 - 256) * 1024;
        float4 v[16];
#pragma unroll
        for (int q = 0; q < 16; ++q) v[q] = *(const float4*)(src + (size_t)(16 * (q >> 2) + 4 * kq + (q & 3)) * 1024 + o0 + oc);
        cvt_wave_store(v, false, WP(W_O) + (size_t)l * 1024 * 1280, 1280, o0, k0, T, lane);
    }
    __syncthreads();
}

#define XB_TMO      128
#define XB_XCNT(j)  (256  + 64 * (j))
#define XB_XSUB(j)  (1280 + 64 * (j))
#define XB_XGEN(j)  (2304 + 64 * (j))
#define XB_TOP      3328
#define XB_TOPGEN   3392
#define XCD_BAR_WORDS 3456
#define XB_SPIN_CAP (1u << 20)
#define LAS __attribute__((address_space(3)))
__device__ __forceinline__ unsigned xb_ld(unsigned* p)              { return __hip_atomic_load(p, __ATOMIC_RELAXED, __HIP_MEMORY_SCOPE_AGENT); }
__device__ __forceinline__ unsigned xb_add(unsigned* p, unsigned v) { return __hip_atomic_fetch_add(p, v, __ATOMIC_RELAXED, __HIP_MEMORY_SCOPE_AGENT); }
__device__ __forceinline__ unsigned xb_xcc_id() { return (unsigned)__builtin_amdgcn_s_getreg((3 << 11) | 20) & 0xFu; }
#define XB_SPIN(cond, bar) do { unsigned _sp = 0; while (cond) { __builtin_amdgcn_s_sleep(1); \
    if ((++_sp & 255u) == 0u) { if (xb_ld(&(bar)[XB_TMO])) break; if (_sp > XB_SPIN_CAP) { atomicAdd(&(bar)[XB_TMO], 1u); break; } } } } while (0)
struct XcdBarrier { unsigned* bar; unsigned x; volatile LAS unsigned* st; int wv; };
__device__ __forceinline__ XcdBarrier xcd_barrier_post(unsigned* bar, volatile LAS unsigned* st, int wv) {
    XcdBarrier b; b.bar = bar; b.x = xb_xcc_id(); b.st = st; b.wv = wv;
    if (tid_(wv) == 0) (void)xb_add(&bar[XB_XCNT(b.x)], 1u);
    return b;
}
__device__ __forceinline__ void xcd_barrier_complete(unsigned* bar, unsigned x, unsigned& nloc, unsigned& nx) {
    const unsigned G = gridDim.x * gridDim.y * gridDim.z;
    unsigned sum, cnt, mine, sp = 0u;
    for (;;) {
        sum = 0u; cnt = 0u; mine = 0u;
#pragma unroll
        for (unsigned j = 0; j < 16; ++j) { const unsigned c = xb_ld(&bar[XB_XCNT(j)]); sum += c; cnt += (c > 0u) ? 1u : 0u; mine = (j == x) ? c : mine; }
        if (sum == G) break;
        __builtin_amdgcn_s_sleep(1);
        if ((++sp & 255u) == 0u) { if (xb_ld(&bar[XB_TMO])) break; if (sp > XB_SPIN_CAP) { atomicAdd(&bar[XB_TMO], 1u); break; } }
    }
    nloc = mine > 0u ? mine : 1u; nx = cnt > 0u ? cnt : 1u;
}
__device__ __forceinline__ void xcd_barrier(const XcdBarrier& b) {
    asm volatile("s_waitcnt vmcnt(0)" ::: "memory");
    __syncthreads();
    if (tid_(b.wv) == 0) {
        unsigned* bar = b.bar; unsigned bx = b.x; asm volatile("" : "+s"(bx));
        __builtin_amdgcn_s_waitcnt(0);
        unsigned nloc = b.st[0], nx = b.st[1];
        if (nloc == 0u) { xcd_barrier_complete(bar, bx, nloc, nx); b.st[0] = nloc; b.st[1] = nx; }
        const unsigned old = xb_add(&bar[XB_XSUB(bx)], 1u);
        const unsigned gen = old / nloc;
        if (old + 1u == (gen + 1u) * nloc) {
            __builtin_amdgcn_fence(__ATOMIC_RELEASE, "agent");
            asm volatile("s_waitcnt vmcnt(0)" ::: "memory");
            const unsigned og = xb_add(&bar[XB_TOP], 1u);
            const unsigned tg = og / nx;
            if (og + 1u == (tg + 1u) * nx) xb_add(&bar[XB_TOPGEN], 1u);
            else XB_SPIN(xb_ld(&bar[XB_TOPGEN]) == tg, bar);
            __builtin_amdgcn_fence(__ATOMIC_ACQUIRE, "agent");
            xb_add(&bar[XB_XGEN(bx)], 1u);
            asm volatile("s_waitcnt vmcnt(0)" ::: "memory");
        } else {
            XB_SPIN(xb_ld(&bar[XB_XGEN(bx)]) == gen, bar);
            __builtin_amdgcn_fence(__ATOMIC_ACQUIRE, "agent");
            asm volatile("s_waitcnt vmcnt(0)" ::: "memory");
        }
    }
    __syncthreads();
}


constexpr int LDS_BAR_OFF = 131072 + 8192;
__global__ void __launch_bounds__(OPT_THREADS, 2) mk_fwd(Params p) {
    extern __shared__ __attribute__((aligned(16))) unsigned char lds_raw[];
    lds_t* lds = (lds_t*)lds_raw;
    p.wv = __builtin_amdgcn_readfirstlane(threadIdx.x >> 6);
    volatile LAS unsigned* bst = (volatile LAS unsigned*)(lds + LDS_BAR_OFF);
    { const int t0_ = tid_(p.wv); if (t0_ < 4) bst[t0_] = 0u; }
    __syncthreads();
    XcdBarrier bar = xcd_barrier_post((unsigned*)p.ws, bst, p.wv);
#define LP() ({ Params q_ = p; unsigned long long w_ = (unsigned long long)(uintptr_t)q_.ws; asm volatile("" : "+s"(w_)); \
    q_.ws = (char*)(uintptr_t)(((unsigned long long)(unsigned)__builtin_amdgcn_readfirstlane((int)(w_ >> 32)) << 32) | (unsigned)__builtin_amdgcn_readfirstlane((int)w_)); q_; })
#define REPN(bit) ([]() { int n_ = 1 + ((MK_REP >> (bit)) & 1); asm volatile("" : "+s"(n_)); return n_; }())
#define REP(bit, stmt) do { const int n__ = REPN(bit); _Pragma("unroll 1") for (int rep_ = 0; rep_ < n__; ++rep_) { stmt; } } while (0)
    REP(0, phase_pro_a(LP(), lds));
    xcd_barrier(bar);
    REP(8, phase_pro_b(LP(), lds)); REP(13, phase_norm1(LP(), lds, 0));
    xcd_barrier(bar);
#pragma unroll 1
    for (int l = 0; l < 2; ++l) {
        REP(1, phase_inproj(LP(), lds, l)); if (l == 0) cvt_in_tail(LP(), lds, 132 * 7, 0, 1800);
        xcd_barrier(bar);
        if (l == 0) phase_cvt_wof(LP(), lds);
        REP(2, phase_up(LP(), lds, l)); REP(10, phase_fft_a(LP(), lds)); REP(11, phase_sgu(LP(), lds, l)); if (l == 0) phase_dft_ctx(LP(), lds);
        xcd_barrier(bar);
        REP(3, phase_mla(LP(), lds, l)); REP(4, phase_win(LP(), lds, l)); REP(12, phase_fft_c(LP(), lds));
        xcd_barrier(bar);
        REP(5, phase_outproj(LP(), lds, l)); if (l == 0) cvt_in_tail(LP(), lds, 132 * 4, 1800, 5500);
        xcd_barrier(bar);
        if (l == 0) { REP(9, phase_postmix(LP(), lds, l)); } else phase_postmix(LP(), lds, l);
        xcd_barrier(bar);
        if (l == 0) {
            REP(6, phase_ffn_gu_dense(LP(), lds)); cvt_in_tail(LP(), lds, 132 * 28, 5500, 8500); xcd_barrier(bar);
            REP(6, phase_ffn_dn_dense(LP(), lds)); cvt_in_tail(LP(), lds, 132 * 4, 8500, CVT_TOT - CVT_MOE0); xcd_barrier(bar);
        } else {
            phase_moe_assign(LP()); xcd_barrier(bar);
            REP(7, phase_moe_gu(p, lds)); xcd_barrier(bar);
            REP(7, phase_moe_dn(p, lds)); xcd_barrier(bar);
        }
        phase_postffn(LP(), lds, l);
        if (l == 0) xcd_barrier(bar);
    }
#ifdef MK_XBAR
#pragma unroll 1
    for (int i = 0; i < MK_XBAR; ++i) xcd_barrier(bar);
#endif
}

template <int PH>
__global__ void __launch_bounds__(OPT_THREADS, 2) opt_k(Params p, int l, int a0) {
    extern __shared__ __attribute__((aligned(16))) unsigned char lds_raw[];
    lds_t* lds = (lds_t*)lds_raw;
    p.wv = __builtin_amdgcn_readfirstlane(threadIdx.x >> 6);
    if constexpr (PH == PH_CVT) phase_cvt(p, lds, 0, CVT_TOT, blockIdx.x, gridDim.x);
    if constexpr (PH == PH_FFN_GU) phase_ffn_gu_dense(p, lds);
    if constexpr (PH == PH_FFN_DN) phase_ffn_dn_dense(p, lds);
    if constexpr (PH == PH_MOE_GU) phase_moe_gu(p, lds);
    if constexpr (PH == PH_MOE_DN) phase_moe_dn(p, lds);
    if constexpr (PH == PH_INPROJ) phase_inproj(p, lds, l);
    if constexpr (PH == PH_UP) phase_up(p, lds, l);
    if constexpr (PH == PH_OUTPROJ) phase_outproj(p, lds, l);
    if constexpr (PH == PH_MLA) phase_mla(p, lds, l);
    if constexpr (PH == PH_WIN) phase_win(p, lds, l);
    if constexpr (PH == PH_FFTA) phase_fft_a(p, lds);
    if constexpr (PH == PH_FFTC) phase_fft_c(p, lds);
    if constexpr (PH == PH_DFTC) phase_dft_ctx(p, lds);
    if constexpr (PH == PH_SGU) phase_sgu(p, lds, l);
    if constexpr (PH == PH_PROA) phase_pro_a(p, lds);
    if constexpr (PH == PH_PROB) { phase_pro_b(p, lds); }
    if constexpr (PH == PH_NORM1) { if (l == 0 && a0 == 1) phase_cvt_wof(p, lds); }
    if constexpr (PH == PH_NORM1) phase_norm1(p, lds, l);
    if constexpr (PH == PH_POSTMIX) phase_postmix(p, lds, l);
    if constexpr (PH == PH_ASSIGN) phase_moe_assign(p);
    if constexpr (PH == PH_POSTFFN) phase_postffn(p, lds, l);
}
template <int PH> static void launch_opt(const Params& p, int l, int a0, hipStream_t stream) {
    static bool init = false;
    if (!init) { (void)hipFuncSetAttribute((const void*)opt_k<PH>, hipFuncAttributeMaxDynamicSharedMemorySize, OPT_LDS); init = true; }
    hipLaunchKernelGGL(opt_k<PH>, dim3(256), dim3(OPT_THREADS), OPT_LDS, stream, p, l, a0);
}

constexpr bool USE_MK = true;
extern "C" void kernel_launch(void* const* d_in, const int* in_sizes, int n_in, void* d_out, int out_size, void* d_ws, size_t ws_size, hipStream_t stream) {
    if (n_in != 27 || ws_size < WS_NEED) { fprintf(stderr, "kernel_launch: bad args n_in %d ws %zu need %zu\n", n_in, ws_size, WS_NEED); return; }
    Params p{};
    const float** pp = (const float**)&p;
    for (int i = 0; i < 27; ++i) pp[i] = (const float*)d_in[i];
    p.out = (float*)d_out; p.ws = (char*)d_ws;
    if (USE_MK) {
        static int grid = 0;
        if (!grid) {
            int dev = 0, cus = 0, per_cu = 0;
            hipGetDevice(&dev); hipDeviceGetAttribute(&cus, hipDeviceAttributeMultiprocessorCount, dev);
            if (hipFuncSetAttribute((const void*)mk_fwd, hipFuncAttributeMaxDynamicSharedMemorySize, OPT_LDS) != hipSuccess) { fprintf(stderr, "kernel_launch: hipFuncSetAttribute failed\n"); return; }
            if (hipOccupancyMaxActiveBlocksPerMultiprocessor(&per_cu, (const void*)mk_fwd, OPT_THREADS, OPT_LDS) != hipSuccess || per_cu < 1) fprintf(stderr, "kernel_launch: note: occupancy query says %d blocks per CU; launching one per CU anyway\n", per_cu);
            grid = cus > 0 ? cus : 256;
        }
        hipMemsetAsync(d_ws, 0, 65536, stream);
        hipLaunchKernelGGL(mk_fwd, dim3(grid), dim3(OPT_THREADS), OPT_LDS, stream, p);
        return;
    }
    hipMemsetAsync(d_ws, 0, 65536, stream);
    launch_opt<PH_PROA>(p, 0, 0, stream);
    launch_opt<PH_PROB>(p, 0, 0, stream);
    launch_opt<PH_NORM1>(p, 0, 1, stream);
    for (int l = 0; l < 2; ++l) {
        launch_opt<PH_INPROJ>(p, l, 0, stream);
        launch_opt<PH_UP>(p, l, 0, stream);
        launch_opt<PH_SGU>(p, l, 0, stream);
        launch_opt<PH_FFTA>(p, l, 0, stream);
        launch_opt<PH_FFTC>(p, l, 0, stream);
        if (l == 0) launch_opt<PH_DFTC>(p, l, 0, stream);
        launch_opt<PH_WIN>(p, l, 0, stream);
        launch_opt<PH_MLA>(p, l, 0, stream);
        launch_opt<PH_OUTPROJ>(p, l, 0, stream);
        launch_opt<PH_POSTMIX>(p, l, 0, stream);
        if (l == 0) {
            launch_opt<PH_FFN_GU>(p, l, 0, stream);
            launch_opt<PH_FFN_DN>(p, l, 0, stream);
        } else {
            launch_opt<PH_ASSIGN>(p, l, 0, stream);
            launch_opt<PH_MOE_GU>(p, l, 0, stream);
            launch_opt<PH_MOE_DN>(p, l, 0, stream);
        }
        launch_opt<PH_POSTFFN>(p, l, 0, stream);
    }
}
```

```cpp
#include <hip/hip_runtime.h>
#include <stdint.h>
#include <stdio.h>

typedef unsigned short bf16_t;
#ifndef MK_REP
#define MK_REP 0
#endif
constexpr int TL = 32768, TC = 1024, RR = TL + TC, DM = 1024, NKEY = 8448, DFF = 3584, NE = 8, DIN = 1696;
constexpr int NSORT = 264 * 256;
constexpr float EPS = 1e-6f;

__device__ __forceinline__ float bf2f(bf16_t v) { return __uint_as_float(((unsigned)v) << 16); }
__device__ __forceinline__ bf16_t f2bf(float f) { unsigned u = __float_as_uint(f); u += 0x7fffu + ((u >> 16) & 1u); return (bf16_t)(u >> 16); }
__device__ __forceinline__ int row_cond(int r) { return r < TL ? (r >> 13) : 4; }
__device__ __forceinline__ int row_batch(int r) { return r < TL ? (r >> 13) : ((r - TL) >> 8); }
__device__ __forceinline__ int row_key(int r) { return r < TL ? (r & 8191) : 8192 + ((r - TL) & 255); }
__device__ __forceinline__ float silu_f(float x) { return x / (1.f + __expf(-x)); }
__device__ __forceinline__ float gelu_f(float x) { return 0.5f * x * (1.f + erff(x * 0.70710678118654752f)); }

constexpr size_t al256(size_t x) { return (x + 255) / 256 * 256; }
constexpr size_t OFF_CTL = 0;
constexpr size_t OFF_MOD = OFF_CTL + 65536;
constexpr size_t OFF_ROPEW = OFF_MOD + al256(2 * 5 * 6144 * 4);
constexpr size_t OFF_ROPEM = OFF_ROPEW + 128 * 16 * 8;
constexpr size_t OFF_TW = OFF_ROPEM + 128 * 8 * 8;
constexpr size_t OFF_CS8K = OFF_TW + 64 * 128 * 8;
constexpr size_t OFF_FA = OFF_CS8K + 8192 * 8;
constexpr size_t OFF_GM = OFF_FA + 256 * 128 * 2;
constexpr size_t OFF_FC = OFF_GM + 128 * 128 * 2;
constexpr size_t OFF_M12 = OFF_FC + 512 * 256 * 2;
constexpr size_t OFF_HXC = OFF_M12 + 2 * 512 * 256 * 4;
constexpr size_t OFF_WOF = OFF_HXC + 1024 * 1024 * 4;
constexpr size_t OFF_TOKE = OFF_WOF + (size_t)2 * 512 * 1024 * 4;
constexpr size_t OFF_TOKW = OFF_TOKE + TL * 2 * 4;
constexpr size_t OFF_TOKS = OFF_TOKW + TL * 2 * 4;
constexpr size_t OFF_ROWIDX = OFF_TOKS + TL * 2 * 4;
constexpr size_t OFF_TILEE = OFF_ROWIDX + NSORT * 4;
constexpr size_t OFF_SSQQ = OFF_TILEE + al256(272 * 4);
constexpr size_t OFF_SSQKV = OFF_SSQQ + (size_t)RR * 16;
constexpr size_t OFF_LNS = OFF_SSQKV + (size_t)RR * 16;
constexpr size_t OFF_XN = OFF_LNS + (size_t)RR * 32;
constexpr size_t OFF_W = OFF_XN + (size_t)RR * 1024 * 2;
constexpr size_t W_BYTES = (size_t)2 * 1792 * 1024 * 2 + (size_t)2 * 1024 * 384 * 2 + (size_t)2 * 1024 * 1280 * 2 + (size_t)7168 * 1024 * 2 + (size_t)1024 * 3584 * 2 + (size_t)8 * 7168 * 1024 + (size_t)8 * 1024 * 3584;
constexpr size_t OFF_S = OFF_W + W_BYTES;
constexpr size_t S_CAT = 0;
constexpr size_t S_ABUF = S_CAT + (size_t)RR * 1280 * 2;
constexpr size_t S_QW = S_ABUF + (size_t)RR * 256 * 2;
constexpr size_t S_KW = S_QW + (size_t)RR * 256 * 2;
constexpr size_t S_VW = S_KW + (size_t)4 * NKEY * 128 * 2;
constexpr size_t S_C2 = S_VW + (size_t)4 * NKEY * 128 * 2;
constexpr size_t S_KM = S_C2 + (size_t)RR * 384 * 2;
constexpr size_t S_VM = S_KM + (size_t)16 * NKEY * 96 * 2;
constexpr size_t S_U = S_VM + (size_t)16 * NKEY * 64 * 2;
constexpr size_t S_VG = S_U + (size_t)RR * 256 * 2;
constexpr size_t S_QM = S_VG + (size_t)RR * 256 * 2;
constexpr size_t S_UP = S_QM + (size_t)RR * 384 * 2;
constexpr size_t S_END_MIX = S_UP + (size_t)4 * 128 * 2 * 64 * 256 * 2;
constexpr size_t S_MX = S_ABUF;
constexpr size_t S_H = 0;
constexpr size_t S_YS = S_H + (size_t)RR * 3584 * 2;
constexpr size_t S_END = S_YS + (size_t)NSORT * 1024 * 2;
static_assert(S_END_MIX <= S_END, "S region");
static_assert(S_MX + (size_t)RR * 1024 * 2 <= S_END_MIX, "MX overlay");
static_assert((size_t)NSORT * 3584 <= (size_t)RR * 3584 * 2, "fp8 H fits");
constexpr size_t WS_NEED = OFF_S + S_END;

constexpr int CW_CNT = 4096;
constexpr int CW_CUR = 4112;
constexpr int CW_OFF = 4128;
constexpr int CW_NT = 4144;

struct Params {
    const float *x, *c, *ctx, *c_ctx, *w_mod, *b_mod, *g_pre_mix, *g_post_mix, *g_pre_ffn, *g_post_ffn, *w_in, *w_out, *w_fourier, *win_sink,
        *mla_g_q, *mla_g_kv, *mla_w_uq, *mla_w_ukv, *sgu_w, *sgu_b, *ffn_w_gate, *ffn_w_up, *ffn_w_down, *moe_w_router, *moe_w_gate, *moe_w_up, *moe_w_down;
    float* out; char* ws;
    int wv, pad_;
};
#define WSP(T, off) ((T*)(p.ws + (off)))
#define SP(T, off) ((T*)(p.ws + OFF_S + (off)))

__device__ __forceinline__ float sum4(const float* q) { return (q[0] + q[1]) + (q[2] + q[3]); }
__device__ __forceinline__ int ld_i(const int* q) { return __hip_atomic_load(q, __ATOMIC_RELAXED, __HIP_MEMORY_SCOPE_AGENT); }
__device__ __forceinline__ float ld_f(const float* q) { return __hip_atomic_load(q, __ATOMIC_RELAXED, __HIP_MEMORY_SCOPE_AGENT); }
__device__ __forceinline__ int bid_() { int b = blockIdx.x; asm volatile("" : "+s"(b)); return b; }
__device__ __forceinline__ int lane_() { int l; asm volatile("v_mbcnt_lo_u32_b32 %0, -1, 0\n\tv_mbcnt_hi_u32_b32 %0, -1, %0" : "=v"(l)); return l; }
__device__ __forceinline__ int tid_(int wv) { return (wv << 6) | lane_(); }
namespace pg8 {
#define PG8_LAS __attribute__((address_space(3)))
typedef short bf16x8 __attribute__((ext_vector_type(8)));
typedef float f32x4 __attribute__((ext_vector_type(4)));
typedef unsigned u32x4 __attribute__((ext_vector_type(4)));
typedef unsigned u32x2 __attribute__((ext_vector_type(2)));
typedef int v8i_t __attribute__((ext_vector_type(8)));
typedef int v4i_t __attribute__((ext_vector_type(4)));
constexpr int BM = 256, BK = 64, HALF = 128, HTB = HALF * BK * 2, STAGE_BYTES = 8 * HTB, NXCD = 8, WGM = 8;
__host__ __device__ __forceinline__ int lds_byte(int r, int c) { const int st = (r >> 4) * 2 + (c >> 5), rr = r & 15, cc = c & 31, ob = rr * 64 + cc * 2; return st * 1024 + (ob ^ (((ob >> 9) & 1) << 5)); }
__host__ __device__ __forceinline__ void stage_rc(int b, int& R, int& C) { const int st = b / 1024, sb = b % 1024, swz = sb ^ (((sb >> 9) & 1) << 5); R = (st >> 1) * 16 + swz / 64; C = (st & 1) * 32 + (swz % 64) / 2; }
__host__ __device__ __forceinline__ int perm32(int rho) { const int n = rho >> 4, i = rho & 15; return 8 * (i >> 2) + 4 * n + (i & 3); }
struct Unit { int pm, pn; };
struct Gemm { int lda, ldb, K, wv; };
__device__ __forceinline__ unsigned cvt_pk_bf16(float lo, float hi) { unsigned r; asm volatile("v_cvt_pk_bf16_f32 %0, %1, %2" : "=v"(r) : "v"(lo), "v"(hi)); return r; }

struct OrderBase {
    int nM, nN, nwg, G, c;
    __device__ void init(int nM_, int nN_, int G_, int c_) { nM = nM_; nN = nN_; nwg = nM * nN; G = G_; c = c_; }
    __device__ bool next(int i, Unit& u) const {
        const long L = (long)i * G + c; if (L >= nwg) return false;
        int wgid = (int)L; { const int q = nwg / NXCD, r = nwg % NXCD, xcd = wgid % NXCD, off = wgid / NXCD; wgid = (xcd < r ? xcd * (q + 1) : r * (q + 1) + (xcd - r) * q) + off; }
        const int nig = WGM * nN, gid = wgid / nig, fm = gid * WGM, gsz = (nM - fm) < WGM ? (nM - fm) : WGM;
        u.pm = fm + ((wgid % nig) % gsz); u.pn = (wgid % nig) / gsz; return true;
    }
};

__device__ __forceinline__ void glds16_s(const char* sbase, unsigned voff, unsigned lds_addr) {
    unsigned keep;
    asm volatile("s_mov_b32 %0, m0\n\ts_mov_b32 m0, %3\n\ts_nop 0\n\tglobal_load_lds_dwordx4 %1, %2\n\ts_mov_b32 m0, %0" : "=&s"(keep) : "v"(voff), "s"(sbase), "s"(lds_addr) : "memory");
}
template <class Epi, class Sched, bool GATHER, bool FP8 = false>
__device__ __forceinline__ void gemm_phase(PG8_LAS unsigned char* lds, const Gemm g, const Sched& S, const Epi& E) {
    int wid_ = g.wv; asm volatile("" : "+s"(wid_));
    const int tid = tid_(g.wv), wid = wid_, lane = tid & 63, wr = wid >> 2, wc = wid & 3, fr = lane & 15, fq = lane >> 4;
    const int K = g.K, nt = K / BK;
    int mxs = 0x7f7f7f7f; asm volatile("" : "+v"(mxs));
    unsigned voffA[2], voffB[2]; int RA[2];
#pragma unroll
    for (int i = 0; i < 2; ++i) { int R, C; stage_rc(tid * 16 + i * 8192, R, C); const int Rb = Epi::PERM ? ((R & ~31) + perm32(R & 31)) : R;
        RA[i] = R; voffA[i] = GATHER ? (unsigned)(C * 2) : (unsigned)(R * g.lda + C) * 2u; voffB[i] = (unsigned)(Rb * g.ldb + C) * 2u; }
    const size_t kstep = (size_t)(BK * 2);
    const size_t hstepA = GATHER ? 0 : (size_t)HALF * g.lda * 2, hstepB = (size_t)HALF * g.ldb * 2, rstepA = (size_t)64 * g.lda * 2, rstepB = (size_t)64 * g.ldb * 2;
    const unsigned ldsw = (unsigned)wid * 1024u, ldsbase = (unsigned)(uintptr_t)lds;
    const int aoff = lds_byte(wr * 64 + fr, fq * 8), boff = lds_byte(wc * 32 + fr, fq * 8);
    unsigned gC[2] = {0, 0}, gN[2] = {0, 0};
#define PG8_SA(b, h) (((b) * 2 + (h)) * HTB)
#define PG8_SB(b, h) ((4 + (b) * 2 + (h)) * HTB)
#define PG8_STAGE_B(bufoff, gbase) do { _Pragma("unroll") for (int _i = 0; _i < 2; ++_i) { \
        if constexpr (FP8) glds16_s((const char*)(gbase) + _i * rstepB, voffB[0], ldsbase + (unsigned)(bufoff) + ldsw + _i * 8192u); \
        else __builtin_amdgcn_global_load_lds((const unsigned*)((const char*)(gbase) + _i * rstepB + voffB[0]), (PG8_LAS unsigned*)(lds + (bufoff) + ldsw + _i * 8192), 16, 0, 0); } } while (0)
#define PG8_STAGE_A(bufoff, gbase, h, usenext) do { _Pragma("unroll") for (int _i = 0; _i < 2; ++_i) { \
        const unsigned _o = GATHER ? voffA[0] + ((((usenext) ? gN[h] : gC[h]) >> (16 * _i)) & 0xffffu) * (unsigned)(g.lda * 2) : voffA[0]; \
        if constexpr (FP8) glds16_s((const char*)(gbase) + (h) * hstepA + (GATHER ? 0 : _i) * rstepA, _o, ldsbase + (unsigned)(bufoff) + ldsw + _i * 8192u); \
        else __builtin_amdgcn_global_load_lds((const unsigned*)((const char*)(gbase) + (h) * hstepA + (GATHER ? 0 : _i) * rstepA + _o), (PG8_LAS unsigned*)(lds + (bufoff) + ldsw + _i * 8192), 16, 0, 0); } } while (0)
#define PG8_LDA(dst, b, h) do { _Pragma("unroll") for (int m = 0; m < 4; ++m) { if constexpr (FP8) { const v4i_t lo_ = *(const PG8_LAS v4i_t*)(lds + PG8_SA(b, h) + aoff + m * 2048), hi_ = *(const PG8_LAS v4i_t*)(lds + PG8_SA(b, h) + aoff + m * 2048 + 1024); \
        dst##8[m] = __builtin_shufflevector(lo_, hi_, 0, 1, 2, 3, 4, 5, 6, 7); } else { _Pragma("unroll") for (int k = 0; k < 2; ++k) dst[m][k] = *(const PG8_LAS bf16x8*)(lds + PG8_SA(b, h) + aoff + m * 2048 + k * 1024); } } } while (0)
#define PG8_LDB(dst, b, h) do { _Pragma("unroll") for (int n = 0; n < 2; ++n) { if constexpr (FP8) { const v4i_t lo_ = *(const PG8_LAS v4i_t*)(lds + PG8_SB(b, h) + boff + n * 2048), hi_ = *(const PG8_LAS v4i_t*)(lds + PG8_SB(b, h) + boff + n * 2048 + 1024); \
        dst##8[n] = __builtin_shufflevector(lo_, hi_, 0, 1, 2, 3, 4, 5, 6, 7); } else { _Pragma("unroll") for (int k = 0; k < 2; ++k) dst[n][k] = *(const PG8_LAS bf16x8*)(lds + PG8_SB(b, h) + boff + n * 2048 + k * 1024); } } } while (0)
#define PG8_MMA(ai, bj, At, Bt) do { __builtin_amdgcn_s_setprio(1); _Pragma("unroll") for (int m = 0; m < 4; ++m) _Pragma("unroll") for (int n = 0; n < 2; ++n) { \
        if constexpr (FP8) acc[ai][bj][m][n] = __builtin_amdgcn_mfma_scale_f32_16x16x128_f8f6f4(Bt##8[n], At##8[m], acc[ai][bj][m][n], 0, 0, 0, mxs, 0, mxs); \
        else { _Pragma("unroll") for (int k = 0; k < 2; ++k) acc[ai][bj][m][n] = __builtin_amdgcn_mfma_f32_16x16x32_bf16(Bt[n][k], At[m][k], acc[ai][bj][m][n], 0, 0, 0); } } \
        __builtin_amdgcn_s_setprio(0); } while (0)
#define PG8_WAIT_V(n) asm volatile("s_waitcnt vmcnt(" #n ")" ::: "memory")
#define PG8_WAIT_L(n) asm volatile("s_waitcnt lgkmcnt(" #n ")" ::: "memory")
#define PG8_BAR __builtin_amdgcn_s_barrier()
#define PG8_SCHED __builtin_amdgcn_sched_barrier(0)
    Unit cur, nxt; int ui = 0;
    if (!S.next(0, cur)) return;
    f32x4 acc[2][2][4][2];
#pragma unroll
    for (int a = 0; a < 2; ++a)
#pragma unroll
        for (int b = 0; b < 2; ++b)
#pragma unroll
            for (int m = 0; m < 4; ++m)
#pragma unroll
                for (int n = 0; n < 2; ++n) acc[a][b][m][n] = (f32x4){0.f, 0.f, 0.f, 0.f};
    bf16x8 At[4][2], B0[2][2], B1[2][2]; v8i_t At8[4], B08[2], B18[2];
    const char* cA = S.a_base(cur); const char* cB = S.b_base(cur);
    if constexpr (GATHER) {
#pragma unroll
        for (int h = 0; h < 2; ++h) gC[h] = (unsigned)S.row(cur, h * HALF + RA[0]) | ((unsigned)S.row(cur, h * HALF + RA[1]) << 16);
    }
    PG8_STAGE_B(PG8_SB(0, 0), cB); PG8_STAGE_B(PG8_SB(0, 1), cB + hstepB); PG8_STAGE_A(PG8_SA(0, 0), cA, 0, false); PG8_STAGE_A(PG8_SA(0, 1), cA, 1, false);
    if (wr == 1) PG8_BAR;
    PG8_WAIT_V(2); PG8_BAR;
    PG8_STAGE_B(PG8_SB(1, 0), cB + kstep); PG8_STAGE_A(PG8_SA(1, 0), cA + kstep, 0, false); PG8_STAGE_B(PG8_SB(1, 1), cB + hstepB + kstep);
    PG8_WAIT_V(6); PG8_BAR;
    for (;;) {
        const bool has_next = S.next(ui + 1, nxt);
        if (!has_next) nxt = cur;
        const char* nA = S.a_base(nxt); const char* nB = S.b_base(nxt);
        if constexpr (GATHER) { int R0_, R1_, C_; const int t3_ = tid_(g.wv); stage_rc(t3_ * 16, R0_, C_); stage_rc(t3_ * 16 + 8192, R1_, C_);
#pragma unroll
            for (int h = 0; h < 2; ++h) gN[h] = (unsigned)S.row(nxt, h * HALF + R0_) | ((unsigned)S.row(nxt, h * HALF + R1_) << 16);
        }
        asm volatile(".p2align 8");
#pragma unroll 1
        for (int t = 0; t < nt; t += 2) {
            const bool last = (t == nt - 2);
            const char* a1 = cA + (size_t)(t + 1) * kstep;
            const char* a2 = last ? nA : cA + (size_t)(t + 2) * kstep; const char* b2 = last ? nB : cB + (size_t)(t + 2) * kstep;
            const char* a3 = a2 + kstep; const char* b3 = b2 + kstep;
            PG8_LDB(B0, 0, 0); PG8_LDB(B1, 0, 1); PG8_SCHED; PG8_LDA(At, 0, 0); PG8_STAGE_A(PG8_SA(1, 1), a1, 1, false);
            PG8_WAIT_V(8); PG8_WAIT_L(0); PG8_BAR; PG8_MMA(0, 0, At, B0); PG8_MMA(0, 1, At, B1); PG8_BAR; PG8_SCHED;
            PG8_LDA(At, 0, 1); PG8_STAGE_B(PG8_SB(0, 0), b2); PG8_STAGE_B(PG8_SB(0, 1), b2 + hstepB); PG8_STAGE_A(PG8_SA(0, 0), a2, 0, last);
            PG8_WAIT_V(8); PG8_WAIT_L(0); PG8_BAR; PG8_MMA(1, 0, At, B0); PG8_MMA(1, 1, At, B1); PG8_BAR; PG8_SCHED;
            PG8_LDB(B0, 1, 0); PG8_LDB(B1, 1, 1); PG8_SCHED; PG8_LDA(At, 1, 0); PG8_STAGE_A(PG8_SA(0, 1), a2, 1, last);
            PG8_WAIT_V(8); PG8_WAIT_L(0); PG8_BAR; PG8_MMA(0, 0, At, B0); PG8_MMA(0, 1, At, B1); PG8_BAR; PG8_SCHED;
            PG8_LDA(At, 1, 1); PG8_STAGE_B(PG8_SB(1, 0), b3); PG8_STAGE_B(PG8_SB(1, 1), b3 + hstepB); PG8_STAGE_A(PG8_SA(1, 0), a3, 0, last);
            PG8_WAIT_V(8); PG8_WAIT_L(0); PG8_BAR; PG8_MMA(1, 0, At, B0); PG8_MMA(1, 1, At, B1); PG8_BAR; PG8_SCHED;
        }
        if (wr == 0) PG8_BAR;
        { const int t2_ = tid_(g.wv), fr_ = t2_ & 15, fq_ = (t2_ >> 4) & 3;
          E(acc, cur, wr, wc, fr_, fq_); }
        if (!has_next) break;
#pragma unroll
        for (int a = 0; a < 2; ++a)
#pragma unroll
            for (int b = 0; b < 2; ++b)
#pragma unroll
                for (int m = 0; m < 4; ++m)
#pragma unroll
                    for (int n = 0; n < 2; ++n) acc[a][b][m][n] = (f32x4){0.f, 0.f, 0.f, 0.f};
        cur = nxt; cA = nA; cB = nB; ++ui;
        if constexpr (GATHER) { gC[0] = gN[0]; gC[1] = gN[1]; }
        if (wr == 1) PG8_BAR;
    }
    PG8_WAIT_V(0);
    PG8_BAR;
#undef PG8_SA
#undef PG8_SB
#undef PG8_STAGE_A
#undef PG8_STAGE_B
#undef PG8_LDA
#undef PG8_LDB
#undef PG8_MMA
#undef PG8_WAIT_V
#undef PG8_WAIT_L
#undef PG8_BAR
#undef PG8_SCHED
}
}

constexpr int OPT_THREADS = 512, OPT_LDS = 147456;
__device__ __forceinline__ bf16_t* ys_row(const Params& p, int srow) { return SP(bf16_t, S_YS) + (size_t)srow * 1024; }
__device__ __forceinline__ unsigned fp8x4(float a, float b, float c, float d) { int r = __builtin_amdgcn_cvt_pk_fp8_f32(a, b, 0, false); return (unsigned)__builtin_amdgcn_cvt_pk_fp8_f32(c, d, r, true); }
__device__ __forceinline__ float clamp448(float v) { return __builtin_amdgcn_fmed3f(v, -448.f, 448.f); }
constexpr size_t W_IN = 0;
constexpr size_t W_UP = W_IN + (size_t)2 * 1792 * 1024 * 2;
constexpr size_t W_O = W_UP + (size_t)2 * 1024 * 384 * 2;
constexpr size_t W_GU = W_O + (size_t)2 * 1024 * 1280 * 2;
constexpr size_t W_D = W_GU + (size_t)7168 * 1024 * 2;
constexpr size_t W_MGU = W_D + (size_t)1024 * 3584 * 2;
constexpr size_t W_MD = W_MGU + (size_t)8 * 7168 * 1024;
constexpr size_t W_END = W_MD + (size_t)8 * 1024 * 3584;
static_assert(W_END == W_BYTES, "weights region");
#ifndef MK_TEST
#define MK_TEST 0
#endif
#ifndef DENSE_FP8
#define DENSE_FP8 2
#endif
constexpr float WSCALE = 64.f, HSCALE = 8.f;
#define WP(off) ((bf16_t*)(p.ws + OFF_W + (off)))

struct CvtJob { bf16_t* dst; int ldd; const float* s0; const float* s1; int lds_, kind; const float* scale; const float* scale2; bool f8; };
__device__ __forceinline__ const float* cvt_src(const CvtJob& j, int k, int n, float& sc) {
    sc = 1.f;
    if (j.kind == 0) return j.s0 + (size_t)k * j.lds_ + n;
    if (j.kind == 1) { if (n < 1184) return j.s0 + (size_t)k * j.lds_ + n; if (n >= 1280) return j.s0 + (size_t)k * j.lds_ + n - 96; return nullptr; }
    if (j.kind == 2) { const int tl = n >> 8, jj = n & 255; return (jj < 128 ? j.s0 : j.s1) + (size_t)k * j.lds_ + tl * 128 + (jj & 127); }
    if (n < 384 && k < 256) { sc = j.scale[k]; return j.s0 + (size_t)k * 384 + n; }
    if (n >= 512 && k >= 256) { sc = j.scale2[k - 256]; return j.s1 + (size_t)(k - 256) * 512 + (n - 512); }
    return nullptr;
}
__device__ __forceinline__ void cvt_wave_store(const float4 (&v)[16], bool f8, void* dst, int ldd, int n0, int k0, unsigned char* T, int lane) {
    const int kq = lane >> 4, nc = (lane & 15) * 4;
    if (f8) {
#pragma unroll
        for (int i = 0; i < 4; ++i) { const int kb = 16 * i + 4 * kq;
            *(unsigned*)(T + (nc + 0) * 68 + kb) = fp8x4(v[4 * i].x, v[4 * i + 1].x, v[4 * i + 2].x, v[4 * i + 3].x);
            *(unsigned*)(T + (nc + 1) * 68 + kb) = fp8x4(v[4 * i].y, v[4 * i + 1].y, v[4 * i + 2].y, v[4 * i + 3].y);
            *(unsigned*)(T + (nc + 2) * 68 + kb) = fp8x4(v[4 * i].z, v[4 * i + 1].z, v[4 * i + 2].z, v[4 * i + 3].z);
            *(unsigned*)(T + (nc + 3) * 68 + kb) = fp8x4(v[4 * i].w, v[4 * i + 1].w, v[4 * i + 2].w, v[4 * i + 3].w); }
        asm volatile("s_waitcnt lgkmcnt(0)" ::: "memory");
#pragma unroll
        for (int r = 0; r < 8; ++r) { const int n = r * 8 + (lane >> 3), kc = (lane & 7) * 8; uint2 w; w.x = *(const unsigned*)(T + n * 68 + kc); w.y = *(const unsigned*)(T + n * 68 + kc + 4);
            *(uint2*)((unsigned char*)dst + (size_t)(n0 + n) * ldd + k0 + kc) = w; }
    } else {
#pragma unroll
        for (int i = 0; i < 4; ++i) { const int kb = (16 * i + 4 * kq) * 2;
            *(unsigned*)(T + (nc + 0) * 132 + kb) = pg8::cvt_pk_bf16(v[4 * i].x, v[4 * i + 1].x); *(unsigned*)(T + (nc + 0) * 132 + kb + 4) = pg8::cvt_pk_bf16(v[4 * i + 2].x, v[4 * i + 3].x);
            *(unsigned*)(T + (nc + 1) * 132 + kb) = pg8::cvt_pk_bf16(v[4 * i].y, v[4 * i + 1].y); *(unsigned*)(T + (nc + 1) * 132 + kb + 4) = pg8::cvt_pk_bf16(v[4 * i + 2].y, v[4 * i + 3].y);
            *(unsigned*)(T + (nc + 2) * 132 + kb) = pg8::cvt_pk_bf16(v[4 * i].z, v[4 * i + 1].z); *(unsigned*)(T + (nc + 2) * 132 + kb + 4) = pg8::cvt_pk_bf16(v[4 * i + 2].z, v[4 * i + 3].z);
            *(unsigned*)(T + (nc + 3) * 132 + kb) = pg8::cvt_pk_bf16(v[4 * i].w, v[4 * i + 1].w); *(unsigned*)(T + (nc + 3) * 132 + kb + 4) = pg8::cvt_pk_bf16(v[4 * i + 2].w, v[4 * i + 3].w); }
        asm volatile("s_waitcnt lgkmcnt(0)" ::: "memory");
#pragma unroll
        for (int r = 0; r < 8; ++r) { const int n = r * 8 + (lane >> 3), kc = (lane & 7) * 16; uint4 w;
            w.x = *(const unsigned*)(T + n * 132 + kc); w.y = *(const unsigned*)(T + n * 132 + kc + 4); w.z = *(const unsigned*)(T + n * 132 + kc + 8); w.w = *(const unsigned*)(T + n * 132 + kc + 12);
            *(uint4*)((bf16_t*)dst + (size_t)(n0 + n) * ldd + k0 + (lane & 7) * 8) = w; }
    }
    asm volatile("s_waitcnt lgkmcnt(0)" ::: "memory");
}
__device__ __forceinline__ void cvt_wave_tile(const CvtJob& j, int n0, int k0, unsigned char* T  , int lane) {
    const int kq = lane >> 4, nc = (lane & 15) * 4;
    float4 v[16]; float sc[16];
#pragma unroll
    for (int q = 0; q < 16; ++q) { const float* src = cvt_src(j, k0 + 16 * (q >> 2) + 4 * kq + (q & 3), n0 + nc, sc[q]); v[q] = src ? *(const float4*)src : make_float4(0.f, 0.f, 0.f, 0.f); }
#pragma unroll
    for (int q = 0; q < 16; ++q) { const float s_ = j.f8 ? WSCALE : sc[q]; v[q].x *= s_; v[q].y *= s_; v[q].z *= s_; v[q].w *= s_; }
    cvt_wave_store(v, j.f8, j.dst, j.ldd, n0, k0, T, lane);
}
typedef __attribute__((address_space(3))) unsigned char lds_t;
__device__ __forceinline__ float silu_fast(float x) { return x * __builtin_amdgcn_rcpf(1.f + __expf(-x)); }

__device__ __forceinline__ void cvt_decode(const Params& p, int ti, CvtJob& j, int& n0, int& k0) {
    constexpr int T_IN = 448, T_UP = 96, T_GU = 1792, T_D = 896;
    int idx = ti, kt; j = CvtJob{};
    if (idx < 2 * T_IN) { const int l = idx / T_IN; idx %= T_IN; j.dst = WP(W_IN) + (size_t)l * 1792 * 1024; j.ldd = 1024; j.s0 = p.w_in + (size_t)l * 1024 * DIN; j.lds_ = DIN; j.kind = 1; kt = 16; }
    else if ((idx -= 2 * T_IN) < 2 * T_UP) { const int l = idx / T_UP; idx %= T_UP; j.dst = WP(W_UP) + (size_t)l * 1024 * 384; j.ldd = 384; j.s0 = p.mla_w_uq + (size_t)l * 256 * 384; j.s1 = p.mla_w_ukv + (size_t)l * 128 * 512;
        j.scale = p.mla_g_q + l * 256; j.scale2 = p.mla_g_kv + l * 128; j.kind = 3; kt = 6; }
    else if ((idx -= 2 * T_UP) < T_GU) { j.dst = WP(W_GU); j.ldd = 1024; j.s0 = p.ffn_w_gate; j.s1 = p.ffn_w_up; j.lds_ = DFF; j.kind = 2; j.f8 = (DENSE_FP8 == 1); kt = 16; }
    else if ((idx -= T_GU) < T_D) { j.dst = WP(W_D); j.ldd = DFF; j.s0 = p.ffn_w_down; j.lds_ = 1024; j.kind = 0; j.f8 = (DENSE_FP8 != 0); kt = 56; }
    else if ((idx -= T_D) < 8 * T_GU) { const int e = idx / T_GU; idx %= T_GU; j.dst = (bf16_t*)(p.ws + OFF_W + W_MGU + (size_t)e * 7168 * 1024); j.ldd = 1024; j.s0 = p.moe_w_gate + (size_t)e * 1024 * DFF; j.s1 = p.moe_w_up + (size_t)e * 1024 * DFF; j.lds_ = DFF; j.kind = 2; j.f8 = true; kt = 16; }
    else { idx -= 8 * T_GU; const int e = idx / T_D; idx %= T_D; j.dst = (bf16_t*)(p.ws + OFF_W + W_MD + (size_t)e * 1024 * DFF); j.ldd = DFF; j.s0 = p.moe_w_down + (size_t)e * DFF * 1024; j.lds_ = 1024; j.kind = 0; j.f8 = true; kt = 56; }
    const int ntn = j.kind == 1 ? 28 : (j.kind == 3 ? 16 : (j.kind == 2 ? 112 : 16)); (void)kt;
    n0 = (idx % ntn) * 64; k0 = (idx / ntn) * 64;
}
constexpr int CVT_TOT = 2 * 448 + 2 * 96 + 1792 + 896 + 8 * (1792 + 896), CVT_MOE0 = 2 * 448 + 2 * 96 + 1792 + 896;
__device__ __forceinline__ void phase_cvt(const Params& p, lds_t* lds, int begin, int end, int wb, int nwb) {
    const int t = tid_(p.wv), lane = t & 63;
    unsigned char* T = (unsigned char*)lds + p.wv * 9216;
    for (int ti = begin + wb * 8 + p.wv; ti < end; ti += nwb * 8) { CvtJob j; int n0, k0; cvt_decode(p, ti, j, n0, k0); cvt_wave_tile(j, n0, k0, T, lane); }
    __syncthreads();
}
__device__ __forceinline__ void cvt_in_tail(const Params& p, lds_t* lds, int nunits, int begin, int end) {
    const int G = gridDim.x, c = bid_(), heavy = nunits % G;
    if (G != 256 || heavy == 0 || c < heavy) return;
    phase_cvt(p, lds, CVT_MOE0 + begin, CVT_MOE0 + end, c - heavy, G - heavy);
}

struct SchedDense : pg8::OrderBase {
    const char *A, *B; size_t ta, tb;
    __device__ const char* a_base(const pg8::Unit& u) const { return A + (size_t)u.pm * ta; }
    __device__ const char* b_base(const pg8::Unit& u) const { return B + (size_t)u.pn * tb; }
    __device__ int row(const pg8::Unit&, int) const { return 0; }
};
struct SchedMoE : pg8::OrderBase {
    const char *A, *B; size_t ta, tb, te; int t0; const int* tile_e; const int* rowidx;
    __device__ const char* a_base(const pg8::Unit& u) const { return A + (size_t)u.pm * ta; }
    __device__ const char* b_base(const pg8::Unit& u) const { return B + (size_t)__builtin_amdgcn_readfirstlane(ld_i(tile_e + t0 + u.pm)) * te + (size_t)u.pn * tb; }
    __device__ int row(const pg8::Unit& u, int r) const { return rowidx[(t0 + u.pm) * 256 + r]; }
};
struct EpiSwiGLU {
    static constexpr bool PERM = true;
    bf16_t* H;
    __device__ __forceinline__ void operator()(const pg8::f32x4 (&acc)[2][2][4][2], const pg8::Unit& u, int wr, int wc, int fr, int fq) const {
#pragma unroll
        for (int ai = 0; ai < 2; ++ai)
#pragma unroll
            for (int m = 0; m < 4; ++m) {
                const int row = u.pm * 256 + ai * 128 + wr * 64 + m * 16 + fr;
                const pg8::f32x4 g0 = acc[ai][0][m][0], g1 = acc[ai][0][m][1], u0 = acc[ai][1][m][0], u1 = acc[ai][1][m][1];
                pg8::u32x4 w;
                w.x = pg8::cvt_pk_bf16(silu_fast(g0[0]) * u0[0], silu_fast(g0[1]) * u0[1]); w.y = pg8::cvt_pk_bf16(silu_fast(g0[2]) * u0[2], silu_fast(g0[3]) * u0[3]);
                w.z = pg8::cvt_pk_bf16(silu_fast(g1[0]) * u1[0], silu_fast(g1[1]) * u1[1]); w.w = pg8::cvt_pk_bf16(silu_fast(g1[2]) * u1[2], silu_fast(g1[3]) * u1[3]);
                *(pg8::u32x4*)(H + (size_t)row * DFF + u.pn * 128 + wc * 32 + 8 * fq) = w;
            }
    }
};
template <bool WS = true> struct EpiSwiGLU8T {
    static constexpr bool PERM = true;
    unsigned char* H;
    __device__ __forceinline__ void operator()(const pg8::f32x4 (&acc)[2][2][4][2], const pg8::Unit& u, int wr, int wc, int fr, int fq) const {
        constexpr float IS = WS ? 1.f / WSCALE : 1.f;
#pragma unroll
        for (int ai = 0; ai < 2; ++ai)
#pragma unroll
            for (int m = 0; m < 4; ++m) {
                const int row = u.pm * 256 + ai * 128 + wr * 64 + m * 16 + fr;
                const pg8::f32x4 g0 = acc[ai][0][m][0] * IS, g1 = acc[ai][0][m][1] * IS, u0 = acc[ai][1][m][0] * (IS * HSCALE), u1 = acc[ai][1][m][1] * (IS * HSCALE);
                pg8::u32x2 w;
                w.x = fp8x4(clamp448(silu_fast(g0[0]) * u0[0]), clamp448(silu_fast(g0[1]) * u0[1]), clamp448(silu_fast(g0[2]) * u0[2]), clamp448(silu_fast(g0[3]) * u0[3]));
                w.y = fp8x4(clamp448(silu_fast(g1[0]) * u1[0]), clamp448(silu_fast(g1[1]) * u1[1]), clamp448(silu_fast(g1[2]) * u1[2]), clamp448(silu_fast(g1[3]) * u1[3]));
                *(pg8::u32x2*)(H + (size_t)row * DFF + u.pn * 128 + wc * 32 + 8 * fq) = w;
            }
    }
};
typedef EpiSwiGLU8T<true> EpiSwiGLU8;
template <bool MOE, bool SCALED = MOE> struct EpiRowsBf16 {
    static constexpr bool PERM = true;
    Params p; bf16_t* O; int t0;
    __device__ __forceinline__ void operator()(const pg8::f32x4 (&acc)[2][2][4][2], const pg8::Unit& u, int wr, int wc, int fr, int fq) const {
#pragma unroll
        for (int ai = 0; ai < 2; ++ai)
#pragma unroll
            for (int m = 0; m < 4; ++m) {
                const int row = u.pm * 256 + ai * 128 + wr * 64 + m * 16 + fr;
                bf16_t* rp = MOE ? ys_row(p, t0 * 256 + row) : O + (size_t)row * 1024;
#pragma unroll
                for (int bj = 0; bj < 2; ++bj) { constexpr float SC = SCALED ? 1.f / (WSCALE * HSCALE) : 1.f; const pg8::f32x4 v0 = acc[ai][bj][m][0] * SC, v1 = acc[ai][bj][m][1] * SC; pg8::u32x4 w;
                    w.x = pg8::cvt_pk_bf16(v0[0], v0[1]); w.y = pg8::cvt_pk_bf16(v0[2], v0[3]); w.z = pg8::cvt_pk_bf16(v1[0], v1[1]); w.w = pg8::cvt_pk_bf16(v1[2], v1[3]);
                    *(pg8::u32x4*)(rp + u.pn * 256 + bj * 128 + wc * 32 + 8 * fq) = w; }
            }
    }
};
__device__ __forceinline__ void phase_ffn_gu_dense(const Params& p, lds_t* lds) {
#if DENSE_FP8 == 1
    SchedDense S; S.init(RR / 256, 28, gridDim.x, bid_()); S.A = (const char*)WSP(bf16_t, OFF_XN); S.B = (const char*)WP(W_GU); S.ta = (size_t)256 * 1024; S.tb = (size_t)256 * 1024;
    EpiSwiGLU8 E{(unsigned char*)SP(bf16_t, S_H)};
    pg8::gemm_phase<EpiSwiGLU8, SchedDense, false, true>(lds, pg8::Gemm{512, 512, 512, p.wv}, S, E);
#elif DENSE_FP8 == 2
    SchedDense S; S.init(RR / 256, 28, gridDim.x, bid_()); S.A = (const char*)WSP(bf16_t, OFF_XN); S.B = (const char*)WP(W_GU); S.ta = (size_t)256 * 1024 * 2; S.tb = (size_t)256 * 1024 * 2;
    EpiSwiGLU8T<false> E{(unsigned char*)SP(bf16_t, S_H)};
    pg8::gemm_phase<EpiSwiGLU8T<false>, SchedDense, false>(lds, pg8::Gemm{1024, 1024, 1024, p.wv}, S, E);
#else
    SchedDense S; S.init(RR / 256, 28, gridDim.x, bid_()); S.A = (const char*)WSP(bf16_t, OFF_XN); S.B = (const char*)WP(W_GU); S.ta = (size_t)256 * 1024 * 2; S.tb = (size_t)256 * 1024 * 2;
    EpiSwiGLU E{SP(bf16_t, S_H)};
    pg8::gemm_phase<EpiSwiGLU, SchedDense, false>(lds, pg8::Gemm{1024, 1024, 1024, p.wv}, S, E);
#endif
}
__device__ __forceinline__ void phase_ffn_dn_dense(const Params& p, lds_t* lds) {
#if DENSE_FP8
    SchedDense S; S.init(RR / 256, 4, gridDim.x, bid_()); S.A = (const char*)SP(bf16_t, S_H); S.B = (const char*)WP(W_D); S.ta = (size_t)256 * DFF; S.tb = (size_t)256 * DFF;
    EpiRowsBf16<false, true> E{p, WSP(bf16_t, OFF_XN), 0};
    pg8::gemm_phase<EpiRowsBf16<false, true>, SchedDense, false, true>(lds, pg8::Gemm{DFF / 2, DFF / 2, DFF / 2, p.wv}, S, E);
#else
    SchedDense S; S.init(RR / 256, 4, gridDim.x, bid_()); S.A = (const char*)SP(bf16_t, S_H); S.B = (const char*)WP(W_D); S.ta = (size_t)256 * DFF * 2; S.tb = (size_t)256 * DFF * 2;
    EpiRowsBf16<false> E{p, WSP(bf16_t, OFF_XN), 0};
    pg8::gemm_phase<EpiRowsBf16<false>, SchedDense, false>(lds, pg8::Gemm{DFF, DFF, DFF, p.wv}, S, E);
#endif
}
__device__ __forceinline__ void phase_moe_gu(const Params& p, lds_t* lds) {
    const int NT = ld_i((const int*)p.ws + CW_NT);
    SchedMoE S; S.init(NT, 28, gridDim.x, bid_()); S.A = (const char*)SP(bf16_t, S_YS); S.B = (const char*)(p.ws + OFF_W + W_MGU); S.ta = (size_t)256 * 1024; S.tb = (size_t)256 * 1024; S.te = (size_t)7168 * 1024;
    S.t0 = 0; S.tile_e = WSP(int, OFF_TILEE); S.rowidx = WSP(int, OFF_ROWIDX);
    EpiSwiGLU8 E{(unsigned char*)SP(bf16_t, S_H)};
    pg8::gemm_phase<EpiSwiGLU8, SchedMoE, false, true>(lds, pg8::Gemm{512, 512, 512, p.wv}, S, E);
}
__device__ __forceinline__ void phase_moe_dn(const Params& p, lds_t* lds) {
    const int NT = ld_i((const int*)p.ws + CW_NT);
    SchedMoE S; S.init(NT, 4, gridDim.x, bid_()); S.A = (const char*)SP(bf16_t, S_H); S.B = (const char*)(p.ws + OFF_W + W_MD); S.ta = (size_t)256 * DFF; S.tb = (size_t)256 * DFF; S.te = (size_t)1024 * DFF;
    S.t0 = 0; S.tile_e = WSP(int, OFF_TILEE); S.rowidx = WSP(int, OFF_ROWIDX);
    EpiRowsBf16<true> E{p, nullptr, 0};
    pg8::gemm_phase<EpiRowsBf16<true>, SchedMoE, false, true>(lds, pg8::Gemm{DFF / 2, DFF / 2, DFF / 2, p.wv}, S, E);
}

typedef float f32x2 __attribute__((ext_vector_type(2)));
__device__ __forceinline__ f32x2 gelu_pk(f32x2 v) {
    const f32x2 av = __builtin_elementwise_abs(v), d = av * 0.2316418882f + 1.0f;
    f32x2 t; t.x = __builtin_amdgcn_rcpf(d.x); t.y = __builtin_amdgcn_rcpf(d.y);
    f32x2 q = t * 0.5307027145f + (-0.7265760135f); q = q * t + 0.7107068705f; q = q * t + (-0.142248368f); q = q * t + 0.127414796f; q = q * t;
    const f32x2 s = (v * v) * (-0.72134752044f);
    f32x2 e; e.x = __builtin_amdgcn_exp2f(s.x); e.y = __builtin_amdgcn_exp2f(s.y);
    const f32x2 m = v * (q * e), r = v - m;
    f32x2 o; o.x = v.x < 0.f ? m.x : r.x; o.y = v.y < 0.f ? m.y : r.y; return o;
}
__device__ __forceinline__ pg8::u32x4 pack8(const float* v) { pg8::u32x4 w; w.x = pg8::cvt_pk_bf16(v[0], v[1]); w.y = pg8::cvt_pk_bf16(v[2], v[3]); w.z = pg8::cvt_pk_bf16(v[4], v[5]); w.w = pg8::cvt_pk_bf16(v[6], v[7]); return w; }
__device__ __forceinline__ void rope8(float* v, const float2* cs) {
    const float4 a = *(const float4*)cs, b = *(const float4*)(cs + 2);
    const float c[4] = {a.x, a.z, b.x, b.z}, sn[4] = {a.y, a.w, b.y, b.w};
#pragma unroll
    for (int q = 0; q < 4; ++q) { const float x1 = v[2 * q], x2 = v[2 * q + 1]; v[2 * q] = x1 * c[q] - x2 * sn[q]; v[2 * q + 1] = x1 * sn[q] + x2 * c[q]; }
}
__device__ __forceinline__ const float2* rope_ptr(const float2* tab, int nf, int pos, int pi0) { const int co = pi0 < nf ? (pos >> 6) : (pos & 63); return tab + co * nf + (pi0 < nf ? pi0 : pi0 - nf); }

__device__ __forceinline__ void rope8r(float* v, const float4 a, const float4 b) {
    const float c[4] = {a.x, a.z, b.x, b.z}, sn[4] = {a.y, a.w, b.y, b.w};
#pragma unroll
    for (int q = 0; q < 4; ++q) { const float x1 = v[2 * q], x2 = v[2 * q + 1]; v[2 * q] = x1 * c[q] - x2 * sn[q]; v[2 * q + 1] = x1 * sn[q] + x2 * c[q]; }
}
struct EpiInProj {
    static constexpr bool PERM = true;
    Params p;
    __device__ __forceinline__ void operator()(const pg8::f32x4 (&acc)[2][2][4][2], const pg8::Unit& u, int wr, int wc, int fr, int fq) const {
        const int pn = u.pn;
        const bool lat_t = u.pm < TL / 256, roped = lat_t && (pn == 1 || pn == 2 || (pn == 4 && wc == 0));
        const int nf = pn == 4 ? 8 : 16, pb = pn == 4 ? 4 * fq : (wc & 1) * 16 + 4 * fq; const bool rowt = pb < nf;
        float4 ra[4], rb[4];
#pragma unroll
        for (int q = 0; q < 4; ++q) { ra[q] = make_float4(1.f, 0.f, 1.f, 0.f); rb[q] = ra[q]; }
        if (roped) { const float2* tab = pn == 4 ? WSP(float2, OFF_ROPEM) : WSP(float2, OFF_ROPEW);
#pragma unroll
            for (int q = 0; q < 4; ++q) { const int coord = rowt ? ((u.pm * 4 + (q & 1) * 2 + wr) & 127) : (q * 16 + fr); const float2* t = tab + coord * nf + (rowt ? pb : pb - nf);
                ra[q] = *(const float4*)t; rb[q] = *(const float4*)(t + 2); } }
#pragma unroll
        for (int ai = 0; ai < 2; ++ai)
#pragma unroll
            for (int m = 0; m < 4; ++m) {
                const int r = u.pm * 256 + ai * 128 + wr * 64 + m * 16 + fr;
                const int bb = row_batch(r), key = row_key(r);
                const float4 ca = rowt ? ra[ai] : ra[m], cb = rowt ? rb[ai] : rb[m];
                float s1 = 0.f, s2 = 0.f;
#pragma unroll
                for (int bj = 0; bj < 2; ++bj) {
                    const int c0 = bj * 128 + wc * 32 + 8 * fq;
                    float v[8];
#pragma unroll
                    for (int e = 0; e < 4; ++e) { v[e] = acc[ai][bj][m][0][e]; v[4 + e] = acc[ai][bj][m][1][e]; }
                    if (pn == 0) { *(pg8::u32x4*)(SP(bf16_t, S_ABUF) + (size_t)r * 256 + c0) = pack8(v); }
                    else if (pn == 1) { rope8r(v, ca, cb);
#pragma unroll
                        for (int e = 0; e < 8; ++e) v[e] *= 0.125f;
                        *(pg8::u32x4*)(SP(bf16_t, S_QW) + (size_t)r * 256 + c0) = pack8(v); }
                    else if (pn == 2) {
                        if (bj == 0) { rope8r(v, ca, cb); *(pg8::u32x4*)(SP(bf16_t, S_KW) + ((size_t)bb * NKEY + key) * 128 + c0) = pack8(v); }
                        else *(pg8::u32x4*)(SP(bf16_t, S_VW) + ((size_t)bb * NKEY + key) * 128 + (c0 - 128)) = pack8(v); }
                    else if (pn == 3) {
#pragma unroll
                        for (int e = 0; e < 8; ++e) s2 += v[e] * v[e];
                        *(pg8::u32x4*)(SP(bf16_t, S_C2) + (size_t)r * 384 + c0) = pack8(v); }
                    else if (pn == 4) {
                        if (bj == 0) {
#pragma unroll
                            for (int e = 0; e < 8; ++e) s2 += v[e] * v[e];
                            *(pg8::u32x4*)(SP(bf16_t, S_C2) + (size_t)r * 384 + 256 + c0) = pack8(v); }
                        else if (wc == 0) { rope8r(v, ca, cb); const pg8::u32x4 w = pack8(v);
#pragma unroll
                            for (int h = 0; h < 4; ++h) *(pg8::u32x4*)(SP(bf16_t, S_KM) + (((size_t)bb * 4 + h) * NKEY + key) * 96 + 64 + 8 * fq) = w; } }
                    else {
#pragma unroll
                        for (int e = 0; e < 8; e += 2) { const f32x2 gq = gelu_pk((f32x2){v[e], v[e + 1]}); v[e] = gq.x; v[e + 1] = gq.y; }
                        if (pn == 6) {
#pragma unroll
                            for (int e = 0; e < 8; ++e) { s1 += v[e]; s2 += v[e] * v[e]; } }
                        *(pg8::u32x4*)(SP(bf16_t, pn == 5 ? S_U : S_VG) + (size_t)r * 256 + c0) = pack8(v); }
                }
                if (pn == 3 || pn == 4 || pn == 6) {
                    { const int l4_ = lane_() << 2; s1 += __int_as_float(__builtin_amdgcn_ds_bpermute(l4_ ^ 64, __float_as_int(s1))); s1 += __int_as_float(__builtin_amdgcn_ds_bpermute(l4_ ^ 128, __float_as_int(s1))); s2 += __int_as_float(__builtin_amdgcn_ds_bpermute(l4_ ^ 64, __float_as_int(s2))); s2 += __int_as_float(__builtin_amdgcn_ds_bpermute(l4_ ^ 128, __float_as_int(s2))); }
                    if (fq == 0) { if (pn == 3) WSP(float, OFF_SSQQ)[(size_t)r * 4 + wc] = s2; else if (pn == 4) WSP(float, OFF_SSQKV)[(size_t)r * 4 + wc] = s2;
                        else { WSP(float, OFF_LNS)[(size_t)r * 8 + wc * 2] = s1; WSP(float, OFF_LNS)[(size_t)r * 8 + wc * 2 + 1] = s2; } }
                }
            }
    }
};
template <int KV> struct EpiUp {
    static constexpr bool PERM = true;
    Params p;
    __device__ __forceinline__ void operator()(const pg8::f32x4 (&acc)[2][2][4][2], const pg8::Unit& u, int wr, int wc, int fr, int fq) const {
        const int pn = u.pn;
        float rs8[8];
#pragma unroll
        for (int q = 0; q < 8; ++q) { const int r = u.pm * 256 + (q >> 2) * 128 + wr * 64 + (q & 3) * 16 + fr; const float4 sq4 = *(const float4*)(WSP(float, KV ? OFF_SSQKV : OFF_SSQQ) + (size_t)r * 4);
            rs8[q] = rsqrtf(((sq4.x + sq4.y) + (sq4.z + sq4.w)) * (KV ? 1.f / 128.f : 1.f / 256.f) + EPS) * (KV ? 1.f : 0.10206207261596575f); }
#pragma unroll
        for (int ai = 0; ai < 2; ++ai)
#pragma unroll
            for (int m = 0; m < 4; ++m) {
                const int r = u.pm * 256 + ai * 128 + wr * 64 + m * 16 + fr;
                const bool lat = r < TL; const int pos = r & 8191, bb = row_batch(r), key = row_key(r);
                const float rs = rs8[ai * 4 + m];
#pragma unroll
                for (int bj = 0; bj < 2; ++bj) {
                    const int c0 = bj * 128 + wc * 32 + 8 * fq, n = pn * 256 + c0;
                    float v[8];
#pragma unroll
                    for (int e = 0; e < 4; ++e) { v[e] = acc[ai][bj][m][0][e] * rs; v[4 + e] = acc[ai][bj][m][1][e] * rs; }
                    if (!KV) { if (n < 384) { const int i = n % 96;
                            if (i >= 64 && lat) rope8(v, rope_ptr(WSP(float2, OFF_ROPEM), 8, pos, (i - 64) >> 1));
                            *(pg8::u32x4*)(SP(bf16_t, S_QM) + (size_t)r * 384 + n) = pack8(v); } }
                    else { const int h = n >> 7, j0 = n & 127;
                        if (j0 < 64) *(pg8::u32x4*)(SP(bf16_t, S_KM) + (((size_t)bb * 4 + h) * NKEY + key) * 96 + j0) = pack8(v);
                        else *(pg8::u32x4*)(SP(bf16_t, S_VM) + (((size_t)bb * 4 + h) * NKEY + key) * 64 + (j0 - 64)) = pack8(v); }
                }
            }
    }
};
__device__ __forceinline__ void phase_inproj(const Params& p, lds_t* lds, int l) {
    SchedDense S; S.init(RR / 256, 7, gridDim.x, bid_()); S.A = (const char*)WSP(bf16_t, OFF_XN); S.B = (const char*)(WP(W_IN) + (size_t)l * 1792 * 1024); S.ta = (size_t)256 * 1024 * 2; S.tb = (size_t)256 * 1024 * 2;
    EpiInProj E{p};
    pg8::gemm_phase<EpiInProj, SchedDense, false>(lds, pg8::Gemm{1024, 1024, 1024, p.wv}, S, E);
}
__device__ __forceinline__ void phase_up(const Params& p, lds_t* lds, int l) {
    { SchedDense S; S.init(RR / 256, 2, gridDim.x, bid_()); S.A = (const char*)SP(bf16_t, S_C2); S.B = (const char*)(WP(W_UP) + (size_t)l * 1024 * 384); S.ta = (size_t)256 * 384 * 2; S.tb = (size_t)256 * 384 * 2;
      EpiUp<0> E{p}; pg8::gemm_phase<EpiUp<0>, SchedDense, false>(lds, pg8::Gemm{384, 384, 256, p.wv}, S, E); }
    { SchedDense S; S.init(RR / 256, 2, gridDim.x, (int)gridDim.x - 1 - bid_()); S.A = (const char*)(SP(bf16_t, S_C2) + 256); S.B = (const char*)(WP(W_UP) + (size_t)l * 1024 * 384 + (size_t)512 * 384 + 256); S.ta = (size_t)256 * 384 * 2; S.tb = (size_t)256 * 384 * 2;
      EpiUp<1> E{p}; pg8::gemm_phase<EpiUp<1>, SchedDense, false>(lds, pg8::Gemm{384, 384, 128, p.wv}, S, E); }
}
__device__ __forceinline__ void phase_outproj(const Params& p, lds_t* lds, int l) {
    SchedDense S; S.init(l == 0 ? RR / 256 : TL / 256, 4, gridDim.x, bid_()); S.A = (const char*)SP(bf16_t, S_CAT); S.B = (const char*)(WP(W_O) + (size_t)l * 1024 * 1280); S.ta = (size_t)256 * 1280 * 2; S.tb = (size_t)256 * 1280 * 2;
    EpiRowsBf16<false> E{p, SP(bf16_t, S_MX), 0};
    pg8::gemm_phase<EpiRowsBf16<false>, SchedDense, false>(lds, pg8::Gemm{1280, 1280, 1280, p.wv}, S, E);
}


namespace att {
using bf16x8 = __attribute__((ext_vector_type(8))) short;
using s16x4 = __attribute__((ext_vector_type(4))) short;
using f32x16 = __attribute__((ext_vector_type(16))) float;
using u32x4 = __attribute__((ext_vector_type(4))) unsigned;
#define KSWZ(row, colB) ((row) * 256 + ((colB) ^ (((row) & 15) << 4)))
#define SBAR() __builtin_amdgcn_sched_barrier(0)
constexpr float THR = 8.f, LOG2E = 1.4426950408889634f;
constexpr int SHM_K = 64 * 256, SHM_V = 64 * 64 * 2;
constexpr int NBUF = 5;
constexpr int ATT_LDS = NBUF * SHM_K + NBUF * SHM_V + 8 * 64 * 4;
__device__ __forceinline__ int crow(int r, int hi) { return (r & 3) + 8 * (r >> 2) + 4 * hi; }
__device__ __forceinline__ unsigned cvtpk(float lo, float hi) { unsigned r; asm volatile("v_cvt_pk_bf16_f32 %0, %1, %2" : "=v"(r) : "v"(lo), "v"(hi)); return r; }
__device__ __forceinline__ void partialSM(f32x16& p0, f32x16& p1, float& m_reg, float& mn, float& alpha) {
    float pmax = p0[0];
#pragma unroll
    for (int r = 1; r < 16; ++r) pmax = fmaxf(pmax, p0[r]);
#pragma unroll
    for (int r = 0; r < 16; ++r) pmax = fmaxf(pmax, p1[r]);
    { auto rr = __builtin_amdgcn_permlane32_swap(__float_as_uint(pmax), __float_as_uint(pmax), false, false); pmax = fmaxf(__uint_as_float(rr[0]), __uint_as_float(rr[1])); }
    if (__builtin_expect(__all(pmax - m_reg <= THR), 1)) { mn = m_reg; alpha = 1.f; }
    else { mn = fmaxf(m_reg, pmax); alpha = __builtin_amdgcn_exp2f((m_reg - mn) * LOG2E); m_reg = mn; }
    const float mnC = -mn * LOG2E;
#pragma unroll
    for (int r = 0; r < 16; ++r) p0[r] = fmaf(p0[r], LOG2E, mnC);
#pragma unroll
    for (int r = 0; r < 16; ++r) p1[r] = fmaf(p1[r], LOG2E, mnC);
#pragma unroll
    for (int r = 0; r < 16; ++r) p0[r] = __builtin_amdgcn_exp2f(p0[r]);
}
__device__ __forceinline__ void finishSM(f32x16& p0, f32x16& p1, bf16x8& pa0, bf16x8& pa1, bf16x8& pa2, bf16x8& pa3) {
#pragma unroll
    for (int r = 0; r < 16; ++r) p1[r] = __builtin_amdgcn_exp2f(p1[r]);
#define PK4(P, BASE, OUT) do { u32x4 w = {cvtpk(P[BASE + 0], P[BASE + 1]), cvtpk(P[BASE + 2], P[BASE + 3]), cvtpk(P[BASE + 4], P[BASE + 5]), cvtpk(P[BASE + 6], P[BASE + 7])}; OUT = *reinterpret_cast<bf16x8*>(&w); } while (0)
    PK4(p0, 0, pa0); PK4(p0, 8, pa1); PK4(p1, 0, pa2); PK4(p1, 8, pa3);
#undef PK4
}
template <int DQK>
__device__ __forceinline__ void qkt(f32x16& p0, f32x16& p1, const char* Ks, const bf16x8* qr, int r32, int hi) {
    p0 = f32x16{}; p1 = f32x16{};
#pragma unroll
    for (int d0 = 0; d0 < DQK / 16; ++d0) { const int cb = (d0 * 16 + hi * 8) * 2;
        const bf16x8 b0 = *reinterpret_cast<const bf16x8*>(Ks + KSWZ(r32, cb));
        const bf16x8 b1 = *reinterpret_cast<const bf16x8*>(Ks + KSWZ(32 + r32, cb));
        p0 = __builtin_amdgcn_mfma_f32_32x32x16_bf16(b0, qr[d0], p0, 0, 0, 0);
        p1 = __builtin_amdgcn_mfma_f32_32x32x16_bf16(b1, qr[d0], p1, 0, 0, 0); }
}
__device__ __forceinline__ void maskband(f32x16& p0, f32x16& p1, int kp0, int qp, int hi) {
#pragma unroll
    for (int r = 0; r < 16; ++r) { const int d0 = kp0 + crow(r, hi) - qp; if (d0 > 128 || d0 < -128) p0[r] = -1e30f; const int d1 = d0 + 32; if (d1 > 128 || d1 < -128) p1[r] = -1e30f; }
}
__device__ __forceinline__ int v_st(int k, int c) { const int kk = k; return ((kk >> 3) * 2 + (c >> 5)) * 512 + ((kk & 7) * 32 + (c & 31)) * 2; }
__device__ __forceinline__ int v_rd_base(int lane) { return ((lane & 3) << 3) | (((lane >> 2) & 3) << 6) | (((lane >> 4) & 1) << 5) | (((lane >> 5) & 1) << 8); }
constexpr int v_rd_off(int d0, int ks, int half) { return d0 * 512 + ks * 2048 + half * 1024; }
template <int OFF> __device__ __forceinline__ s16x4 tr_read(int vb) { s16x4 r; asm volatile("ds_read_b64_tr_b16 %0, %1 offset:%2" : "=&v"(r) : "v"(vb), "i"(OFF) : "memory"); return r; }
template <int D0> __device__ __forceinline__ void pv_one(f32x16& od, int vb, bf16x8 pa0, bf16x8 pa1, bf16x8 pa2, bf16x8 pa3) {
    const s16x4 l0 = tr_read<v_rd_off(D0, 0, 0)>(vb), h0 = tr_read<v_rd_off(D0, 0, 1)>(vb), l1 = tr_read<v_rd_off(D0, 1, 0)>(vb), h1 = tr_read<v_rd_off(D0, 1, 1)>(vb);
    const s16x4 l2 = tr_read<v_rd_off(D0, 2, 0)>(vb), h2 = tr_read<v_rd_off(D0, 2, 1)>(vb), l3 = tr_read<v_rd_off(D0, 3, 0)>(vb), h3 = tr_read<v_rd_off(D0, 3, 1)>(vb);
    asm volatile("s_waitcnt lgkmcnt(0)" ::: "memory"); SBAR();
#define PK(L, H) (bf16x8){L[0], L[1], L[2], L[3], H[0], H[1], H[2], H[3]}
    od = __builtin_amdgcn_mfma_f32_32x32x16_bf16(pa0, PK(l0, h0), od, 0, 0, 0);
    od = __builtin_amdgcn_mfma_f32_32x32x16_bf16(pa1, PK(l1, h1), od, 0, 0, 0);
    od = __builtin_amdgcn_mfma_f32_32x32x16_bf16(pa2, PK(l2, h2), od, 0, 0, 0);
    od = __builtin_amdgcn_mfma_f32_32x32x16_bf16(pa3, PK(l3, h3), od, 0, 0, 0);
#undef PK
}
__device__ __forceinline__ void pv_pair(f32x16& o0, f32x16& o1, int vb, bf16x8 pa0, bf16x8 pa1, bf16x8 pa2, bf16x8 pa3) {
    const s16x4 l0 = tr_read<v_rd_off(0, 0, 0)>(vb), h0 = tr_read<v_rd_off(0, 0, 1)>(vb), l1 = tr_read<v_rd_off(0, 1, 0)>(vb), h1 = tr_read<v_rd_off(0, 1, 1)>(vb);
    const s16x4 l2 = tr_read<v_rd_off(0, 2, 0)>(vb), h2 = tr_read<v_rd_off(0, 2, 1)>(vb), l3 = tr_read<v_rd_off(0, 3, 0)>(vb), h3 = tr_read<v_rd_off(0, 3, 1)>(vb);
    const s16x4 m0 = tr_read<v_rd_off(1, 0, 0)>(vb), n0 = tr_read<v_rd_off(1, 0, 1)>(vb), m1 = tr_read<v_rd_off(1, 1, 0)>(vb), n1 = tr_read<v_rd_off(1, 1, 1)>(vb);
    const s16x4 m2 = tr_read<v_rd_off(1, 2, 0)>(vb), n2 = tr_read<v_rd_off(1, 2, 1)>(vb), m3 = tr_read<v_rd_off(1, 3, 0)>(vb), n3 = tr_read<v_rd_off(1, 3, 1)>(vb);
#define PK(L, H) (bf16x8){L[0], L[1], L[2], L[3], H[0], H[1], H[2], H[3]}
    asm volatile("s_waitcnt lgkmcnt(8)" ::: "memory"); SBAR();
    o0 = __builtin_amdgcn_mfma_f32_32x32x16_bf16(pa0, PK(l0, h0), o0, 0, 0, 0); o0 = __builtin_amdgcn_mfma_f32_32x32x16_bf16(pa1, PK(l1, h1), o0, 0, 0, 0);
    o0 = __builtin_amdgcn_mfma_f32_32x32x16_bf16(pa2, PK(l2, h2), o0, 0, 0, 0); o0 = __builtin_amdgcn_mfma_f32_32x32x16_bf16(pa3, PK(l3, h3), o0, 0, 0, 0);
    asm volatile("s_waitcnt lgkmcnt(0)" ::: "memory"); SBAR();
    o1 = __builtin_amdgcn_mfma_f32_32x32x16_bf16(pa0, PK(m0, n0), o1, 0, 0, 0); o1 = __builtin_amdgcn_mfma_f32_32x32x16_bf16(pa1, PK(m1, n1), o1, 0, 0, 0);
    o1 = __builtin_amdgcn_mfma_f32_32x32x16_bf16(pa2, PK(m2, n2), o1, 0, 0, 0); o1 = __builtin_amdgcn_mfma_f32_32x32x16_bf16(pa3, PK(m3, n3), o1, 0, 0, 0);
#undef PK
}
struct Unit {
    const bf16_t* Q; int ldq;
    const bf16_t* K; int ldk;
    const bf16_t* V; int ldv;
    bf16_t* O; int ldo;
    int NT, n1, k1, k2;
    int qpos0;
    float sink; int has_sink, wv;
};
__device__ __forceinline__ void partialSM2(f32x16& p0, f32x16& p1, float& m_reg, float& mn, float& alpha) {
    float pmax = p0[0];
#pragma unroll
    for (int r = 1; r < 16; ++r) pmax = fmaxf(pmax, p0[r]);
#pragma unroll
    for (int r = 0; r < 16; ++r) pmax = fmaxf(pmax, p1[r]);
    { auto rr = __builtin_amdgcn_permlane32_swap(__float_as_uint(pmax), __float_as_uint(pmax), false, false); pmax = fmaxf(__uint_as_float(rr[0]), __uint_as_float(rr[1])); }
    if (__builtin_expect(__all(pmax - m_reg <= THR), 1)) { mn = m_reg; alpha = 1.f; }
    else { mn = fmaxf(m_reg, pmax); alpha = __builtin_amdgcn_exp2f(m_reg - mn); m_reg = mn; }
#pragma unroll
    for (int r = 0; r < 16; ++r) p0[r] -= mn;
#pragma unroll
    for (int r = 0; r < 16; ++r) p1[r] -= mn;
#pragma unroll
    for (int r = 0; r < 16; ++r) p0[r] = __builtin_amdgcn_exp2f(p0[r]);
}
template <int DQK, bool WIN>
__device__ __forceinline__ void attn_unit(const Unit& U, char* lds) {
    constexpr int NCH = DQK / 8;
    const int tid = tid_(U.wv), wid = U.wv, lane = tid & 63, r32 = lane & 31, hi = lane >> 5;
    char* V_lds = lds; char* K_lds = lds + NBUF * SHM_V;
    float* ws = (float*)(lds + NBUF * SHM_V + NBUF * SHM_K) + wid * 64; float* li_l = ws; float* al_l = ws + 32;
    float m_reg; f32x16 o[2], lacc; bf16x8 qr[DQK / 16]; bool force = false;
    const bf16x8 ones = {0x3F80, 0x3F80, 0x3F80, 0x3F80, 0x3F80, 0x3F80, 0x3F80, 0x3F80};
    const bf16_t* Qw = U.Q + (size_t)(wid * 32 + r32) * U.ldq + hi * 8;
#pragma unroll
    for (int d0 = 0; d0 < DQK / 16; ++d0) { qr[d0] = *reinterpret_cast<const bf16x8*>(Qw + d0 * 16);
#pragma unroll
        for (int e = 0; e < 8; ++e) qr[d0][e] = (short)f2bf(bf2f((bf16_t)qr[d0][e]) * LOG2E); }
    const int kc0 = tid, kr0 = kc0 / NCH, kcol0 = (kc0 % NCH) * 8;
    const int kc1 = tid + 512, kr1 = kc1 / NCH, kcol1 = (kc1 % NCH) * 8; const bool has1 = kc1 < 64 * NCH;
    const int vr = tid >> 3, vc = (tid & 7) * 8, vst = v_st(vr, vc);
    const int kst0 = KSWZ(kr0, kcol0 * 2), kst1 = KSWZ(kr1, kcol1 * 2);
    const int vb0 = (int)(uintptr_t)V_lds + v_rd_base(lane);
    const int qp = U.qpos0 + wid * 32 + r32;
    struct { bf16x8 k0, k1, v; } sr_[2];
#define TKEY(j) ((j) < U.n1 ? U.k1 + 64 * (j) : U.k2 + 64 * ((j) - U.n1))
#define SLOAD(i, j) do { const int _k0 = TKEY(j); sr_[i].k0 = *reinterpret_cast<const bf16x8*>(U.K + (size_t)(_k0 + kr0) * U.ldk + kcol0); \
    if (has1) sr_[i].k1 = *reinterpret_cast<const bf16x8*>(U.K + (size_t)(_k0 + kr1) * U.ldk + kcol1); \
    sr_[i].v = *reinterpret_cast<const bf16x8*>(U.V + (size_t)(_k0 + vr) * U.ldv + vc); } while (0)
#define SWRITE(b, i) do { *(bf16x8*)(V_lds + (b) * SHM_V + vst) = sr_[i].v; *(bf16x8*)(K_lds + (b) * SHM_K + kst0) = sr_[i].k0; \
    if (has1) *(bf16x8*)(K_lds + (b) * SHM_K + kst1) = sr_[i].k1; } while (0)
#define RESC(a) do { if (__any((a) < 1.f)) { if (hi == 0) al_l[r32] = (a); asm volatile("s_waitcnt lgkmcnt(0)" ::: "memory"); \
    _Pragma("unroll") for (int r = 0; r < 16; ++r) { const float a_ = al_l[crow(r, hi)]; o[0][r] *= a_; o[1][r] *= a_; lacc[r] *= a_; } } } while (0)
#define PSM(P0, P1, mn, al) do { if (force) partialSM2(P0, P1, m_reg, mn, al); else { al = 1.f; _Pragma("unroll") for (int r = 0; r < 16; ++r) P0[r] = __builtin_amdgcn_exp2f(P0[r]); } } while (0)
#define MASK(P0, P1, j) do { if (WIN && (j) >= U.n1) maskband(P0, P1, TKEY(j), qp, hi); } while (0)
#define PVD(vbase) do { pv_one<0>(o[0], vbase, pa0, pa1, pa2, pa3); pv_one<1>(o[1], vbase, pa0, pa1, pa2, pa3); \
    lacc = __builtin_amdgcn_mfma_f32_32x32x16_bf16(pa0, ones, lacc, 0, 0, 0); lacc = __builtin_amdgcn_mfma_f32_32x32x16_bf16(pa1, ones, lacc, 0, 0, 0); \
    lacc = __builtin_amdgcn_mfma_f32_32x32x16_bf16(pa2, ones, lacc, 0, 0, 0); lacc = __builtin_amdgcn_mfma_f32_32x32x16_bf16(pa3, ones, lacc, 0, 0, 0); } while (0)
    f32x16 pA0, pA1, pB0, pB1; float mnA, mnB, alA, alB; bf16x8 pa0, pa1, pa2, pa3; const int NT = U.NT;
    int* fl = (int*)(lds + NBUF * SHM_V + NBUF * SHM_K + 8 * 64 * 4);
#pragma unroll 1
    for (int pass = 0; pass < 2; ++pass) {
    m_reg = force ? -1e30f : 0.f; o[0] = o[1] = lacc = f32x16{};
#define M5(x) ((x) >= 5 ? (x) - 5 : (x))
    SLOAD(0, 0); SLOAD(1, 1); asm volatile("s_waitcnt vmcnt(0)" ::: "memory"); SWRITE(0, 0); SWRITE(1, 1);
    if (2 < NT) { SLOAD(0, 2); asm volatile("s_waitcnt vmcnt(0)" ::: "memory"); SWRITE(2, 0); }
    __syncthreads();
    if (3 < NT) SLOAD(0, 3); if (4 < NT) SLOAD(1, 4);
    qkt<DQK>(pA0, pA1, K_lds, qr, r32, hi); MASK(pA0, pA1, 0); PSM(pA0, pA1, mnA, alA);
    int sj = 1;
    for (int j = 1; j + 1 < NT; j += 2) {
        const int sp = M5(sj + 4), s1 = M5(sj + 1), s2 = M5(sj + 2), s3 = M5(sj + 3);
        SBAR(); qkt<DQK>(pB0, pB1, K_lds + sj * SHM_K, qr, r32, hi); MASK(pB0, pB1, j);
        finishSM(pA0, pA1, pa0, pa1, pa2, pa3); SBAR();
        PVD(vb0 + sp * SHM_V); PSM(pB0, pB1, mnB, alB);
        RESC(alB);
        SBAR(); qkt<DQK>(pA0, pA1, K_lds + s1 * SHM_K, qr, r32, hi); MASK(pA0, pA1, j + 1);
        finishSM(pB0, pB1, pa0, pa1, pa2, pa3); SBAR();
        if (j + 2 < NT) SWRITE(s2, 0); if (j + 3 < NT) SWRITE(s3, 1);
        if (j + 4 < NT) SLOAD(0, j + 4); if (j + 5 < NT) SLOAD(1, j + 5);
        PVD(vb0 + sj * SHM_V); PSM(pA0, pA1, mnA, alA);
        RESC(alA); __syncthreads();
        sj = s2;
    }
    { const int sp = M5(sj + 4);
      SBAR(); qkt<DQK>(pB0, pB1, K_lds + sj * SHM_K, qr, r32, hi); MASK(pB0, pB1, NT - 1);
      finishSM(pA0, pA1, pa0, pa1, pa2, pa3); SBAR();
      PVD(vb0 + sp * SHM_V); PSM(pB0, pB1, mnB, alB);
      RESC(alB);
      finishSM(pB0, pB1, pa0, pa1, pa2, pa3); SBAR();
      PVD(vb0 + sj * SHM_V); }
#undef M5
    if (WIN && U.has_sink) {
        if (hi == 0) li_l[r32] = __builtin_amdgcn_exp2f(U.sink * LOG2E - m_reg); asm volatile("s_waitcnt lgkmcnt(0)" ::: "memory");
#pragma unroll
        for (int r = 0; r < 16; ++r) lacc[r] += li_l[crow(r, hi)]; }
    if (pass) break;
    { bool bad = false;
#pragma unroll
      for (int r = 0; r < 16; ++r) bad |= !(lacc[r] > 8.7e-19f && lacc[r] < 1.1e18f);
      bad = __any(bad); __syncthreads();
      if (lane == 0) fl[wid] = bad ? 1 : 0; __syncthreads();
      const bool redo = __any(fl[lane & 7] != 0); __syncthreads();
      if (!redo) break; force = true; }
    }
    float rli[16];
#pragma unroll
    for (int r = 0; r < 16; ++r) rli[r] = __builtin_amdgcn_rcpf(lacc[r]);
    bf16_t* Ow = U.O + (size_t)(wid * 32) * U.ldo;
#pragma unroll
    for (int r = 0; r < 16; ++r) { const int orow = crow(r, hi);
#pragma unroll
        for (int d0 = 0; d0 < 2; ++d0) Ow[(size_t)orow * U.ldo + d0 * 32 + r32] = f2bf(o[d0][r] * rli[r]); }
    __syncthreads();
#undef TKEY
#undef SLOAD
#undef SWRITE
#undef RESC
#undef MASK
#undef PSM
#undef PVD
}

typedef __bf16 bf16x2_t __attribute__((ext_vector_type(2)));
typedef float f32x2_t __attribute__((ext_vector_type(2)));
__device__ __forceinline__ unsigned cvtpk2(float lo, float hi) { f32x2_t f = {lo, hi}; bf16x2_t b = __builtin_convertvector(f, bf16x2_t); return *reinterpret_cast<unsigned*>(&b); }
__device__ __forceinline__ void sl_pk(const f32x16& p, bf16x8& lo, bf16x8& hi) {
#define PK4(BASE, OUT) do { u32x4 w = {cvtpk2(p[BASE + 0], p[BASE + 1]), cvtpk2(p[BASE + 2], p[BASE + 3]), cvtpk2(p[BASE + 4], p[BASE + 5]), cvtpk2(p[BASE + 6], p[BASE + 7])}; OUT = *reinterpret_cast<bf16x8*>(&w); } while (0)
    PK4(0, lo); PK4(8, hi);
#undef PK4
}
template <int DQK>
__device__ __forceinline__ void attn_mla2(const Unit& U, char* lds) {
    constexpr int NCH = DQK / 8; constexpr float PLIM = 1073741824.f;
    const int tid = tid_(U.wv), wid = U.wv, lane = tid & 63, r32 = lane & 31, hi = lane >> 5;
    char* V_lds = lds; char* K_lds = lds + 4 * SHM_V;
    float* ws = (float*)(lds + 4 * SHM_V + 4 * SHM_K) + wid * 64; float* li_l = ws; float* al_l = ws + 32;
    float mA, mB, lA, lB; f32x16 oA[2], oB[2]; bf16x8 qA[DQK / 16], qB[DQK / 16]; bool refA, refB, force = false;
    { const bf16_t* Qw = U.Q + (size_t)(wid * 64 + r32) * U.ldq + hi * 8;
#pragma unroll
      for (int d0 = 0; d0 < DQK / 16; ++d0) { qA[d0] = *reinterpret_cast<const bf16x8*>(Qw + d0 * 16); qB[d0] = *reinterpret_cast<const bf16x8*>(Qw + (size_t)32 * U.ldq + d0 * 16);
#pragma unroll
        for (int e = 0; e < 8; ++e) { qA[d0][e] = (short)f2bf(bf2f((bf16_t)qA[d0][e]) * LOG2E); qB[d0][e] = (short)f2bf(bf2f((bf16_t)qB[d0][e]) * LOG2E); } } }
    const int kc0 = tid, kr0 = kc0 / NCH, kcol0 = (kc0 % NCH) * 8;
    const int kc1 = tid + 512, kr1 = kc1 / NCH, kcol1 = (kc1 % NCH) * 8; const bool has1 = kc1 < 64 * NCH;
    const int vr = tid >> 3, vc = (tid & 7) * 8, vst = v_st(vr, vc);
    const int kst0 = KSWZ(kr0, kcol0 * 2), kst1 = KSWZ(kr1, kcol1 * 2);
    const int vb0 = (int)(uintptr_t)V_lds + v_rd_base(lane);
    bf16x8 sk0, sk1, sv;
    typedef __attribute__((address_space(1))) const char* g_c_p; typedef __attribute__((address_space(1))) const bf16x8* g_b8_p;
    const unsigned ko0 = (unsigned)(kr0 * U.ldk + kcol0) * 2u, ko1 = (unsigned)(kr1 * U.ldk + kcol1) * 2u, vo = (unsigned)(vr * U.ldv + vc) * 2u;
#define SLOAD4(j) do { unsigned long long kj_ = (unsigned long long)((const char*)U.K + (size_t)(64 * (j)) * U.ldk * 2), vj_ = (unsigned long long)((const char*)U.V + (size_t)(64 * (j)) * U.ldv * 2); \
    asm volatile("" : "+s"(kj_), "+s"(vj_)); g_c_p Kj_ = (g_c_p)kj_; g_c_p Vj_ = (g_c_p)vj_; \
    sk0 = *(g_b8_p)(Kj_ + ko0); if (has1) sk1 = *(g_b8_p)(Kj_ + ko1); sv = *(g_b8_p)(Vj_ + vo); } while (0)
#define SWRITE4(b) do { *(bf16x8*)(V_lds + (b) * SHM_V + vst) = sv; *(bf16x8*)(K_lds + (b) * SHM_K + kst0) = sk0; if (has1) *(bf16x8*)(K_lds + (b) * SHM_K + kst1) = sk1; } while (0)
#define SOFTMAX4(S0, S1, q, m, refnz, l, o, f0, f1, f2, f3, Ks) do { \
    float ps_ = 0.f; \
    if (refnz) { _Pragma("unroll") for (int r = 0; r < 16; ++r) { S0[r] -= (m); S1[r] -= (m); } } \
    _Pragma("unroll") for (int r = 0; r < 16; ++r) S0[r] = __builtin_amdgcn_exp2f(S0[r]); \
    _Pragma("unroll") for (int r = 0; r < 16; ++r) S1[r] = __builtin_amdgcn_exp2f(S1[r]); \
    _Pragma("unroll") for (int r = 0; r < 16; ++r) ps_ += S0[r]; \
    _Pragma("unroll") for (int r = 0; r < 16; ++r) ps_ += S1[r]; \
    { auto rr_ = __builtin_amdgcn_permlane32_swap(__float_as_uint(ps_), __float_as_uint(ps_), false, false); ps_ = __uint_as_float(rr_[0]) + __uint_as_float(rr_[1]); } \
    if (__builtin_expect(force || (MK_TEST == 1 && first_) || __any(!(ps_ <= PLIM)), 0)) { \
        qkt<DQK>(S0, S1, Ks, q, r32, hi); \
        float pm_ = S0[0]; \
        _Pragma("unroll") for (int r = 1; r < 16; ++r) pm_ = fmaxf(pm_, S0[r]); \
        _Pragma("unroll") for (int r = 0; r < 16; ++r) pm_ = fmaxf(pm_, S1[r]); \
        { auto rr_ = __builtin_amdgcn_permlane32_swap(__float_as_uint(pm_), __float_as_uint(pm_), false, false); pm_ = fmaxf(__uint_as_float(rr_[0]), __uint_as_float(rr_[1])); } \
        const float mn_ = fmaxf(m, pm_), al_ = __builtin_amdgcn_exp2f((m) - mn_); m = mn_; l *= al_; refnz = true; \
        if (hi == 0) al_l[r32] = al_; asm volatile("s_waitcnt lgkmcnt(0)" ::: "memory"); \
        _Pragma("unroll") for (int r = 0; r < 16; ++r) { const float a_ = al_l[crow(r, hi)]; o[0][r] *= a_; o[1][r] *= a_; } \
        ps_ = 0.f; \
        _Pragma("unroll") for (int r = 0; r < 16; ++r) { S0[r] = __builtin_amdgcn_exp2f(S0[r] - mn_); ps_ += S0[r]; } \
        _Pragma("unroll") for (int r = 0; r < 16; ++r) { S1[r] = __builtin_amdgcn_exp2f(S1[r] - mn_); ps_ += S1[r]; } \
        { auto rr_ = __builtin_amdgcn_permlane32_swap(__float_as_uint(ps_), __float_as_uint(ps_), false, false); ps_ = __uint_as_float(rr_[0]) + __uint_as_float(rr_[1]); } \
    } \
    l += ps_; \
    { bf16x8 t0_, t1_; sl_pk(S0, t0_, t1_); f0 = t0_; f1 = t1_; sl_pk(S1, t0_, t1_); f2 = t0_; f3 = t1_; } \
} while (0)
    const int NT = U.NT;
#define W2ND do { if (j + 2 < NT) SWRITE4((b0 ^ 2) + 1); if (j + 4 < NT) SLOAD4(j + 4); } while (0)
#define TILE4(b, HOOK) do { \
        f32x16 pA0 = {}, pA1 = {}, pB0 = {}, pB1 = {}; \
        const char* Ks = K_lds + (b) * SHM_K; \
        _Pragma("unroll") for (int d0 = 0; d0 < DQK / 16; ++d0) { const int cb = (d0 * 16 + hi * 8) * 2; \
            const bf16x8 k0 = *reinterpret_cast<const bf16x8*>(Ks + KSWZ(r32, cb)), k1 = *reinterpret_cast<const bf16x8*>(Ks + KSWZ(32 + r32, cb)); \
            pA0 = __builtin_amdgcn_mfma_f32_32x32x16_bf16(k0, qA[d0], pA0, 0, 0, 0); pA1 = __builtin_amdgcn_mfma_f32_32x32x16_bf16(k1, qA[d0], pA1, 0, 0, 0); \
            pB0 = __builtin_amdgcn_mfma_f32_32x32x16_bf16(k0, qB[d0], pB0, 0, 0, 0); pB1 = __builtin_amdgcn_mfma_f32_32x32x16_bf16(k1, qB[d0], pB1, 0, 0, 0); } \
        bf16x8 pa0, pa1, pa2, pa3, pb0, pb1, pb2, pb3; \
        SOFTMAX4(pA0, pA1, qA, mA, refA, lA, oA, pa0, pa1, pa2, pa3, Ks); \
        pv_one<0>(oA[0], vb0 + (b) * SHM_V, pa0, pa1, pa2, pa3); pv_one<1>(oA[1], vb0 + (b) * SHM_V, pa0, pa1, pa2, pa3); \
        SOFTMAX4(pB0, pB1, qB, mB, refB, lB, oB, pb0, pb1, pb2, pb3, Ks); \
        HOOK; \
        pv_one<0>(oB[0], vb0 + (b) * SHM_V, pb0, pb1, pb2, pb3); pv_one<1>(oB[1], vb0 + (b) * SHM_V, pb0, pb1, pb2, pb3); \
    } while (0)
    int* fl = (int*)(lds + 4 * SHM_V + 4 * SHM_K + 8 * 64 * 4);
#pragma unroll 1
    for (int pass = 0; pass < 2; ++pass) {
    mA = mB = force ? -1e30f : 0.f; lA = lB = 0.f; refA = refB = false; oA[0] = oA[1] = oB[0] = oB[1] = f32x16{};
    SLOAD4(0); asm volatile("s_waitcnt vmcnt(0)" ::: "memory"); SWRITE4(0); SLOAD4(1); asm volatile("s_waitcnt vmcnt(0)" ::: "memory"); SWRITE4(1); __syncthreads();
    if (2 < NT) SLOAD4(2);
    asm volatile(".p2align 8");
#pragma unroll 1
    for (int j = 0; j < NT; j += 2) {
        const bool first_ = j == 0;
        const int b0 = j & 3;
        TILE4(b0, (void)0);
        if (j + 2 < NT) { SWRITE4(b0 ^ 2); SLOAD4(j + 3); }
        SBAR();
        TILE4(b0 + 1, W2ND);
        __syncthreads();
    }
    if (pass) break;
    { const bool bad = (MK_TEST == 2) || __any(!(lA > 1e-30f) || !(lB > 1e-30f));
      if (lane == 0) fl[wid] = bad ? 1 : 0; __syncthreads();
      const bool redo = __any(fl[lane & 7] != 0); __syncthreads();
      if (!redo) break; force = true; }
    }
#pragma unroll
    for (int t = 0; t < 2; ++t) {
        if (hi == 0) li_l[r32] = t ? lB : lA; asm volatile("s_waitcnt lgkmcnt(0)" ::: "memory");
        bf16_t* Ow = U.O + (size_t)(wid * 64 + t * 32) * U.ldo;
#pragma unroll
        for (int r = 0; r < 16; ++r) { const int orow = crow(r, hi); const float rl = __builtin_amdgcn_rcpf(li_l[orow]);
#pragma unroll
            for (int d0 = 0; d0 < 2; ++d0) Ow[(size_t)orow * U.ldo + d0 * 32 + r32] = f2bf((t ? oB[d0][r] : oA[d0][r]) * rl); }
        asm volatile("s_waitcnt lgkmcnt(0)" ::: "memory");
    }
    __syncthreads();
#undef SLOAD4
#undef SWRITE4
#undef SOFTMAX4
#undef TILE4
#undef W2ND
}
}

__device__ __forceinline__ void phase_mla(const Params& p, lds_t* lds, int l) {
    for (int L = bid_(); L < 256; L += gridDim.x) {
        const int u = gridDim.x == 256 ? ((((L & 7) + 8 * ((L >> 3) & 1)) << 4) | (L >> 4)) : L;
        const int qb = u & 15, h = (u >> 4) & 3, b = u >> 6; const int r0 = b * 8192 + qb * 512;
        att::Unit U{}; U.Q = SP(bf16_t, S_QM) + (size_t)r0 * 384 + h * 96; U.NT = 132; U.O = SP(bf16_t, S_CAT) + (size_t)r0 * 1280 + 768 + h * 64;
        U.K = SP(bf16_t, S_KM) + ((size_t)b * 4 + h) * NKEY * 96; U.V = SP(bf16_t, S_VM) + ((size_t)b * 4 + h) * NKEY * 64;
        U.ldq = 384; U.ldk = 96; U.ldv = 64; U.ldo = 1280; U.wv = p.wv;
        att::attn_mla2<96>(U, (char*)lds);
    }
    if (l == 0) for (int c = bid_(); c < 16; c += gridDim.x) {
        const int h = c & 3, b = c >> 2; const int r0 = TL + b * 256;
        att::Unit U{}; U.Q = SP(bf16_t, S_QM) + (size_t)r0 * 384 + h * 96; U.NT = 4; U.n1 = 4; U.k1 = 8192; U.O = SP(bf16_t, S_CAT) + (size_t)r0 * 1280 + 768 + h * 64;
        U.K = SP(bf16_t, S_KM) + ((size_t)b * 4 + h) * NKEY * 96; U.V = SP(bf16_t, S_VM) + ((size_t)b * 4 + h) * NKEY * 64;
        U.ldq = 384; U.ldk = 96; U.ldv = 64; U.ldo = 1280; U.wv = p.wv;
        att::attn_unit<96, false>(U, (char*)lds);
    }
}
__device__ __forceinline__ void phase_win(const Params& p, lds_t* lds, int l) {
    const int nun = 512 + (l == 0 ? 16 : 0);
    for (int u = bid_(); u < nun; u += gridDim.x) {
        att::Unit U{}; int b, h, r0;
        if (u < 512) { const int qb = u & 31; h = (u >> 5) & 3; b = u >> 7; r0 = b * 8192 + qb * 256; const int q0 = qb * 256;
            const int klo = q0 - 128 < 0 ? 0 : q0 - 128, khi = q0 + 384 > 8192 ? 8192 : q0 + 384;
            U.n1 = 4; U.k1 = 8192; U.k2 = klo; U.NT = 4 + (khi - klo) / 64; U.qpos0 = q0; }
        else { h = (u - 512) & 3; b = (u - 512) >> 2; r0 = TL + b * 256; U.n1 = 4; U.k1 = 8192; U.k2 = 0; U.NT = 4; U.qpos0 = 0; }
        U.Q = SP(bf16_t, S_QW) + (size_t)r0 * 256 + h * 64; U.ldq = 256;
        U.K = SP(bf16_t, S_KW) + (size_t)b * NKEY * 128 + (h >> 1) * 64; U.ldk = 128; U.V = SP(bf16_t, S_VW) + (size_t)b * NKEY * 128 + (h >> 1) * 64; U.ldv = 128;
        U.O = SP(bf16_t, S_CAT) + (size_t)r0 * 1280 + 512 + h * 64; U.ldo = 1280; U.sink = p.win_sink[l * 4 + h]; U.has_sink = 1; U.wv = p.wv;
        att::attn_unit<64, true>(U, (char*)lds);
    }
}


namespace sg {
using bf16x8 = __attribute__((ext_vector_type(8))) short;
using s16x4 = __attribute__((ext_vector_type(4))) short;
using f32x16 = __attribute__((ext_vector_type(16))) float;
__device__ __forceinline__ int crow(int r, int hi) { return (r & 3) + 8 * (r >> 2) + 4 * hi; }
__device__ __forceinline__ int b_off(int k, int n8, int NB32) { return ((k >> 3) * NB32 + (n8 >> 2)) * 512 + (k & 7) * 64 + (n8 & 3) * 16; }
__device__ __forceinline__ int tr_lane(int lane, int NB32) { return (((lane & 15) >> 2) * 64) + (((lane >> 4) & 1) * 32) + ((lane & 3) * 8) + (lane >> 5) * NB32 * 512; }
__device__ __forceinline__ s16x4 tr_read(int addr) { s16x4 r; asm volatile("ds_read_b64_tr_b16 %0, %1" : "=&v"(r) : "v"(addr) : "memory"); return r; }
template <int MT, int KS, bool SWAP = false>
__device__ __forceinline__ void mma_block(f32x16 (&acc)[MT][2], const bf16x8 (&af)[MT][KS], int base, int NB32, int nb0) {
#pragma unroll
    for (int ks = 0; ks < KS; ++ks) {
        const int a0 = base + ((2 * ks) * NB32 + nb0) * 512;
        const s16x4 l0 = tr_read(a0), h0 = tr_read(a0 + 256), l1 = tr_read(a0 + 512), h1 = tr_read(a0 + 512 + 256);
        asm volatile("s_waitcnt lgkmcnt(0)" ::: "memory"); __builtin_amdgcn_sched_barrier(0);
        const bf16x8 b0 = (bf16x8){l0[0], l0[1], l0[2], l0[3], h0[0], h0[1], h0[2], h0[3]}, b1 = (bf16x8){l1[0], l1[1], l1[2], l1[3], h1[0], h1[1], h1[2], h1[3]};
#pragma unroll
        for (int mt = 0; mt < MT; ++mt) {
            if constexpr (SWAP) { acc[mt][0] = __builtin_amdgcn_mfma_f32_32x32x16_bf16(b0, af[mt][ks], acc[mt][0], 0, 0, 0); acc[mt][1] = __builtin_amdgcn_mfma_f32_32x32x16_bf16(b1, af[mt][ks], acc[mt][1], 0, 0, 0); }
            else { acc[mt][0] = __builtin_amdgcn_mfma_f32_32x32x16_bf16(af[mt][ks], b0, acc[mt][0], 0, 0, 0); acc[mt][1] = __builtin_amdgcn_mfma_f32_32x32x16_bf16(af[mt][ks], b1, acc[mt][1], 0, 0, 0); } }
    }
}
template <int KR, int NC>
__device__ __forceinline__ void stage_b(char* lds, const bf16_t* src, size_t ld, int tid) {
    constexpr int CH = NC / 8, TOT = KR * CH;
#pragma unroll
    for (int c = tid; c < TOT; c += 512) { const int k = c / CH, n8 = c % CH;
        *(bf16x8*)(lds + b_off(k, n8, NC / 32)) = *(const bf16x8*)(src + (size_t)k * ld + n8 * 8); }
}
}

__device__ __forceinline__ void phase_fft_a(const Params& p, lds_t* lds_) {
    char* lds = (char*)lds_;
    const int tid = tid_(p.wv), w = p.wv, lane = tid & 63, r32 = lane & 31, hi = lane >> 5, kb = w & 3;
    sg::bf16x8 af[2][8];
#pragma unroll
    for (int mt = 0; mt < 2; ++mt)
#pragma unroll
        for (int ks = 0; ks < 8; ++ks) af[mt][ks] = *(const sg::bf16x8*)(WSP(bf16_t, OFF_FA) + (size_t)(kb * 64 + mt * 32 + r32) * 128 + ks * 16 + 8 * hi);
    const int base = (int)(uintptr_t)lds + sg::tr_lane(lane, 4);
    for (int u = bid_(); u < 512; u += gridDim.x) {
        const int b = u >> 7, T = u & 127;
        sg::stage_b<128, 128>(lds, SP(bf16_t, S_ABUF) + (size_t)b * 8192 * 256 + T * 128, 16384, tid);
        __syncthreads();
        sg::f32x16 acc[2][2] = {};
        sg::mma_block<2, 8>(acc, af, base, 4, 2 * (w >> 2));
        const int n2 = T >> 1, cb = (T & 1) * 128 + 64 * (w >> 2) + r32;
#pragma unroll
        for (int r = 0; r < 16; ++r) { const int k1 = kb * 32 + sg::crow(r, hi); const float2 t = WSP(float2, OFF_TW)[n2 * 128 + k1];
            bf16_t* o = SP(bf16_t, S_UP) + ((((size_t)b * 128 + k1) * 2) * 64 + n2) * 256 + cb;
#pragma unroll
            for (int nt = 0; nt < 2; ++nt) { const float ur = acc[0][nt][r], ui = acc[1][nt][r]; o[nt * 32] = f2bf(ur * t.x + ui * t.y); o[64 * 256 + nt * 32] = f2bf(ui * t.x - ur * t.y); } }
        __syncthreads();
    }
}
__device__ __forceinline__ void phase_fft_c(const Params& p, lds_t* lds_) {
    char* lds = (char*)lds_;
    const int tid = tid_(p.wv), w = p.wv, lane = tid & 63, r32 = lane & 31, hi = lane >> 5, rio = w & 1;
    sg::bf16x8 af[2][8];
#pragma unroll
    for (int mt = 0; mt < 2; ++mt)
#pragma unroll
        for (int ks = 0; ks < 8; ++ks) af[mt][ks] = *(const sg::bf16x8*)(WSP(bf16_t, OFF_GM) + (size_t)(rio * 64 + mt * 32 + r32) * 128 + ks * 16 + 8 * hi);
    const int base = (int)(uintptr_t)lds + sg::tr_lane(lane, 8);
    for (int u = bid_(); u < 512; u += gridDim.x) {
        const int b = u >> 7, k1 = u & 127;
        sg::stage_b<128, 256>(lds, SP(bf16_t, S_UP) + (size_t)u * 128 * 256, 256, tid);
        __syncthreads();
        sg::f32x16 acc[2][2] = {};
        sg::mma_block<2, 8>(acc, af, base, 8, 2 * (w >> 1));
#pragma unroll
        for (int mt = 0; mt < 2; ++mt)
#pragma unroll
            for (int r = 0; r < 16; ++r) { const int k2 = mt * 32 + sg::crow(r, hi);
                bf16_t* o = SP(bf16_t, S_CAT) + ((size_t)b * 8192 + k1 + 128 * k2) * 1280 + rio * 256 + 64 * (w >> 1) + r32;
                o[0] = f2bf(acc[mt][0][r]); o[32] = f2bf(acc[mt][1][r]); }
        __syncthreads();
    }
}
__device__ __forceinline__ void phase_dft_ctx(const Params& p, lds_t* lds_) {
    char* lds = (char*)lds_;
    const int tid = tid_(p.wv), w = p.wv, lane = tid & 63, r32 = lane & 31, hi = lane >> 5;
    const int base = (int)(uintptr_t)lds + sg::tr_lane(lane, 4);
    for (int u = (int)gridDim.x - 64 - bid_(); u < 32; u += gridDim.x) { if (u < 0) continue;
        const int b = u >> 3, mb = (u >> 1) & 3, nh = u & 1;
        sg::bf16x8 af[1][16];
#pragma unroll
        for (int ks = 0; ks < 16; ++ks) af[0][ks] = *(const sg::bf16x8*)(WSP(bf16_t, OFF_FC) + (size_t)(mb * 128 + 32 * (w & 3) + r32) * 256 + ks * 16 + 8 * hi);
        sg::stage_b<256, 128>(lds, SP(bf16_t, S_ABUF) + ((size_t)TL + b * 256) * 256 + nh * 128, 256, tid);
        __syncthreads();
        sg::f32x16 acc[1][2] = {};
        sg::mma_block<1, 16>(acc, af, base, 4, 2 * (w >> 2));
#pragma unroll
        for (int r = 0; r < 16; ++r) { const int row = mb * 128 + 32 * (w & 3) + sg::crow(r, hi), ri = row >> 8, k = row & 255;
            bf16_t* o = SP(bf16_t, S_CAT) + ((size_t)TL + b * 256 + k) * 1280 + ri * 256 + nh * 128 + 64 * (w >> 2) + r32;
            o[0] = f2bf(acc[0][0][r]); o[32] = f2bf(acc[0][1][r]); }
        __syncthreads();
    }
}
__device__ __forceinline__ void phase_sgu(const Params& p, lds_t* lds_, int l) {
    char* lds = (char*)lds_;
    const int tid = tid_(p.wv), w = p.wv, lane = tid & 63, r32 = lane & 31, hi = lane >> 5, g = w >> 1, mh = w & 1;
    sg::bf16x8 af[2][8];
#pragma unroll
    for (int mt = 0; mt < 2; ++mt)
#pragma unroll
        for (int ks = 0; ks < 8; ++ks) { const float* src = p.sgu_w + ((size_t)(l * 4 + g) * 128 + mh * 64 + mt * 32 + r32) * 128 + ks * 16 + 8 * hi;
            const float4 a = *(const float4*)src, b = *(const float4*)(src + 4); const float v[8] = {a.x, a.y, a.z, a.w, b.x, b.y, b.z, b.w}; const pg8::u32x4 pk = pack8(v); af[mt][ks] = *(const sg::bf16x8*)&pk; }
    const int base = (int)(uintptr_t)lds + sg::tr_lane(lane, 8);
    const int nch = l == 0 ? RR / 128 : TL / 128;
    for (int u = (int)((bid_() + (gridDim.x >> 1)) % gridDim.x); u < nch; u += gridDim.x) {
        const int r0 = u * 128;
#pragma unroll
        for (int c = tid; c < 128 * 32; c += 512) { const int q = c >> 5, n8 = c & 31;
            const float* st = WSP(float, OFF_LNS) + (size_t)(r0 + q) * 8; const float4 sa = *(const float4*)st, sb = *(const float4*)(st + 4);
            const float s1 = (sa.x + sa.z) + (sb.x + sb.z), s2 = (sa.y + sa.w) + (sb.y + sb.w), mu = s1 * (1.f / 256.f), rstd = rsqrtf(fmaxf(s2 * (1.f / 256.f) - mu * mu, 0.f) + EPS);
            const pg8::u32x4 raw = *(const pg8::u32x4*)(SP(bf16_t, S_VG) + (size_t)(r0 + q) * 256 + n8 * 8); float v[8];
#pragma unroll
            for (int e = 0; e < 4; ++e) { v[2 * e] = (__uint_as_float(raw[e] << 16) - mu) * rstd; v[2 * e + 1] = (__uint_as_float(raw[e] & 0xffff0000u) - mu) * rstd; }
            *(pg8::u32x4*)(lds + sg::b_off(q, n8, 8)) = pack8(v); }
        __syncthreads();
        sg::f32x16 acc[2][2] = {};
        sg::mma_block<2, 8, true>(acc, af, base, 8, 2 * g);
        bf16_t* simg = (bf16_t*)(lds + 65536);
#pragma unroll
        for (int mt = 0; mt < 2; ++mt) { const int pp = mh * 64 + mt * 32 + r32; const float bias = p.sgu_b[(l * 4 + g) * 128 + pp];
#pragma unroll
            for (int nt = 0; nt < 2; ++nt)
#pragma unroll
                for (int t4 = 0; t4 < 4; ++t4) { pg8::u32x2 w; w.x = pg8::cvt_pk_bf16(acc[mt][nt][4 * t4] + bias, acc[mt][nt][4 * t4 + 1] + bias); w.y = pg8::cvt_pk_bf16(acc[mt][nt][4 * t4 + 2] + bias, acc[mt][nt][4 * t4 + 3] + bias);
                    *(pg8::u32x2*)(simg + pp * 256 + g * 64 + nt * 32 + 8 * t4 + 4 * hi) = w; } }
        __syncthreads();
#pragma unroll
        for (int c = tid; c < 128 * 32; c += 512) { const int pp = c >> 5, n8 = c & 31; const size_t row = (size_t)r0 + pp;
            const pg8::u32x4 sv = *(const pg8::u32x4*)(simg + pp * 256 + n8 * 8), uv = *(const pg8::u32x4*)(SP(bf16_t, S_U) + row * 256 + n8 * 8); float v[8];
#pragma unroll
            for (int e = 0; e < 4; ++e) { v[2 * e] = __uint_as_float(sv[e] << 16) * __uint_as_float(uv[e] << 16); v[2 * e + 1] = __uint_as_float(sv[e] & 0xffff0000u) * __uint_as_float(uv[e] & 0xffff0000u); }
            *(pg8::u32x4*)(SP(bf16_t, S_CAT) + row * 1280 + 1024 + n8 * 8) = pack8(v); }
    }
    __syncthreads();
}
enum { PH_CVT = 0, PH_FFN_GU, PH_FFN_DN, PH_MOE_GU, PH_MOE_DN, PH_INPROJ, PH_UP, PH_OUTPROJ, PH_MLA, PH_WIN, PH_FFTA, PH_FFTC, PH_DFTC, PH_SGU, PH_PROA, PH_PROB, PH_NORM1, PH_POSTMIX, PH_ASSIGN, PH_POSTFFN };

__device__ __forceinline__ float wave_sum(float v) {
    const int l4 = lane_() << 2;
#pragma unroll
    for (int o = 32; o > 0; o >>= 1) v += __int_as_float(__builtin_amdgcn_ds_bpermute(l4 ^ (o << 2), __float_as_int(v)));
    return v;
}
__device__ __forceinline__ const float* hx_in_row(const Params& p, int l, int r) {
    if (l == 0) return r < TL ? p.x + (size_t)r * 1024 : p.ctx + (size_t)(r - TL) * 1024;
    return r < TL ? p.out + (size_t)r * 1024 : WSP(float, OFF_HXC) + (size_t)(r - TL) * 1024;
}
__device__ __forceinline__ float* hx_row(const Params& p, int r) { return r < TL ? p.out + (size_t)r * 1024 : WSP(float, OFF_HXC) + (size_t)(r - TL) * 1024; }
__device__ __forceinline__ void store4bf(bf16_t* dst, const float4 v) { pg8::u32x2 w; w.x = pg8::cvt_pk_bf16(v.x, v.y); w.y = pg8::cvt_pk_bf16(v.z, v.w); *(pg8::u32x2*)dst = w; }
__device__ __forceinline__ float4 load4bf(const bf16_t* src) { const pg8::u32x2 w = *(const pg8::u32x2*)src; return make_float4(__uint_as_float(w.x << 16), __uint_as_float(w.x & 0xffff0000u), __uint_as_float(w.y << 16), __uint_as_float(w.y & 0xffff0000u)); }
__device__ __forceinline__ float4 hx_load4(const Params& p, int kind, int r, int k) {
    if (kind == 0) return *(const float4*)((r < TL ? p.x + (size_t)r * 1024 : p.ctx + (size_t)(r - TL) * 1024) + k);
    if (r < TL) return load4bf((const bf16_t*)((const char*)p.out + (size_t)r * 4096 + 2048) + k);
    return *(const float4*)(WSP(float, OFF_HXC) + (size_t)(r - TL) * 1024 + k);
}
__device__ __forceinline__ void hx_store4(const Params& p, int r, int k, const float4 v) {
    if (r < TL) store4bf((bf16_t*)((char*)p.out + (size_t)r * 4096 + 2048) + k, v);
    else *(float4*)(WSP(float, OFF_HXC) + (size_t)(r - TL) * 1024 + k) = v;
}
#define F4OP(dst, expr) do { (dst).x = (expr(x)); (dst).y = (expr(y)); (dst).z = (expr(z)); (dst).w = (expr(w)); } while (0)
__device__ __forceinline__ float half_sum(float v) {
    const int l4 = lane_() << 2;
#pragma unroll
    for (int o = 16; o > 0; o >>= 1) v += __int_as_float(__builtin_amdgcn_ds_bpermute(l4 ^ (o << 2), __float_as_int(v)));
    return v;
}
__device__ __forceinline__ float qsum(float v) {
    const int l4 = lane_() << 2;
#pragma unroll
    for (int o = 8; o > 0; o >>= 1) v += __int_as_float(__builtin_amdgcn_ds_bpermute(l4 ^ (o << 2), __float_as_int(v)));
    return v;
}
#define SQ4(v) ((v).x * (v).x + (v).y * (v).y + (v).z * (v).z + (v).w * (v).w)
struct V8 { float v[8]; };
__device__ __forceinline__ V8 ld8_f32(const float* q) { const float4 a = *(const float4*)q, b = *(const float4*)(q + 4); return V8{{a.x, a.y, a.z, a.w, b.x, b.y, b.z, b.w}}; }
__device__ __forceinline__ V8 ld8_bf16(const bf16_t* q) { const pg8::u32x4 w = *(const pg8::u32x4*)q; V8 r;
#pragma unroll
    for (int e = 0; e < 4; ++e) { r.v[2 * e] = __uint_as_float(w[e] << 16); r.v[2 * e + 1] = __uint_as_float(w[e] & 0xffff0000u); } return r; }
__device__ __forceinline__ void st8_bf16(bf16_t* q, const V8& a) { *(pg8::u32x4*)q = pack8(a.v); }
__device__ __forceinline__ void st8_f32nt(float* q, const V8& a) { __builtin_nontemporal_store((pg8::f32x4){a.v[0], a.v[1], a.v[2], a.v[3]}, (pg8::f32x4*)q); __builtin_nontemporal_store((pg8::f32x4){a.v[4], a.v[5], a.v[6], a.v[7]}, (pg8::f32x4*)(q + 4)); }
__device__ __forceinline__ void st8_fp8(unsigned char* q, const V8& a) { pg8::u32x2 w; w.x = fp8x4(clamp448(a.v[0]), clamp448(a.v[1]), clamp448(a.v[2]), clamp448(a.v[3])); w.y = fp8x4(clamp448(a.v[4]), clamp448(a.v[5]), clamp448(a.v[6]), clamp448(a.v[7])); *(pg8::u32x2*)q = w; }
__device__ __forceinline__ float sq8(const V8& a) { float s = 0;
#pragma unroll
    for (int e = 0; e < 8; ++e) s += a.v[e] * a.v[e]; return s; }
__device__ __forceinline__ V8 hx_load8(const Params& p, int kind, int r, int k) {
    if (kind == 0) return ld8_f32((r < TL ? p.x + (size_t)r * 1024 : p.ctx + (size_t)(r - TL) * 1024) + k);
    if (r < TL) return ld8_bf16((const bf16_t*)((const char*)p.out + (size_t)r * 4096 + 2048) + k);
    return ld8_f32(WSP(float, OFF_HXC) + (size_t)(r - TL) * 1024 + k);
}
__device__ __forceinline__ void hx_store8(const Params& p, int r, int k, const V8& a) {
    if (r < TL) st8_bf16((bf16_t*)((char*)p.out + (size_t)r * 4096 + 2048) + k, a);
    else { *(float4*)(WSP(float, OFF_HXC) + (size_t)(r - TL) * 1024 + k) = make_float4(a.v[0], a.v[1], a.v[2], a.v[3]); *(float4*)(WSP(float, OFF_HXC) + (size_t)(r - TL) * 1024 + k + 4) = make_float4(a.v[4], a.v[5], a.v[6], a.v[7]); }
}
typedef __attribute__((address_space(3))) float lds_fl;
__device__ __forceinline__ V8 lds8(const lds_fl* q) { const pg8::f32x4 a = *(const __attribute__((address_space(3))) pg8::f32x4*)q, b = *(const __attribute__((address_space(3))) pg8::f32x4*)(q + 4); return V8{{a[0], a[1], a[2], a[3], b[0], b[1], b[2], b[3]}}; }
constexpr int EW_PAR_OFF = 49152;
__device__ __forceinline__ int seg_end(int r0, int rend) { const int nb = r0 < TL ? ((((r0 >> 13) + 1) << 13) < TL ? (((r0 >> 13) + 1) << 13) : TL) : RR; return nb < rend ? nb : rend; }
__device__ __forceinline__ void phase_norm1(const Params& p, lds_t* lds, int l) {
    const int tid = tid_(p.wv), lane = tid & 63, sl0 = lane & 15, q = p.wv * 4 + (lane >> 4), G = gridDim.x, RPB = (RR + G - 1) / G;
    lds_fl* par = (lds_fl*)(lds + EW_PAR_OFF);
    const int rbeg = bid_() * RPB, rend = rbeg + RPB < RR ? rbeg + RPB : RR;
    for (int r0 = rbeg; r0 < rend;) { const int r1 = seg_end(r0, rend); const float* mod = WSP(float, OFF_MOD) + ((size_t)l * 5 + row_cond(r0)) * 6144;
        __syncthreads();
        for (int i = tid; i < 1024; i += 512) { par[i] = p.g_pre_mix[l * 1024 + i]; par[1024 + i] = 1.f + mod[1024 + i]; par[2048 + i] = mod[i]; }
        __syncthreads();
        for (int rw = r0 + p.wv * 4; rw < r1; rw += 32) {
            int sl = sl0; asm volatile("" : "+v"(sl));
            const int rr = rw + (lane >> 4); const bool ok = rr < r1; const int r = ok ? rr : r0;
            V8 v[8]; float ss = 0;
#pragma unroll
            for (int i = 0; i < 8; ++i) { v[i] = hx_load8(p, l == 0 ? 0 : 1, r, sl * 8 + 128 * i); ss += sq8(v[i]); }
            const float rstd = rsqrtf(qsum(ss) * (1.f / 1024.f) + EPS);
#pragma unroll
            for (int i = 0; i < 8; ++i) { const int k = sl * 8 + 128 * i; const V8 gg = lds8(par + k), sc = lds8(par + 1024 + k), sh = lds8(par + 2048 + k); V8 y;
#pragma unroll
                for (int e = 0; e < 8; ++e) y.v[e] = v[i].v[e] * rstd * gg.v[e] * sc.v[e] + sh.v[e];
                if (ok) st8_bf16(WSP(bf16_t, OFF_XN) + (size_t)r * 1024 + k, y); }
        }
        r0 = r1; }
    __syncthreads(); (void)q;
}
__device__ __forceinline__ void phase_postmix(const Params& p, lds_t* lds, int l) {
    const int tid = tid_(p.wv), lane = tid & 63, sl0 = lane & 15, G = gridDim.x, g = (bid_() * 8 + p.wv) * 4 + (lane >> 4);
    const int nrows = l == 0 ? RR : TL, RPB = (nrows + G - 1) / G;
    if (l == 1) for (int i = bid_() * 512 + tid; i < NSORT; i += G * 512) WSP(int, OFF_ROWIDX)[i] = 0;
    int wcnt[8] = {0, 0, 0, 0, 0, 0, 0, 0};
    typedef __attribute__((address_space(3))) pg8::f32x4 lds_f4;
    const lds_f4* wrl = (const lds_f4*)lds;
    lds_fl* par = (lds_fl*)(lds + EW_PAR_OFF);
    if (l == 1) { for (int i = tid; i < 2048; i += 512) ((lds_f4*)lds)[i] = ((const pg8::f32x4*)p.moe_w_router)[i]; }
    const int rbeg = bid_() * RPB, rend = rbeg + RPB < nrows ? rbeg + RPB : nrows;
    for (int r0 = rbeg; r0 < rend;) { const int r1 = seg_end(r0, rend); const float* mod = WSP(float, OFF_MOD) + ((size_t)l * 5 + row_cond(r0)) * 6144;
        __syncthreads();
        for (int i = tid; i < 1024; i += 512) { par[i] = p.g_post_mix[l * 1024 + i] * mod[2048 + i]; par[1024 + i] = p.g_pre_ffn[l * 1024 + i] * (1.f + mod[4096 + i]); par[2048 + i] = mod[3072 + i]; }
        __syncthreads();
        for (int rw = r0 + p.wv * 4; rw < r1; rw += 32) {
            int sl = sl0; asm volatile("" : "+v"(sl));
            const int rr = rw + (lane >> 4); const bool ok = rr < r1; const int r = ok ? rr : r0;
            pg8::u32x4 mp[8]; V8 hv[8]; float ss = 0;
#pragma unroll
            for (int i = 0; i < 8; ++i) mp[i] = *(const pg8::u32x4*)(SP(bf16_t, S_MX) + (size_t)r * 1024 + sl * 8 + 128 * i);
#pragma unroll
            for (int i = 0; i < 8; ++i) hv[i] = hx_load8(p, l == 0 ? 0 : 1, r, sl * 8 + 128 * i);
#pragma unroll
            for (int i = 0; i < 8; ++i)
#pragma unroll
                for (int e = 0; e < 4; ++e) { const float a_ = __uint_as_float(mp[i][e] << 16), b_ = __uint_as_float(mp[i][e] & 0xffff0000u); ss += a_ * a_ + b_ * b_; }
            const float rstd = rsqrtf(qsum(ss) * (1.f / 1024.f) + EPS); float s2 = 0;
#pragma unroll
            for (int i = 0; i < 8; ++i) { const int k = sl * 8 + 128 * i; const V8 gg = lds8(par + k);
#pragma unroll
                for (int e = 0; e < 4; ++e) { hv[i].v[2 * e] += gg.v[2 * e] * (__uint_as_float(mp[i][e] << 16) * rstd); hv[i].v[2 * e + 1] += gg.v[2 * e + 1] * (__uint_as_float(mp[i][e] & 0xffff0000u) * rstd); }
                if (ok) hx_store8(p, r, k, hv[i]);
                s2 += sq8(hv[i]); }
            const float rstd2 = rsqrtf(qsum(s2) * (1.f / 1024.f) + EPS);
            float lg[8] = {0, 0, 0, 0, 0, 0, 0, 0};
#pragma unroll
            for (int i = 0; i < 8; ++i) { const int k = sl * 8 + 128 * i; const V8 gg = lds8(par + 1024 + k), sh = lds8(par + 2048 + k); V8 fx;
#pragma unroll
                for (int e = 0; e < 8; ++e) fx.v[e] = hv[i].v[e] * rstd2 * gg.v[e] + sh.v[e];
                if (ok) { if (l == 1 || DENSE_FP8 == 1) st8_fp8((unsigned char*)WSP(bf16_t, OFF_XN) + (size_t)r * 1024 + k, fx); else st8_bf16(WSP(bf16_t, OFF_XN) + (size_t)r * 1024 + k, fx); }
                hv[i] = fx; }
            if (l == 1) {
#pragma unroll
                for (int i = 0; i < 8; ++i) { const lds_f4* wr = wrl + (sl * 8 + 128 * i) * 2;
#pragma unroll
                    for (int e = 0; e < 8; ++e) { const float f = hv[i].v[e]; const pg8::f32x4 wa = wr[e * 2], wb = wr[e * 2 + 1];
                        lg[0] += f * wa[0]; lg[1] += f * wa[1]; lg[2] += f * wa[2]; lg[3] += f * wa[3]; lg[4] += f * wb[0]; lg[5] += f * wb[1]; lg[6] += f * wb[2]; lg[7] += f * wb[3]; } }
#pragma unroll
                for (int e = 0; e < 8; ++e) lg[e] = qsum(lg[e]);
                int e0 = 0; float v0 = lg[0];
#pragma unroll
                for (int e = 1; e < 8; ++e) if (lg[e] > v0) { v0 = lg[e]; e0 = e; }
                int e1 = -1; float v1 = -3.0e38f;
#pragma unroll
                for (int e = 0; e < 8; ++e) if (e != e0 && lg[e] > v1) { v1 = lg[e]; e1 = e; }
                if (ok) {
#pragma unroll
                    for (int e = 0; e < 8; ++e) wcnt[e] += (e0 == e) + (e1 == e);
                    if (sl == 0) { const float w1 = __expf(v1 - v0), inv = 1.f / (1.f + w1);
                        WSP(int, OFF_TOKE)[r * 2] = e0; WSP(int, OFF_TOKE)[r * 2 + 1] = e1; WSP(float, OFF_TOKW)[r * 2] = inv; WSP(float, OFF_TOKW)[r * 2 + 1] = w1 * inv; } }
            }
        }
        r0 = r1; }
    if (l == 1) {
        __syncthreads();
        int* lc = (int*)(lds + 40960);
        if (sl0 == 0) { int4* dst = (int4*)(WSP(int, OFF_LNS) + (size_t)g * 8); dst[0] = make_int4(wcnt[0], wcnt[1], wcnt[2], wcnt[3]); dst[1] = make_int4(wcnt[4], wcnt[5], wcnt[6], wcnt[7]);
            const int o_ = p.wv * 4 + (lane >> 4);
#pragma unroll
            for (int e = 0; e < 8; ++e) lc[o_ * 8 + e] = wcnt[e]; }
        __syncthreads();
        if (tid < 8) { int t_ = 0;
#pragma unroll
            for (int o_ = 0; o_ < 32; ++o_) t_ += lc[o_ * 8 + tid];
            WSP(int, OFF_LNS)[(size_t)G * 32 * 8 + bid_() * 8 + tid] = t_; }
    }
    __syncthreads();
}
__device__ __forceinline__ void phase_moe_assign(const Params& p) {
    const int tid = tid_(p.wv), lane = tid & 63, gw = bid_() * 8 + p.wv, nown = gridDim.x * 32;
    const int* cntW = WSP(int, OFF_LNS); const int* cntB = cntW + (size_t)gridDim.x * 32 * 8;
    int tot[8] = {0, 0, 0, 0, 0, 0, 0, 0}, pre[8] = {0, 0, 0, 0, 0, 0, 0, 0};
    const int myb = bid_();
    for (int b = lane; b < (int)gridDim.x; b += 64) { const int4 a = *(const int4*)(cntB + (size_t)b * 8), c4 = *(const int4*)(cntB + (size_t)b * 8 + 4); const int c[8] = {a.x, a.y, a.z, a.w, c4.x, c4.y, c4.z, c4.w}; const int m = b < myb ? 1 : 0;
#pragma unroll
        for (int e = 0; e < 8; ++e) { tot[e] += c[e]; pre[e] += m * c[e]; } }
    if (lane < 32) { const int go = myb * 32 + lane; const int4 a = *(const int4*)(cntW + (size_t)go * 8), c4 = *(const int4*)(cntW + (size_t)go * 8 + 4); const int c[8] = {a.x, a.y, a.z, a.w, c4.x, c4.y, c4.z, c4.w}; const int m = go < 4 * gw ? 1 : 0;
#pragma unroll
        for (int e = 0; e < 8; ++e) pre[e] += m * c[e]; }
#pragma unroll
    for (int e = 0; e < 8; ++e)
#pragma unroll
        for (int o = 32; o > 0; o >>= 1) { tot[e] += __builtin_amdgcn_ds_bpermute((lane << 2) ^ (o << 2), tot[e]); pre[e] += __builtin_amdgcn_ds_bpermute((lane << 2) ^ (o << 2), pre[e]); }
    int off[9]; { int o = 0;
#pragma unroll
        for (int e = 0; e < 8; ++e) { off[e] = o; o += ((tot[e] + 255) >> 8) << 8; } off[8] = o; }
    int* cw = (int*)p.ws;
    if (gw == 0 && lane == 0) cw[CW_NT] = off[8] >> 8;
    for (int t = bid_() * 512 + tid; t < 272; t += gridDim.x * 512) { int e = 0;
#pragma unroll
        for (int q = 1; q < 8; ++q) if (t * 256 >= off[q]) e = q;
        WSP(int, OFF_TILEE)[t] = e; }
    int base[8];
#pragma unroll
    for (int e = 0; e < 8; ++e) base[e] = off[e] + pre[e];
    const int j = lane & 15, G = gridDim.x, RPB = (TL + G - 1) / G, rbeg = bid_() * RPB, rend = rbeg + RPB < TL ? rbeg + RPB : TL;
    const unsigned char* xn8 = (const unsigned char*)WSP(bf16_t, OFF_XN); unsigned char* xs8 = (unsigned char*)SP(bf16_t, S_YS);
    for (int r0 = rbeg; r0 < rend;) { const int r1 = seg_end(r0, rend);
        for (int k0 = 0; r0 + p.wv * 4 + 32 * k0 < r1; k0 += 8) {
            const int r = r0 + p.wv * 4 + (lane >> 4) + 32 * (k0 + (j >> 1)); const bool ok = r < r1;
            const int e = ok ? WSP(int, OFF_TOKE)[r * 2 + (j & 1)] : -1; int pos = 0;
#pragma unroll
            for (int q = 0; q < 8; ++q) { const unsigned long long mk = __ballot(e == q); if (e == q) pos = base[q] + __popcll(mk & ((1ull << lane) - 1ull)); base[q] += __popcll(mk); }
            if (ok) { WSP(int, OFF_ROWIDX)[pos] = r; WSP(int, OFF_TOKS)[r * 2 + (j & 1)] = pos; }
#pragma unroll
            for (int q = 0; q < 64; ++q) { const int rq = __builtin_amdgcn_readlane(r, q), pq = __builtin_amdgcn_readlane(pos, q), okq = __builtin_amdgcn_readlane((int)ok, q);
                if (okq) *(uint4*)(xs8 + (size_t)pq * 1024 + lane * 16) = *(const uint4*)(xn8 + (size_t)rq * 1024 + lane * 16); }
        }
        r0 = r1; }
}
__device__ __forceinline__ void phase_postffn(const Params& p, lds_t* lds, int l) {
    const int tid = tid_(p.wv), lane = tid & 63, sl0 = lane & 15, G = gridDim.x;
    const int nrows = l == 0 ? RR : TL, RPB = (nrows + G - 1) / G;
    lds_fl* par = (lds_fl*)(lds + EW_PAR_OFF);
    const int rbeg = bid_() * RPB, rend = rbeg + RPB < nrows ? rbeg + RPB : nrows;
    for (int r0 = rbeg; r0 < rend;) { const int r1 = seg_end(r0, rend); const float* mod = WSP(float, OFF_MOD) + ((size_t)l * 5 + row_cond(r0)) * 6144; const float* mod1 = WSP(float, OFF_MOD) + ((size_t)5 + row_cond(r0)) * 6144;
        __syncthreads();
        for (int i = tid; i < 1024; i += 512) { par[i] = p.g_post_ffn[l * 1024 + i] * mod[5120 + i]; if (l == 0) { par[1024 + i] = p.g_pre_mix[1024 + i] * (1.f + mod1[1024 + i]); par[2048 + i] = mod1[i]; } }
        __syncthreads();
        for (int rw = r0 + p.wv * 4; rw < r1; rw += 32) {
            int sl = sl0; asm volatile("" : "+v"(sl));
            const int rr = rw + (lane >> 4); const bool ok = rr < r1; const int r = ok ? rr : r0;
            V8 y[8], hv[8]; float ss = 0;
            if (l == 0) {
#pragma unroll
                for (int i = 0; i < 8; ++i) y[i] = ld8_bf16(WSP(bf16_t, OFF_XN) + (size_t)r * 1024 + sl * 8 + 128 * i);
#pragma unroll
                for (int i = 0; i < 8; ++i) hv[i] = hx_load8(p, 1, r, sl * 8 + 128 * i);
            } else { const bf16_t* y0 = ys_row(p, WSP(int, OFF_TOKS)[r * 2]); const bf16_t* y1 = ys_row(p, WSP(int, OFF_TOKS)[r * 2 + 1]); const float w0 = WSP(float, OFF_TOKW)[r * 2], w1 = WSP(float, OFF_TOKW)[r * 2 + 1];
                pg8::u32x4 ya[8], yb[8];
#pragma unroll
                for (int i = 0; i < 8; ++i) { ya[i] = *(const pg8::u32x4*)(y0 + sl * 8 + 128 * i); yb[i] = *(const pg8::u32x4*)(y1 + sl * 8 + 128 * i); }
#pragma unroll
                for (int i = 0; i < 8; ++i) hv[i] = hx_load8(p, 1, r, sl * 8 + 128 * i);
#pragma unroll
                for (int i = 0; i < 8; ++i)
#pragma unroll
                    for (int e = 0; e < 4; ++e) { y[i].v[2 * e] = w0 * __uint_as_float(ya[i][e] << 16) + w1 * __uint_as_float(yb[i][e] << 16); y[i].v[2 * e + 1] = w0 * __uint_as_float(ya[i][e] & 0xffff0000u) + w1 * __uint_as_float(yb[i][e] & 0xffff0000u); } }
#pragma unroll
            for (int i = 0; i < 8; ++i) ss += sq8(y[i]);
            const float rstd = rsqrtf(qsum(ss) * (1.f / 1024.f) + EPS); float s2 = 0;
#pragma unroll
            for (int i = 0; i < 8; ++i) { const int k = sl * 8 + 128 * i; const V8 gg = lds8(par + k);
#pragma unroll
                for (int e = 0; e < 8; ++e) hv[i].v[e] += gg.v[e] * (y[i].v[e] * rstd);
                if (l == 0 && ok) hx_store8(p, r, k, hv[i]); s2 += sq8(hv[i]); }
            if (l == 1) {
                asm volatile("s_waitcnt vmcnt(0)" ::: "memory");
                if (ok) {
#pragma unroll
                    for (int i = 0; i < 8; ++i) st8_f32nt(p.out + (size_t)r * 1024 + sl * 8 + 128 * i, hv[i]); } }
            if (l == 0) { const float rstd2 = rsqrtf(qsum(s2) * (1.f / 1024.f) + EPS);
#pragma unroll
                for (int i = 0; i < 8; ++i) { const int k = sl * 8 + 128 * i; const V8 gg = lds8(par + 1024 + k), sh = lds8(par + 2048 + k); V8 v;
#pragma unroll
                    for (int e = 0; e < 8; ++e) v.v[e] = hv[i].v[e] * rstd2 * gg.v[e] + sh.v[e];
                    if (ok) st8_bf16(WSP(bf16_t, OFF_XN) + (size_t)r * 1024 + k, v); } }
        }
        r0 = r1; }
    __syncthreads();
}
constexpr size_t S_MODP = 0;
__device__ __forceinline__ void phase_pro_a(const Params& p, lds_t* lds) {
    const int gt = bid_() * 512 + tid_(p.wv), ng = gridDim.x * 512;
    const double PI2 = 6.283185307179586476925;
    for (int i = gt; i < 8192; i += ng) {
        if (i < 128 * 16) { const int co = i >> 4, j = i & 15; const double a = (double)co * pow(10000.0, -(double)j / 16.0); WSP(float2, OFF_ROPEW)[i] = make_float2((float)cos(a), (float)sin(a)); }
        if (i < 128 * 8) { const int co = i >> 3, j = i & 7; const double a = (double)co * pow(10000.0, -(double)j / 8.0); WSP(float2, OFF_ROPEM)[i] = make_float2((float)cos(a), (float)sin(a)); }
        if (i < 64 * 128) { const int n2 = i >> 7, k1 = i & 127; const double a = PI2 * (double)(k1 * n2) / 8192.0; WSP(float2, OFF_TW)[i] = make_float2((float)cos(a), (float)sin(a)); }
    }
    for (int i = gt; i < 512 * 256; i += ng) {
        if (i < 256 * 128) { const int m = i >> 7, n1 = i & 127, kb = m >> 6, ri = (m >> 5) & 1, k1 = kb * 32 + (m & 31); float sn, cs; sincospif((float)((k1 * n1) & 127) * (1.f / 64.f), &sn, &cs);
            WSP(bf16_t, OFF_FA)[i] = f2bf((ri ? -sn : cs) * (1.f / 724.0773439350247f)); }
        if (i < 128 * 128) { const int m = i >> 7, kc = i & 127, rio = m >> 6, k2 = m & 63, rii = kc >> 6, n2 = kc & 63; float sn, cs; sincospif((float)((n2 * k2) & 63) * (1.f / 32.f), &sn, &cs);
            WSP(bf16_t, OFF_GM)[i] = f2bf(rio == rii ? cs : (rio == 0 ? sn : -sn)); }
        { const int row = i >> 8, n = i & 255, ri = row >> 8, k = row & 255; float sn, cs; sincospif((float)((k * n) & 255) * (1.f / 128.f), &sn, &cs);
            WSP(bf16_t, OFF_FC)[i] = f2bf((ri ? -sn : cs) * (1.f / 128.f)); }
    }
    { const int t = tid_(p.wv); float2* trig = (float2*)lds;
      if (t < 64) { float sn, cs; sincospif((float)t * (1.f / 32.f), &sn, &cs); trig[t] = make_float2(cs, sn); }
      __syncthreads();
      for (int i = gt; i < 2 * 512 * 256; i += ng) { const int j = i & 255, row = (i >> 8) & 511, l = i >> 17, ri = row >> 8, g = (row >> 6) & 3, c = row & 63; float acc = 0;
#pragma unroll 8
        for (int cp = 0; cp < 64; ++cp) { const float2 tv = trig[(c * cp) & 63]; acc += (ri ? tv.y : tv.x) * p.w_fourier[(size_t)l * 65536 + (g * 64 + cp) * 256 + j]; }
        WSP(float, OFF_M12)[i] = acc; }
      __syncthreads(); }
    { const int t = tid_(p.wv), w = p.wv, lane = t & 63; float* sil = (float*)lds  , *red = (float*)lds + 5 * 1024;
      if (bid_() < 2 * 96) { for (int i = t; i < 5 * 1024; i += 512) { const int k = i / 5, r = i % 5; sil[i] = silu_f(r < 4 ? p.c[r * 1024 + k] : p.c_ctx[k]); } }
      __syncthreads();
      for (int it = bid_(); it < 2 * 96; it += gridDim.x) { const int l = it / 96, n = (it % 96) * 64 + lane; const float* W = p.w_mod + (size_t)l * 1024 * 6144 + n;
        float acc[5] = {0, 0, 0, 0, 0};
#pragma unroll 8
        for (int kk = 0; kk < 128; ++kk) { const int k = w * 128 + kk; const float wv = W[(size_t)k * 6144];
#pragma unroll
            for (int r = 0; r < 5; ++r) acc[r] += sil[k * 5 + r] * wv; }
        __syncthreads();
#pragma unroll
        for (int r = 0; r < 5; ++r) red[(w * 5 + r) * 64 + lane] = acc[r];
        __syncthreads();
        if (t < 320) { const int r = t >> 6; float a = p.b_mod[l * 6144 + n];
#pragma unroll
            for (int ww = 0; ww < 8; ++ww) a += red[(ww * 5 + r) * 64 + lane];
            WSP(float, OFF_MOD)[((size_t)l * 5 + r) * 6144 + n] = a; } }
      __syncthreads(); }
    phase_cvt(p, lds, 0, gridDim.x == 256 ? CVT_MOE0 : CVT_TOT, bid_(), gridDim.x);
}
__device__ __forceinline__ void phase_pro_b(const Params& p, lds_t* lds) {
    const int tid = tid_(p.wv), hk = tid >> 8, o4 = (tid & 255) * 4;
    typedef __attribute__((address_space(3))) float lds_f;
    lds_f* mrow = (lds_f*)lds;
    for (int it = bid_(); it < 2 * 64; it += gridDim.x) { const int l = it >> 6, k0 = (it & 63) * 8;
        __syncthreads();
        for (int i = tid; i < 8 * 256; i += 512) mrow[i] = ld_f(WSP(float, OFF_M12) + ((size_t)l * 512 + k0) * 256 + i);
        __syncthreads();
        const float* wo = p.w_out + (size_t)l * 1024 * 1024 + o4; const lds_f* m = mrow + hk * 4 * 256;
        float4 acc[4];
#pragma unroll
        for (int q = 0; q < 4; ++q) acc[q] = make_float4(0.f, 0.f, 0.f, 0.f);
#pragma unroll 8
        for (int j = 0; j < 256; ++j) { const float4 w4 = *(const float4*)(wo + (size_t)j * 1024);
#pragma unroll
            for (int q = 0; q < 4; ++q) { const float mv = m[q * 256 + j]; acc[q].x += mv * w4.x; acc[q].y += mv * w4.y; acc[q].z += mv * w4.z; acc[q].w += mv * w4.w; } }
#pragma unroll
        for (int q = 0; q < 4; ++q) *(float4*)(WSP(float, OFF_WOF) + ((size_t)l * 512 + k0 + hk * 4 + q) * 1024 + o4) = acc[q];
    }
    __syncthreads();
}
__device__ __forceinline__ void phase_cvt_wof(const Params& p, lds_t* lds) {
    const int t = tid_(p.wv), lane = t & 63, gw = bid_() * 8 + p.wv, nw = gridDim.x * 8, kq = lane >> 4, oc = (lane & 15) * 4;
    unsigned char* T = (unsigned char*)lds + p.wv * 9216;
    for (int ti = gw; ti < 2 * 20 * 16; ti += nw) { const int l = ti / 320, kb = (ti % 320) / 16, ob = ti % 16, k0 = kb * 64, o0 = ob * 64;
        const float* src = k0 < 512 ? WSP(float, OFF_WOF) + ((size_t)l * 512 + k0) * 1024 : p.w_out + (size_t)l * 1024 * 1024 + (size_t)(k0 - 256) * 1024;
        float4 v[16];
#pragma unroll
        for (int q = 0; q < 16; ++q) v[q] = *(const float4*)(src + (size_t)(16 * (q >> 2) + 4 * kq + (q & 3)) * 1024 + o0 + oc);
        cvt_wave_store(v, false, WP(W_O) + (size_t)l * 1024 * 1280, 1280, o0, k0, T, lane);
    }
    __syncthreads();
}

#define XB_TMO      128
#define XB_XCNT(j)  (256  + 64 * (j))
#define XB_XSUB(j)  (1280 + 64 * (j))
#define XB_XGEN(j)  (2304 + 64 * (j))
#define XB_TOP      3328
#define XB_TOPGEN   3392
#define XCD_BAR_WORDS 3456
#define XB_SPIN_CAP (1u << 20)
#define LAS __attribute__((address_space(3)))
__device__ __forceinline__ unsigned xb_ld(unsigned* p)              { return __hip_atomic_load(p, __ATOMIC_RELAXED, __HIP_MEMORY_SCOPE_AGENT); }
__device__ __forceinline__ unsigned xb_add(unsigned* p, unsigned v) { return __hip_atomic_fetch_add(p, v, __ATOMIC_RELAXED, __HIP_MEMORY_SCOPE_AGENT); }
__device__ __forceinline__ unsigned xb_xcc_id() { return (unsigned)__builtin_amdgcn_s_getreg((3 << 11) | 20) & 0xFu; }
#define XB_SPIN(cond, bar) do { unsigned _sp = 0; while (cond) { __builtin_amdgcn_s_sleep(1); \
    if ((++_sp & 255u) == 0u) { if (xb_ld(&(bar)[XB_TMO])) break; if (_sp > XB_SPIN_CAP) { atomicAdd(&(bar)[XB_TMO], 1u); break; } } } } while (0)
struct XcdBarrier { unsigned* bar; unsigned x; volatile LAS unsigned* st; int wv; };
__device__ __forceinline__ XcdBarrier xcd_barrier_post(unsigned* bar, volatile LAS unsigned* st, int wv) {
    XcdBarrier b; b.bar = bar; b.x = xb_xcc_id(); b.st = st; b.wv = wv;
    if (tid_(wv) == 0) (void)xb_add(&bar[XB_XCNT(b.x)], 1u);
    return b;
}
__device__ __forceinline__ void xcd_barrier_complete(unsigned* bar, unsigned x, unsigned& nloc, unsigned& nx) {
    const unsigned G = gridDim.x * gridDim.y * gridDim.z;
    unsigned sum, cnt, mine, sp = 0u;
    for (;;) {
        sum = 0u; cnt = 0u; mine = 0u;
#pragma unroll
        for (unsigned j = 0; j < 16; ++j) { const unsigned c = xb_ld(&bar[XB_XCNT(j)]); sum += c; cnt += (c > 0u) ? 1u : 0u; mine = (j == x) ? c : mine; }
        if (sum == G) break;
        __builtin_amdgcn_s_sleep(1);
        if ((++sp & 255u) == 0u) { if (xb_ld(&bar[XB_TMO])) break; if (sp > XB_SPIN_CAP) { atomicAdd(&bar[XB_TMO], 1u); break; } }
    }
    nloc = mine > 0u ? mine : 1u; nx = cnt > 0u ? cnt : 1u;
}
__device__ __forceinline__ void xcd_barrier(const XcdBarrier& b) {
    asm volatile("s_waitcnt vmcnt(0)" ::: "memory");
    __syncthreads();
    if (tid_(b.wv) == 0) {
        unsigned* bar = b.bar; unsigned bx = b.x; asm volatile("" : "+s"(bx));
        __builtin_amdgcn_s_waitcnt(0);
        unsigned nloc = b.st[0], nx = b.st[1];
        if (nloc == 0u) { xcd_barrier_complete(bar, bx, nloc, nx); b.st[0] = nloc; b.st[1] = nx; }
        const unsigned old = xb_add(&bar[XB_XSUB(bx)], 1u);
        const unsigned gen = old / nloc;
        if (old + 1u == (gen + 1u) * nloc) {
            __builtin_amdgcn_fence(__ATOMIC_RELEASE, "agent");
            asm volatile("s_waitcnt vmcnt(0)" ::: "memory");
            const unsigned og = xb_add(&bar[XB_TOP], 1u);
            const unsigned tg = og / nx;
            if (og + 1u == (tg + 1u) * nx) xb_add(&bar[XB_TOPGEN], 1u);
            else XB_SPIN(xb_ld(&bar[XB_TOPGEN]) == tg, bar);
            __builtin_amdgcn_fence(__ATOMIC_ACQUIRE, "agent");
            xb_add(&bar[XB_XGEN(bx)], 1u);
            asm volatile("s_waitcnt vmcnt(0)" ::: "memory");
        } else {
            XB_SPIN(xb_ld(&bar[XB_XGEN(bx)]) == gen, bar);
            __builtin_amdgcn_fence(__ATOMIC_ACQUIRE, "agent");
            asm volatile("s_waitcnt vmcnt(0)" ::: "memory");
        }
    }
    __syncthreads();
}


constexpr int LDS_BAR_OFF = 131072 + 8192;
__global__ void __launch_bounds__(OPT_THREADS, 2) mk_fwd(Params p) {
    extern __shared__ __attribute__((aligned(16))) unsigned char lds_raw[];
    lds_t* lds = (lds_t*)lds_raw;
    p.wv = __builtin_amdgcn_readfirstlane(threadIdx.x >> 6);
    volatile LAS unsigned* bst = (volatile LAS unsigned*)(lds + LDS_BAR_OFF);
    { const int t0_ = tid_(p.wv); if (t0_ < 4) bst[t0_] = 0u; }
    __syncthreads();
    XcdBarrier bar = xcd_barrier_post((unsigned*)p.ws, bst, p.wv);
#define LP() ({ Params q_ = p; unsigned long long w_ = (unsigned long long)(uintptr_t)q_.ws; asm volatile("" : "+s"(w_)); \
    q_.ws = (char*)(uintptr_t)(((unsigned long long)(unsigned)__builtin_amdgcn_readfirstlane((int)(w_ >> 32)) << 32) | (unsigned)__builtin_amdgcn_readfirstlane((int)w_)); q_; })
#define REPN(bit) ([]() { int n_ = 1 + ((MK_REP >> (bit)) & 1); asm volatile("" : "+s"(n_)); return n_; }())
#define REP(bit, stmt) do { const int n__ = REPN(bit); _Pragma("unroll 1") for (int rep_ = 0; rep_ < n__; ++rep_) { stmt; } } while (0)
    REP(0, phase_pro_a(LP(), lds));
    xcd_barrier(bar);
    REP(8, phase_pro_b(LP(), lds)); REP(13, phase_norm1(LP(), lds, 0));
    xcd_barrier(bar);
#pragma unroll 1
    for (int l = 0; l < 2; ++l) {
        REP(1, phase_inproj(LP(), lds, l)); if (l == 0) cvt_in_tail(LP(), lds, 132 * 7, 0, 1800);
        xcd_barrier(bar);
        if (l == 0) phase_cvt_wof(LP(), lds);
        REP(2, phase_up(LP(), lds, l)); REP(10, phase_fft_a(LP(), lds)); REP(11, phase_sgu(LP(), lds, l)); if (l == 0) phase_dft_ctx(LP(), lds);
        xcd_barrier(bar);
        REP(3, phase_mla(LP(), lds, l)); REP(4, phase_win(LP(), lds, l)); REP(12, phase_fft_c(LP(), lds));
        xcd_barrier(bar);
        REP(5, phase_outproj(LP(), lds, l)); if (l == 0) cvt_in_tail(LP(), lds, 132 * 4, 1800, 5500);
        xcd_barrier(bar);
        if (l == 0) { REP(9, phase_postmix(LP(), lds, l)); } else phase_postmix(LP(), lds, l);
        xcd_barrier(bar);
        if (l == 0) {
            REP(6, phase_ffn_gu_dense(LP(), lds)); cvt_in_tail(LP(), lds, 132 * 28, 5500, 8500); xcd_barrier(bar);
            REP(6, phase_ffn_dn_dense(LP(), lds)); cvt_in_tail(LP(), lds, 132 * 4, 8500, CVT_TOT - CVT_MOE0); xcd_barrier(bar);
        } else {
            phase_moe_assign(LP()); xcd_barrier(bar);
            REP(7, phase_moe_gu(p, lds)); xcd_barrier(bar);
            REP(7, phase_moe_dn(p, lds)); xcd_barrier(bar);
        }
        phase_postffn(LP(), lds, l);
        if (l == 0) xcd_barrier(bar);
    }
#ifdef MK_XBAR
#pragma unroll 1
    for (int i = 0; i < MK_XBAR; ++i) xcd_barrier(bar);
#endif
}

template <int PH>
__global__ void __launch_bounds__(OPT_THREADS, 2) opt_k(Params p, int l, int a0) {
    extern __shared__ __attribute__((aligned(16))) unsigned char lds_raw[];
    lds_t* lds = (lds_t*)lds_raw;
    p.wv = __builtin_amdgcn_readfirstlane(threadIdx.x >> 6);
    if constexpr (PH == PH_CVT) phase_cvt(p, lds, 0, CVT_TOT, blockIdx.x, gridDim.x);
    if constexpr (PH == PH_FFN_GU) phase_ffn_gu_dense(p, lds);
    if constexpr (PH == PH_FFN_DN) phase_ffn_dn_dense(p, lds);
    if constexpr (PH == PH_MOE_GU) phase_moe_gu(p, lds);
    if constexpr (PH == PH_MOE_DN) phase_moe_dn(p, lds);
    if constexpr (PH == PH_INPROJ) phase_inproj(p, lds, l);
    if constexpr (PH == PH_UP) phase_up(p, lds, l);
    if constexpr (PH == PH_OUTPROJ) phase_outproj(p, lds, l);
    if constexpr (PH == PH_MLA) phase_mla(p, lds, l);
    if constexpr (PH == PH_WIN) phase_win(p, lds, l);
    if constexpr (PH == PH_FFTA) phase_fft_a(p, lds);
    if constexpr (PH == PH_FFTC) phase_fft_c(p, lds);
    if constexpr (PH == PH_DFTC) phase_dft_ctx(p, lds);
    if constexpr (PH == PH_SGU) phase_sgu(p, lds, l);
    if constexpr (PH == PH_PROA) phase_pro_a(p, lds);
    if constexpr (PH == PH_PROB) { phase_pro_b(p, lds); }
    if constexpr (PH == PH_NORM1) { if (l == 0 && a0 == 1) phase_cvt_wof(p, lds); }
    if constexpr (PH == PH_NORM1) phase_norm1(p, lds, l);
    if constexpr (PH == PH_POSTMIX) phase_postmix(p, lds, l);
    if constexpr (PH == PH_ASSIGN) phase_moe_assign(p);
    if constexpr (PH == PH_POSTFFN) phase_postffn(p, lds, l);
}
template <int PH> static void launch_opt(const Params& p, int l, int a0, hipStream_t stream) {
    static bool init = false;
    if (!init) { (void)hipFuncSetAttribute((const void*)opt_k<PH>, hipFuncAttributeMaxDynamicSharedMemorySize, OPT_LDS); init = true; }
    hipLaunchKernelGGL(opt_k<PH>, dim3(256), dim3(OPT_THREADS), OPT_LDS, stream, p, l, a0);
}

constexpr bool USE_MK = true;
extern "C" void kernel_launch(void* const* d_in, const int* in_sizes, int n_in, void* d_out, int out_size, void* d_ws, size_t ws_size, hipStream_t stream) {
    if (n_in != 27 || ws_size < WS_NEED) { fprintf(stderr, "kernel_launch: bad args n_in %d ws %zu need %zu\n", n_in, ws_size, WS_NEED); return; }
    Params p{};
    const float** pp = (const float**)&p;
    for (int i = 0; i < 27; ++i) pp[i] = (const float*)d_in[i];
    p.out = (float*)d_out; p.ws = (char*)d_ws;
    if (USE_MK) {
        static int grid = 0;
        if (!grid) {
            int dev = 0, cus = 0, per_cu = 0;
            hipGetDevice(&dev); hipDeviceGetAttribute(&cus, hipDeviceAttributeMultiprocessorCount, dev);
            if (hipFuncSetAttribute((const void*)mk_fwd, hipFuncAttributeMaxDynamicSharedMemorySize, OPT_LDS) != hipSuccess) { fprintf(stderr, "kernel_launch: hipFuncSetAttribute failed\n"); return; }
            if (hipOccupancyMaxActiveBlocksPerMultiprocessor(&per_cu, (const void*)mk_fwd, OPT_THREADS, OPT_LDS) != hipSuccess || per_cu < 1) fprintf(stderr, "kernel_launch: note: occupancy query says %d blocks per CU; launching one per CU anyway\n", per_cu);
            grid = cus > 0 ? cus : 256;
        }
        hipMemsetAsync(d_ws, 0, 65536, stream);
        hipLaunchKernelGGL(mk_fwd, dim3(grid), dim3(OPT_THREADS), OPT_LDS, stream, p);
        return;
    }
    hipMemsetAsync(d_ws, 0, 65536, stream);
    launch_opt<PH_PROA>(p, 0, 0, stream);
    launch_opt<PH_PROB>(p, 0, 0, stream);
    launch_opt<PH_NORM1>(p, 0, 1, stream);
    for (int l = 0; l < 2; ++l) {
        launch_opt<PH_INPROJ>(p, l, 0, stream);
        launch_opt<PH_UP>(p, l, 0, stream);
        launch_opt<PH_SGU>(p, l, 0, stream);
        launch_opt<PH_FFTA>(p, l, 0, stream);
        launch_opt<PH_FFTC>(p, l, 0, stream);
        if (l == 0) launch_opt<PH_DFTC>(p, l, 0, stream);
        launch_opt<PH_WIN>(p, l, 0, stream);
        launch_opt<PH_MLA>(p, l, 0, stream);
        launch_opt<PH_OUTPROJ>(p, l, 0, stream);
        launch_opt<PH_POSTMIX>(p, l, 0, stream);
        if (l == 0) {
            launch_opt<PH_FFN_GU>(p, l, 0, stream);
            launch_opt<PH_FFN_DN>(p, l, 0, stream);
        } else {
            launch_opt<PH_ASSIGN>(p, l, 0, stream);
            launch_opt<PH_MOE_GU>(p, l, 0, stream);
            launch_opt<PH_MOE_DN>(p, l, 0, stream);
        }
        launch_opt<PH_POSTFFN>(p, l, 0, stream);
    }
}
```
